# Optimizing an MI355X kernel written in HIP

```python
import math
import jax, jax.numpy as jnp
from jax import lax
import numpy as np

D_MODEL = 1024
BATCH = 32
SEQ = 256
DEPTH = 2
DEC_BATCH = 4
DEC_SEQ = 4096
PAST_LEN = 256

GRID_W = 64
N_HEADS_A = 4
HEAD_DIM_A = 64
V_DIM_A = 2 * HEAD_DIM_A
QK_WIDTH = N_HEADS_A * 2 * HEAD_DIM_A
WIDTH_A = N_HEADS_A * V_DIM_A
N_GROUPS_B = 4
CHUNK = 128
GROUP_DIM_B = 128
WIDTH_B = N_GROUPS_B * GROUP_DIM_B
IN_WIDTH_0 = 2 * QK_WIDTH + WIDTH_A + 2 * WIDTH_B
MIX_WIDTH_0 = WIDTH_A + WIDTH_B
WIDTH_C = D_MODEL
CONV_W = 3
D_FF = 4 * D_MODEL
ROPE_BASE = 10000.0
ROPE_PAIRS = HEAD_DIM_A // 4
LN_EPS = 1e-5
Q_BLOCK = 128
ALPHA = (2 * DEPTH) ** 0.25
BETA = (8 * DEPTH) ** -0.25
LAMBDA_INIT_0 = 0.8 - 0.6 * math.exp(-0.3 * 0)

kernel_name = 'hybrid_diffattn_sgu_shortconv_deepnorm_step'


def layer_norm(x, g, b):
    xf = x.astype(jnp.float32)
    mu = jnp.mean(xf, -1, keepdims=True)
    var = jnp.mean(jnp.square(xf - mu), -1, keepdims=True)
    return ((xf - mu) * lax.rsqrt(var + LN_EPS)).astype(x.dtype) * g + b


def layer_norm_plain(x):
    xf = x.astype(jnp.float32)
    mu = jnp.mean(xf, -1, keepdims=True)
    var = jnp.mean(jnp.square(xf - mu), -1, keepdims=True)
    return ((xf - mu) * lax.rsqrt(var + LN_EPS)).astype(x.dtype)


def rms_norm(x, g):
    xf = x.astype(jnp.float32)
    return (xf * lax.rsqrt(jnp.mean(jnp.square(xf), -1, keepdims=True) + LN_EPS)).astype(x.dtype) * g


def adaln(cvec, w_mod, b_mod):
    m = jax.nn.silu(cvec) @ w_mod + b_mod
    return [t[:, None, :] for t in jnp.split(m, 6, axis=-1)]


def grid_angles(n):
    rows = n // GRID_W
    row = jnp.repeat(jnp.arange(rows, dtype=jnp.float32), GRID_W)
    col = jnp.tile(jnp.arange(GRID_W, dtype=jnp.float32), rows)
    inv = 1.0 / (ROPE_BASE ** (jnp.arange(ROPE_PAIRS, dtype=jnp.float32) / ROPE_PAIRS))
    return row[:, None] * inv, col[:, None] * inv


def rotate(x, ang):
    cos = jnp.cos(ang)[:, None, None, :].astype(x.dtype)
    sin = jnp.sin(ang)[:, None, None, :].astype(x.dtype)
    x1, x2 = jnp.split(x, 2, axis=-1)
    return jnp.concatenate([x1 * cos - x2 * sin, x1 * sin + x2 * cos], axis=-1)


def axial_rope(x, ang_r, ang_c):
    half = HEAD_DIM_A // 2
    return jnp.concatenate([rotate(x[..., :half], ang_r), rotate(x[..., half:], ang_c)], axis=-1)


def diff_lambda(lq1, lk1, lq2, lk2, lambda_init):
    f = jnp.float32
    return (jnp.exp(jnp.sum(lq1.astype(f) * lk1.astype(f)))
            - jnp.exp(jnp.sum(lq2.astype(f) * lk2.astype(f))) + lambda_init)


def diff_attend(q, k, v, lam):
    s = jnp.einsum('bqhid,bkhid->bhiqk', q, k).astype(jnp.float32) * (HEAD_DIM_A ** -0.5)
    p = jax.nn.softmax(s, axis=-1)
    a = p[:, :, 0] - lam * p[:, :, 1]
    return jnp.einsum('bhqk,bkhv->bqhv', a.astype(v.dtype), v)


def blocked_diff_attend(q, k, v, lam):
    b, n = q.shape[:2]
    nb = n // Q_BLOCK
    qb = jnp.moveaxis(q.reshape(b, nb, Q_BLOCK, N_HEADS_A, 2, HEAD_DIM_A), 1, 0)
    ob = lax.map(lambda qi: diff_attend(qi, k, v, lam), qb)
    return jnp.moveaxis(ob, 0, 1).reshape(b, n, N_HEADS_A, V_DIM_A)


def ab_project(h, w_in):
    b, n, _ = h.shape
    q, k, v, u, g = jnp.split(h @ w_in, [QK_WIDTH, 2 * QK_WIDTH, 2 * QK_WIDTH + WIDTH_A,
                                         2 * QK_WIDTH + WIDTH_A + WIDTH_B], axis=-1)
    return (q.reshape(b, n, N_HEADS_A, 2, HEAD_DIM_A), k.reshape(b, n, N_HEADS_A, 2, HEAD_DIM_A),
            v.reshape(b, n, N_HEADS_A, V_DIM_A), u.reshape(b, n, N_GROUPS_B, GROUP_DIM_B),
            g.reshape(b, n, N_GROUPS_B, GROUP_DIM_B))


def chunk_sgu(u, v, sgu_w, sgu_b):
    b, n = u.shape[:2]
    vc = layer_norm_plain(v).reshape(b, n // CHUNK, CHUNK, N_GROUPS_B, GROUP_DIM_B)
    mixed = jnp.einsum('gpq,bcqgd->bcpgd', sgu_w, vc) + sgu_b.T[None, None, :, :, None]
    return u * mixed.reshape(b, n, N_GROUPS_B, GROUP_DIM_B)


def ab_output(attn, u, g, subln_g, sgu_w, sgu_b, w_out):
    b, n = attn.shape[:2]
    a = rms_norm(attn, subln_g) * (1.0 - LAMBDA_INIT_0)
    s = chunk_sgu(u, g, sgu_w, sgu_b)
    return jnp.concatenate([a.reshape(b, n, WIDTH_A), s.reshape(b, n, WIDTH_B)], axis=-1) @ w_out


def short_conv_mixer(h, w_in, conv_w, w_out):
    bg, cg, xt = jnp.split(h @ w_in, 3, axis=-1)
    z = cg * xt
    n = h.shape[1]
    pad = CONV_W // 2
    zp = jnp.pad(z, ((0, 0), (pad, pad), (0, 0)))
    y = zp[:, 0:n] * conv_w[0]
    for j in range(1, CONV_W):
        y = y + zp[:, j:j + n] * conv_w[j]
    return (bg * y) @ w_out


def sq_relu_mlp(h, w1, w2):
    return jnp.square(jax.nn.relu(h @ w1)) @ w2


def setup_inputs(seed: int = 0) -> dict:
    key = jax.random.key(seed)
    ks = iter(jax.random.split(key, 64))
    f = jnp.float32
    d = D_MODEL

    def nrm(shape, scale):
        return jax.random.normal(next(ks), shape, f) * scale

    return {
        'x_prompt': nrm((BATCH, SEQ, d), 1.0),
        'x_sample': nrm((DEC_BATCH, DEC_SEQ, d), 1.0),
        'cache_k0': nrm((DEC_BATCH, PAST_LEN, N_HEADS_A, 2, HEAD_DIM_A), 1.0),
        'cache_v0': nrm((DEC_BATCH, PAST_LEN, N_HEADS_A, V_DIM_A), 1.0),
        'c': nrm((DEC_BATCH, d), 1.0),
        'c_ctx': nrm((d,), 1.0),
        'w_mod0': nrm((d, 6 * d), d ** -0.5),
        'b_mod0': nrm((6 * d,), 0.02),
        'w_in0': nrm((d, IN_WIDTH_0), d ** -0.5),
        'lambda_q1_0': nrm((HEAD_DIM_A,), 0.1),
        'lambda_k1_0': nrm((HEAD_DIM_A,), 0.1),
        'lambda_q2_0': nrm((HEAD_DIM_A,), 0.1),
        'lambda_k2_0': nrm((HEAD_DIM_A,), 0.1),
        'subln_g0': 1.0 + nrm((V_DIM_A,), 0.02),
        'sgu_w0': nrm((N_GROUPS_B, CHUNK, CHUNK), CHUNK ** -0.5),
        'sgu_b0': 1.0 + nrm((N_GROUPS_B, CHUNK), 0.02),
        'w_out0': nrm((MIX_WIDTH_0, d), BETA * MIX_WIDTH_0 ** -0.5),
        'ln_mix_g0': 1.0 + nrm((d,), 0.02),
        'ln_mix_b0': nrm((d,), 0.02),
        'w_ff1_0': nrm((d, D_FF), d ** -0.5),
        'w_ff2_0': nrm((D_FF, d), BETA * D_FF ** -0.5),
        'ln_ff_g0': 1.0 + nrm((d,), 0.02),
        'ln_ff_b0': nrm((d,), 0.02),
        'w_mod1': nrm((d, 6 * d), d ** -0.5),
        'b_mod1': nrm((6 * d,), 0.02),
        'w_in1': nrm((d, 3 * WIDTH_C), d ** -0.5),
        'conv_w1': nrm((CONV_W, WIDTH_C), CONV_W ** -0.5),
        'w_out1': nrm((WIDTH_C, d), BETA * WIDTH_C ** -0.5),
        'ln_mix_g1': 1.0 + nrm((d,), 0.02),
        'ln_mix_b1': nrm((d,), 0.02),
        'w_ff1_1': nrm((d, D_FF), d ** -0.5),
        'w_ff2_1': nrm((D_FF, d), BETA * D_FF ** -0.5),
        'ln_ff_g1': 1.0 + nrm((d,), 0.02),
        'ln_ff_b1': nrm((d,), 0.02),
    }


def reference(x_prompt, x_sample, cache_k0, cache_v0, c, c_ctx,
              w_mod0, b_mod0, w_in0, lambda_q1_0, lambda_k1_0, lambda_q2_0, lambda_k2_0,
              subln_g0, sgu_w0, sgu_b0, w_out0, ln_mix_g0, ln_mix_b0, w_ff1_0, w_ff2_0,
              ln_ff_g0, ln_ff_b0,
              w_mod1, b_mod1, w_in1, conv_w1, w_out1, ln_mix_g1, ln_mix_b1, w_ff1_1, w_ff2_1,
              ln_ff_g1, ln_ff_b1):
    shared = ((w_mod0, b_mod0, ln_mix_g0, ln_mix_b0, w_ff1_0, w_ff2_0, ln_ff_g0, ln_ff_b0),
              (w_mod1, b_mod1, ln_mix_g1, ln_mix_b1, w_ff1_1, w_ff2_1, ln_ff_g1, ln_ff_b1))
    ang_r, ang_c = grid_angles(x_sample.shape[1])
    xp, xs = x_prompt, x_sample
    new_k0 = new_v0 = None
    for layer in range(DEPTH):
        w_mod, b_mod, g_mix, bt_mix, w_ff1, w_ff2, g_ff, bt_ff = shared[layer]
        sh_p, sc_p, ga_p, shf_p, scf_p, gaf_p = adaln(c_ctx[None, :], w_mod, b_mod)
        sh_s, sc_s, ga_s, shf_s, scf_s, gaf_s = adaln(c, w_mod, b_mod)
        hp = xp * (1.0 + sc_p) + sh_p
        hs = xs * (1.0 + sc_s) + sh_s
        if layer % 2 == 0:
            lam = diff_lambda(lambda_q1_0, lambda_k1_0, lambda_q2_0, lambda_k2_0, LAMBDA_INIT_0)
            qp, kp, vp, up, gp = ab_project(hp, w_in0)
            out_p = ab_output(diff_attend(qp, kp, vp, lam), up, gp, subln_g0, sgu_w0, sgu_b0, w_out0)
            new_k0, new_v0 = kp, vp
            qs, ks_, vs, us, gs = ab_project(hs, w_in0)
            qs = axial_rope(qs, ang_r, ang_c)
            k_all = jnp.concatenate([cache_k0, axial_rope(ks_, ang_r, ang_c)], axis=1)
            v_all = jnp.concatenate([cache_v0, vs], axis=1)
            out_s = ab_output(blocked_diff_attend(qs, k_all, v_all, lam), us, gs,
                              subln_g0, sgu_w0, sgu_b0, w_out0)
        else:
            out_p = short_conv_mixer(hp, w_in1, conv_w1, w_out1)
            out_s = short_conv_mixer(hs, w_in1, conv_w1, w_out1)
        xp = layer_norm(ALPHA * xp + ga_p * out_p, g_mix, bt_mix)
        xs = layer_norm(ALPHA * xs + ga_s * out_s, g_mix, bt_mix)
        fp = sq_relu_mlp(xp * (1.0 + scf_p) + shf_p, w_ff1, w_ff2)
        fs = sq_relu_mlp(xs * (1.0 + scf_s) + shf_s, w_ff1, w_ff2)
        xp = layer_norm(ALPHA * xp + gaf_p * fp, g_ff, bt_ff)
        xs = layer_norm(ALPHA * xs + gaf_s * fs, g_ff, bt_ff)
    return (xp, xs, new_k0, new_v0)
```

```cpp
#include <hip/hip_runtime.h>
#include <hip/hip_cooperative_groups.h>
#include <hip/hip_bf16.h>
#include <cstdio>
#include <cstdint>
namespace cg = cooperative_groups;

#ifndef MK_PER_PHASE
#define MK_PER_PHASE 0
#endif

constexpr int DM = 1024, MP = 8192, MS = 16384, MT = MP + MS;
constexpr int NCOND = 5, MODW = 6 * DM;
constexpr int IN0 = 2560, IN1 = 3072, DFF = 4096;
constexpr float ALPHA_F = 1.4142135623730951f;
constexpr float LN_EPS_F = 1e-5f;
constexpr float LAMBDA_INIT = 0.2f;
constexpr int MHALF = MT / 2;

constexpr size_t WS_MOD  = 0;
constexpr size_t WS_CK   = 262144;
constexpr size_t WS_CV   = WS_CK + 1048576;
constexpr size_t WS_WIN0 = WS_CV + 1048576;
constexpr size_t WS_WOUT0 = WS_WIN0 + (size_t)IN0 * DM * 2;
constexpr size_t WS_WFF1_0 = WS_WOUT0 + (size_t)DM * DM * 2;
constexpr size_t WS_WFF2_0 = WS_WFF1_0 + (size_t)DFF * DM * 2;
constexpr size_t WS_WIN1 = WS_WFF2_0 + (size_t)DFF * DM * 2;
constexpr size_t WS_WOUT1 = WS_WIN1 + (size_t)IN1 * DM * 2;
constexpr size_t WS_WFF1_1 = WS_WOUT1 + (size_t)DM * DM * 2;
constexpr size_t WS_WFF2_1 = WS_WFF1_1 + (size_t)DFF * DM * 2;
constexpr size_t WS_HB   = WS_WFF2_1 + (size_t)DFF * DM * 2;
constexpr size_t WS_R1   = WS_HB + (size_t)MT * DM * 2;
constexpr size_t WS_END  = WS_R1 + (size_t)MT * IN1 * 2;
static_assert(WS_END <= 268435456ull, "workspace budget (256 MiB)");
static_assert((size_t)MHALF * DFF * 2 <= (size_t)MT * IN1 * 2, "hidden half fits R1");
constexpr int LDS_BYTES = 131072 + 4096;

__device__ __forceinline__ int opaque_tid() { int t = threadIdx.x; asm volatile("" : "+v"(t)); return t; }
namespace pg8 {
#define PG8_LAS __attribute__((address_space(3)))
typedef unsigned short bf16_t;
typedef short bf16x8 __attribute__((ext_vector_type(8)));
typedef float f32x4 __attribute__((ext_vector_type(4)));
typedef unsigned u32x4 __attribute__((ext_vector_type(4)));
constexpr int BM = 256, BK = 64, HALF = 128, HTB = HALF * BK * 2  , STAGE_BYTES = 8 * HTB, NXCD = 8, WGM = 8;

__host__ __device__ __forceinline__ int lds_byte(int r, int c) { const int st = (r >> 4) * 2 + (c >> 5), rr = r & 15, cc = c & 31, ob = rr * 64 + cc * 2; return st * 1024 + (ob ^ (((ob >> 9) & 1) << 5)); }
__host__ __device__ __forceinline__ void stage_rc(int b, int& R, int& C) { const int st = b / 1024, sb = b % 1024, swz = sb ^ (((sb >> 9) & 1) << 5); R = (st >> 1) * 16 + swz / 64; C = (st & 1) * 32 + (swz % 64) / 2; }
__host__ __device__ __forceinline__ int perm32(int rho) { const int n = rho >> 4, i = rho & 15; return 8 * (i >> 2) + 4 * n + (i & 3); }

struct Unit { int pm, pn; };
struct Gemm { const bf16_t* A; const bf16_t* Bt; int M, N, K; };

struct StaticOrder {
    int nM, nN, nwg, G, c;
    __host__ __device__ void init(int M, int N, int G_, int c_) { nM = M / BM; nN = N / BM; nwg = nM * nN; G = G_; c = c_; }
    __host__ __device__ bool next(int i, Unit& u) const {
        const long L = (long)i * G + c; if (L >= nwg) return false;
        int wgid = (int)L; { const int q = nwg / NXCD, r = nwg % NXCD, xcd = wgid % NXCD, off = wgid / NXCD; wgid = (xcd < r ? xcd * (q + 1) : r * (q + 1) + (xcd - r) * q) + off; }
        const int nig = WGM * nN, gid = wgid / nig, fm = gid * WGM, gsz = (nM - fm) < WGM ? (nM - fm) : WGM;
        u.pm = fm + ((wgid % nig) % gsz); u.pn = (wgid % nig) / gsz; return true;
    }
    __device__ __forceinline__ void a_ready(const Unit&) const {}
    __device__ __forceinline__ void done(const Unit&) const {}
};
__device__ __forceinline__ unsigned cvt_pk_bf16(float lo, float hi) { unsigned r; asm volatile("v_cvt_pk_bf16_f32 %0, %1, %2" : "=v"(r) : "v"(lo), "v"(hi)); return r; }
typedef float f32x2 __attribute__((ext_vector_type(2)));
typedef unsigned u32x2 __attribute__((ext_vector_type(2)));
struct EpiInProj0 {
    static constexpr bool PERM = false, AFTER_DRAIN = false;
    bf16_t* O; float* newk; float* newv;
    __device__ __forceinline__ void operator()(const f32x4 (&acc)[2][2][4][2], const Unit& u, int wr, int wc, int fr, int fq) const {
        const int t = u.pn >> 1;
        bf16_t* base = O + (size_t)t * ((size_t)MT * 512);
        const int colt = (u.pn & 1) * 256 + wc * 32 + 4 * fq;
        const bool rope = (t <= 1) && (u.pm >= MP / 256);
        float* f32o = (u.pm < MP / 256) ? (t == 1 ? newk : (t == 2 ? newv : nullptr)) : nullptr;
        float inv[4];
#pragma unroll
        for (int e = 0; e < 4; ++e) inv[e] = __builtin_amdgcn_exp2f(-(float)(4 * fq + e) * (13.287712379549449f / 16.0f));
#pragma unroll
        for (int ai = 0; ai < 2; ++ai)
#pragma unroll
            for (int m = 0; m < 4; ++m) {
                const int row = u.pm * BM + ai * HALF + wr * 64 + m * 16 + fr;
                f32x4 v[2][2];
#pragma unroll
                for (int bj = 0; bj < 2; ++bj) { v[bj][0] = acc[ai][bj][m][0]; v[bj][1] = acc[ai][bj][m][1]; }
                if (rope) {
                    const int tok = (row - MP) & 4095; const float pos = (float)((wc & 1) ? (tok & 63) : (tok >> 6));
                    f32x4 cs, sn;
#pragma unroll
                    for (int e = 0; e < 4; ++e) { const float a = pos * inv[e]; cs[e] = __cosf(a); sn[e] = __sinf(a); }
#pragma unroll
                    for (int bj = 0; bj < 2; ++bj) { const f32x4 x1 = v[bj][0], x2 = v[bj][1]; v[bj][0] = x1 * cs - x2 * sn; v[bj][1] = x1 * sn + x2 * cs; }
                }
                bf16_t* rowp = base + (size_t)row * 512 + colt;
#pragma unroll
                for (int bj = 0; bj < 2; ++bj)
#pragma unroll
                    for (int n = 0; n < 2; ++n) { u32x2 w; w.x = cvt_pk_bf16(v[bj][n][0], v[bj][n][1]); w.y = cvt_pk_bf16(v[bj][n][2], v[bj][n][3]); *(u32x2*)(rowp + bj * HALF + n * 16) = w; }
                if (f32o) { float* fp = f32o + (size_t)row * 512 + colt;
#pragma unroll
                    for (int bj = 0; bj < 2; ++bj)
#pragma unroll
                        for (int n = 0; n < 2; ++n) *(f32x4*)(fp + bj * HALF + n * 16) = v[bj][n]; }
            }
    }
};
struct EpiResid {
    static constexpr bool PERM = false, AFTER_DRAIN = false;
    const float* xp; const float* xs; float* out; const float* gate; int pm_off;
    __device__ __forceinline__ void operator()(const f32x4 (&acc)[2][2][4][2], const Unit& u, int wr, int wc, int fr, int fq) const {
        const int pm = u.pm + pm_off; const int cond = pm < MP / 256 ? 0 : 1 + ((pm - MP / 256) >> 4);
        const int col0 = u.pn * BM + wc * 32 + 4 * fq; const float* g = gate + (size_t)cond * MODW + col0;
        f32x4 gv[2][2];
#pragma unroll
        for (int bj = 0; bj < 2; ++bj)
#pragma unroll
            for (int n = 0; n < 2; ++n) gv[bj][n] = *(const f32x4*)(g + bj * HALF + n * 16);
#pragma unroll
        for (int ai = 0; ai < 2; ++ai)
#pragma unroll
            for (int m = 0; m < 4; ++m) {
                const int row = pm * BM + ai * HALF + wr * 64 + m * 16 + fr;
                const float* xin = (row < MP ? xp + (size_t)row * DM : xs + (size_t)(row - MP) * DM) + col0; float* op = out + (size_t)row * DM + col0;
#pragma unroll
                for (int bj = 0; bj < 2; ++bj)
#pragma unroll
                    for (int n = 0; n < 2; ++n) { const f32x4 x = *(const f32x4*)(xin + bj * HALF + n * 16); *(f32x4*)(op + bj * HALF + n * 16) = x * ALPHA_F + gv[bj][n] * acc[ai][bj][m][n]; }
            }
    }
};
template <int ACT> struct EpiAct {
    static constexpr bool PERM = true, AFTER_DRAIN = false;
    bf16_t* O; int ldc;
    __device__ __forceinline__ void operator()(const f32x4 (&acc)[2][2][4][2], const Unit& u, int wr, int wc, int fr, int fq) const {
        const int row0 = u.pm * BM + wr * 64 + fr; const int col0 = u.pn * BM + wc * 32 + 8 * fq;
#pragma unroll
        for (int ai = 0; ai < 2; ++ai)
#pragma unroll
            for (int m = 0; m < 4; ++m) { bf16_t* rowp = O + (size_t)(row0 + ai * HALF + m * 16) * ldc + col0;
#pragma unroll
                for (int bj = 0; bj < 2; ++bj) { f32x4 v0 = acc[ai][bj][m][0], v1 = acc[ai][bj][m][1];
                    if (ACT == 1) { v0 = __builtin_elementwise_max(v0, (f32x4){0.f, 0.f, 0.f, 0.f}); v1 = __builtin_elementwise_max(v1, (f32x4){0.f, 0.f, 0.f, 0.f}); v0 = v0 * v0; v1 = v1 * v1; }
                    u32x4 w; w.x = cvt_pk_bf16(v0[0], v0[1]); w.y = cvt_pk_bf16(v0[2], v0[3]); w.z = cvt_pk_bf16(v1[0], v1[1]); w.w = cvt_pk_bf16(v1[2], v1[3]);
                    *(u32x4*)(rowp + bj * HALF) = w; } }
    }
};
template <class Epi, class Sched, bool ALIGN_EPI = false, bool SP2 = false>
__device__ __forceinline__ void gemm_phase(PG8_LAS unsigned char* lds, const Gemm g, const Sched& S, const Epi& E) {
    const int tid = opaque_tid(), wid = __builtin_amdgcn_readfirstlane(tid >> 6), lane = tid & 63, wr = wid >> 2, wc = wid & 3, fr = lane & 15, fq = lane >> 4;
    const int K = g.K, nt = K / BK;
    unsigned voffA[2], voffB[2];
#pragma unroll
    for (int i = 0; i < 2; ++i) { int R, C; stage_rc(tid * 16 + i * 8192, R, C); const int Rb = Epi::PERM ? ((R & ~31) + perm32(R & 31)) : R;
        voffA[i] = (unsigned)(R * K + C) * 2u; voffB[i] = (unsigned)(Rb * K + C) * 2u; }
    const size_t kstep = (size_t)(BK * 2);
    const size_t hstep = (size_t)HALF * K * 2;
    const size_t tstep = 2 * hstep;
    const unsigned ldsw = (unsigned)wid * 1024u;
    const int aoff = lds_byte(wr * 64 + fr, fq * 8), boff = lds_byte(wc * 32 + fr, fq * 8);
#define PG8_SA(b, h) (((b) * 2 + (h)) * HTB)
#define PG8_SB(b, h) ((4 + (b) * 2 + (h)) * HTB)
#define PG8_STAGE(bufoff, gbase, voff) do { _Pragma("unroll") for (int _i = 0; _i < 2; ++_i) \
        __builtin_amdgcn_global_load_lds((const unsigned*)((const char*)(gbase) + (voff)[_i]), (PG8_LAS unsigned*)(lds + (bufoff) + ldsw + _i * 8192), 16, 0, 0); } while (0)
#define PG8_LDA(dst, b, h) do { _Pragma("unroll") for (int m = 0; m < 4; ++m) _Pragma("unroll") for (int k = 0; k < 2; ++k) dst[m][k] = *(const PG8_LAS bf16x8*)(lds + PG8_SA(b, h) + aoff + m * 2048 + k * 1024); } while (0)
#define PG8_LDB(dst, b, h) do { _Pragma("unroll") for (int n = 0; n < 2; ++n) _Pragma("unroll") for (int k = 0; k < 2; ++k) dst[n][k] = *(const PG8_LAS bf16x8*)(lds + PG8_SB(b, h) + boff + n * 2048 + k * 1024); } while (0)
#define PG8_MMA(ai, bj, At, Bt) do { __builtin_amdgcn_s_setprio(1); _Pragma("unroll") for (int m = 0; m < 4; ++m) _Pragma("unroll") for (int n = 0; n < 2; ++n) _Pragma("unroll") for (int k = 0; k < 2; ++k) \
        acc[ai][bj][m][n] = __builtin_amdgcn_mfma_f32_16x16x32_bf16(Bt[n][k], At[m][k], acc[ai][bj][m][n], 0, 0, 0); __builtin_amdgcn_s_setprio(0); } while (0)
#define PG8_WAIT_V(n) asm volatile("s_waitcnt vmcnt(" #n ")" ::: "memory")
#define PG8_WAIT_L(n) asm volatile("s_waitcnt lgkmcnt(" #n ")" ::: "memory")
#define PG8_BAR __builtin_amdgcn_s_barrier()
#define PG8_SCHED __builtin_amdgcn_sched_barrier(0)
    Unit cur, nxt; int ui = 0;
    if (!S.next(0, cur)) return;
    f32x4 acc[2][2][4][2];
#pragma unroll
    for (int a = 0; a < 2; ++a)
#pragma unroll
        for (int b = 0; b < 2; ++b)
#pragma unroll
            for (int m = 0; m < 4; ++m)
#pragma unroll
                for (int n = 0; n < 2; ++n) acc[a][b][m][n] = (f32x4){0.f, 0.f, 0.f, 0.f};
    bf16x8 At[4][2], B0[2][2], B1[2][2];
    const char* cA = (const char*)g.A + (size_t)cur.pm * tstep; const char* cB = (const char*)g.Bt + (size_t)cur.pn * tstep;
    S.a_ready(cur);
    if constexpr (SP2) {
        PG8_STAGE(PG8_SB(0, 0), cB, voffB); PG8_STAGE(PG8_SB(0, 1), cB + hstep, voffB); PG8_STAGE(PG8_SA(0, 0), cA, voffA); PG8_STAGE(PG8_SA(0, 1), cA + hstep, voffA);
        if (wr == 1) PG8_BAR;
        PG8_WAIT_V(2); PG8_BAR;
        PG8_STAGE(PG8_SB(1, 0), cB + kstep, voffB); PG8_STAGE(PG8_SA(1, 0), cA + kstep, voffA); PG8_STAGE(PG8_SB(1, 1), cB + hstep + kstep, voffB);
        PG8_WAIT_V(6); PG8_BAR;
    } else {
        PG8_STAGE(PG8_SB(0, 0), cB, voffB); PG8_STAGE(PG8_SA(0, 0), cA, voffA); PG8_STAGE(PG8_SB(0, 1), cB + hstep, voffB); PG8_STAGE(PG8_SA(0, 1), cA + hstep, voffA);
        if (wr == 1) PG8_BAR;
        PG8_WAIT_V(4); PG8_BAR;
        PG8_STAGE(PG8_SB(1, 0), cB + kstep, voffB); PG8_STAGE(PG8_SA(1, 0), cA + kstep, voffA); PG8_STAGE(PG8_SB(1, 1), cB + hstep + kstep, voffB);
        PG8_WAIT_V(6); PG8_BAR;
    }
    for (;;) {
        const bool has_next = S.next(ui + 1, nxt);
        const char* nA = has_next ? (const char*)g.A + (size_t)nxt.pm * tstep : cA; const char* nB = has_next ? (const char*)g.Bt + (size_t)nxt.pn * tstep : cB;
        for (int t = 0; t < nt; t += 2) {
            const bool last = (t == nt - 2);
            const char* a1 = cA + (size_t)(t + 1) * kstep;
            const char* a2 = last ? nA : cA + (size_t)(t + 2) * kstep; const char* b2 = last ? nB : cB + (size_t)(t + 2) * kstep;
            const char* a3 = a2 + kstep; const char* b3 = b2 + kstep;
            if (last && has_next) S.a_ready(nxt);
            if constexpr (SP2) {
            PG8_LDB(B0, 0, 0); PG8_LDB(B1, 0, 1); PG8_SCHED; PG8_LDA(At, 0, 0); PG8_STAGE(PG8_SA(1, 1), a1 + hstep, voffA);
            PG8_WAIT_V(8); PG8_WAIT_L(0); PG8_BAR; PG8_MMA(0, 0, At, B0); PG8_MMA(0, 1, At, B1); PG8_BAR; PG8_SCHED;
            PG8_LDA(At, 0, 1); PG8_STAGE(PG8_SB(0, 0), b2, voffB); PG8_STAGE(PG8_SB(0, 1), b2 + hstep, voffB); PG8_STAGE(PG8_SA(0, 0), a2, voffA);
            PG8_WAIT_V(8); PG8_WAIT_L(0); PG8_BAR; PG8_MMA(1, 0, At, B0); PG8_MMA(1, 1, At, B1); PG8_BAR; PG8_SCHED;
            PG8_LDB(B0, 1, 0); PG8_LDB(B1, 1, 1); PG8_SCHED; PG8_LDA(At, 1, 0); PG8_STAGE(PG8_SA(0, 1), a2 + hstep, voffA);
            PG8_WAIT_V(8); PG8_WAIT_L(0); PG8_BAR; PG8_MMA(0, 0, At, B0); PG8_MMA(0, 1, At, B1); PG8_BAR; PG8_SCHED;
            PG8_LDA(At, 1, 1); PG8_STAGE(PG8_SB(1, 0), b3, voffB); PG8_STAGE(PG8_SB(1, 1), b3 + hstep, voffB); PG8_STAGE(PG8_SA(1, 0), a3, voffA);
            PG8_WAIT_V(8); PG8_WAIT_L(0); PG8_BAR; PG8_MMA(1, 0, At, B0); PG8_MMA(1, 1, At, B1); PG8_BAR; PG8_SCHED;
            } else {
            PG8_LDB(B0, 0, 0); PG8_SCHED; PG8_LDA(At, 0, 0); PG8_STAGE(PG8_SA(1, 1), a1 + hstep, voffA);
            PG8_WAIT_L(8); PG8_BAR; PG8_WAIT_L(0); PG8_MMA(0, 0, At, B0); PG8_BAR; PG8_SCHED;
            PG8_LDB(B1, 0, 1); PG8_STAGE(PG8_SB(0, 0), b2, voffB);
            PG8_BAR; PG8_WAIT_L(0); PG8_MMA(0, 1, At, B1); PG8_BAR;
            PG8_LDA(At, 0, 1); PG8_STAGE(PG8_SA(0, 0), a2, voffA);
            PG8_BAR; PG8_WAIT_L(0); PG8_MMA(1, 0, At, B0); PG8_BAR; PG8_SCHED;
            PG8_STAGE(PG8_SB(0, 1), b2 + hstep, voffB);
            PG8_WAIT_V(6); PG8_BAR; PG8_MMA(1, 1, At, B1); PG8_BAR;
            PG8_LDB(B0, 1, 0); PG8_SCHED; PG8_LDA(At, 1, 0); PG8_STAGE(PG8_SA(0, 1), a2 + hstep, voffA);
            PG8_WAIT_L(8); PG8_BAR; PG8_WAIT_L(0); PG8_MMA(0, 0, At, B0); PG8_BAR; PG8_SCHED;
            PG8_LDB(B1, 1, 1); PG8_STAGE(PG8_SB(1, 0), b3, voffB);
            PG8_BAR; PG8_WAIT_L(0); PG8_MMA(0, 1, At, B1); PG8_BAR;
            PG8_LDA(At, 1, 1); PG8_STAGE(PG8_SA(1, 0), a3, voffA);
            PG8_BAR; PG8_WAIT_L(0); PG8_MMA(1, 0, At, B0); PG8_BAR; PG8_SCHED;
            PG8_STAGE(PG8_SB(1, 1), b3 + hstep, voffB);
            PG8_WAIT_V(6); PG8_BAR; PG8_MMA(1, 1, At, B1); PG8_BAR;
            }
        }
        if constexpr (ALIGN_EPI) { if (wr == 0) PG8_BAR; }
        if constexpr (!Epi::AFTER_DRAIN) { E(acc, cur, wr, wc, fr, fq); S.done(cur); }
        if (!has_next) break;
#pragma unroll
        for (int a = 0; a < 2; ++a)
#pragma unroll
            for (int b = 0; b < 2; ++b)
#pragma unroll
                for (int m = 0; m < 4; ++m)
#pragma unroll
                    for (int n = 0; n < 2; ++n) acc[a][b][m][n] = (f32x4){0.f, 0.f, 0.f, 0.f};
        cur = nxt; cA = nA; cB = nB; ++ui;
        if constexpr (ALIGN_EPI) { if (wr == 1) PG8_BAR; }
    }
    PG8_WAIT_V(0);
    if constexpr (!ALIGN_EPI) { if (wr == 0) PG8_BAR; }
    PG8_BAR;
    if constexpr (Epi::AFTER_DRAIN) { E.fused(acc, cur, wr, wc, fr, fq, lds, wid, lane); S.done(cur); }
#undef PG8_SA
#undef PG8_SB
#undef PG8_STAGE
#undef PG8_LDA
#undef PG8_LDB
#undef PG8_MMA
#undef PG8_WAIT_V
#undef PG8_WAIT_L
#undef PG8_BAR
#undef PG8_SCHED
}
}
namespace att {
using bf16x8 = __attribute__((ext_vector_type(8))) short;
using s16x4  = __attribute__((ext_vector_type(4))) short;
using f32x16 = __attribute__((ext_vector_type(16))) float;
using u32x4  = __attribute__((ext_vector_type(4))) unsigned;
typedef unsigned short bf16_t;
constexpr float SCALE = 0.125f;
constexpr float THR = 8.f;
constexpr int SHM_V = 64 * 128 * 2, SHM_K = 64 * 64 * 2;
constexpr int LDS_ATT = 2 * SHM_V + 2 * SHM_K + 8 * 64 * 4;
#define KSWZ(row, colB) ((row) * 128 + ((colB) ^ ((((row) >> 1) & 7) << 4)))
#define SBAR() __builtin_amdgcn_sched_barrier(0)
__device__ __forceinline__ int crow(int r, int hi) { return (r & 3) + 8 * (r >> 2) + 4 * hi; }
__device__ __forceinline__ unsigned cvtpk(float lo, float hi) { unsigned r; asm volatile("v_cvt_pk_bf16_f32 %0, %1, %2" : "=v"(r) : "v"(lo), "v"(hi)); return r; }

__device__ __forceinline__ void partialSM(f32x16& p0, f32x16& p1, float& m_reg, float& mn, float& alpha) {
  constexpr float C = SCALE * 1.4426950408889634f;
  float pmax = p0[0];
#pragma unroll
  for (int r = 1; r < 16; ++r) pmax = fmaxf(pmax, p0[r]);
#pragma unroll
  for (int r = 0; r < 16; ++r) pmax = fmaxf(pmax, p1[r]);
  { auto rr = __builtin_amdgcn_permlane32_swap(__float_as_uint(pmax), __float_as_uint(pmax), false, false);
    pmax = fmaxf(__uint_as_float(rr[0]), __uint_as_float(rr[1])); }
  if (__builtin_expect(__all(pmax - m_reg <= THR / SCALE), 1)) { mn = m_reg; alpha = 1.f; }
  else { mn = fmaxf(m_reg, pmax); alpha = __builtin_amdgcn_exp2f((m_reg - mn) * C); m_reg = mn; }
  float mnC = -mn * C;
#pragma unroll
  for (int r = 0; r < 16; ++r) p0[r] = fmaf(p0[r], C, mnC);
#pragma unroll
  for (int r = 0; r < 16; ++r) p1[r] = fmaf(p1[r], C, mnC);
#pragma unroll
  for (int r = 0; r < 16; ++r) p0[r] = __builtin_amdgcn_exp2f(p0[r]);
}
__device__ __forceinline__ void finishSM(f32x16& p0, f32x16& p1, float alpha, float& l_reg, bf16x8& pa0, bf16x8& pa1, bf16x8& pa2, bf16x8& pa3) {
#pragma unroll
  for (int r = 0; r < 16; ++r) p1[r] = __builtin_amdgcn_exp2f(p1[r]);
  float ps = 0;
#pragma unroll
  for (int r = 0; r < 16; ++r) ps += p0[r];
#pragma unroll
  for (int r = 0; r < 16; ++r) ps += p1[r];
  { auto rr = __builtin_amdgcn_permlane32_swap(__float_as_uint(ps), __float_as_uint(ps), false, false);
    ps = __uint_as_float(rr[0]) + __uint_as_float(rr[1]); }
  l_reg = l_reg * alpha + ps;
#define PK4(P, BASE, OUT) do { unsigned a0 = cvtpk(P[BASE + 0], P[BASE + 1]), a1 = cvtpk(P[BASE + 2], P[BASE + 3]);   \
    unsigned b0 = cvtpk(P[BASE + 4], P[BASE + 5]), b1 = cvtpk(P[BASE + 6], P[BASE + 7]);                              \
    auto r0 = __builtin_amdgcn_permlane32_swap(a0, b0, false, false); auto r1 = __builtin_amdgcn_permlane32_swap(a1, b1, false, false); \
    u32x4 w = {r0[0], r1[0], r0[1], r1[1]}; OUT = *reinterpret_cast<bf16x8*>(&w); } while (0)
  PK4(p0, 0, pa0); PK4(p0, 8, pa1); PK4(p1, 0, pa2); PK4(p1, 8, pa3);
#undef PK4
}
__device__ __forceinline__ void qkt(f32x16& p0, f32x16& p1, const char* Ks, const bf16x8* qr, int r32, int hi) {
  p0 = f32x16{}; p1 = f32x16{};
#pragma unroll
  for (int d0 = 0; d0 < 4; ++d0) { int cb = (d0 * 16 + hi * 8) * 2;
    bf16x8 b0 = *reinterpret_cast<const bf16x8*>(Ks + KSWZ(r32, cb));
    bf16x8 b1 = *reinterpret_cast<const bf16x8*>(Ks + KSWZ(32 + r32, cb));
    p0 = __builtin_amdgcn_mfma_f32_32x32x16_bf16(b0, qr[d0], p0, 0, 0, 0);
    p1 = __builtin_amdgcn_mfma_f32_32x32x16_bf16(b1, qr[d0], p1, 0, 0, 0); }
}
__device__ __forceinline__ int v_st(int k, int c) { const int kk = (k & ~0xC) | ((k & 4) << 1) | ((k & 8) >> 1); return ((kk >> 3) * 4 + (c >> 5)) * 512 + ((kk & 7) * 32 + (c & 31)) * 2; }
__device__ __forceinline__ int v_rd_base(int lane) { return ((lane & 3) << 3) | (((lane >> 2) & 3) << 6) | (((lane >> 4) & 1) << 5) | (((lane >> 5) & 1) << 8); }
constexpr int v_rd_off(int d0, int ks, int half) { return d0 * 512 + ks * 4096 + half * 2048; }
template <int OFF> __device__ __forceinline__ s16x4 tr_read(int vb) {
  s16x4 r; asm volatile("ds_read_b64_tr_b16 %0, %1 offset:%2" : "=&v"(r) : "v"(vb), "i"(OFF) : "memory"); return r;
}
template <int D0> __device__ __forceinline__ void pv_one(f32x16& od, int vb, bf16x8 pa0, bf16x8 pa1, bf16x8 pa2, bf16x8 pa3) {
  const s16x4 l0 = tr_read<v_rd_off(D0, 0, 0)>(vb), h0 = tr_read<v_rd_off(D0, 0, 1)>(vb), l1 = tr_read<v_rd_off(D0, 1, 0)>(vb), h1 = tr_read<v_rd_off(D0, 1, 1)>(vb);
  const s16x4 l2 = tr_read<v_rd_off(D0, 2, 0)>(vb), h2 = tr_read<v_rd_off(D0, 2, 1)>(vb), l3 = tr_read<v_rd_off(D0, 3, 0)>(vb), h3 = tr_read<v_rd_off(D0, 3, 1)>(vb);
  asm volatile("s_waitcnt lgkmcnt(0)" ::: "memory"); SBAR();
#define PK(L, H) (bf16x8){L[0], L[1], L[2], L[3], H[0], H[1], H[2], H[3]}
  od = __builtin_amdgcn_mfma_f32_32x32x16_bf16(pa0, PK(l0, h0), od, 0, 0, 0);
  od = __builtin_amdgcn_mfma_f32_32x32x16_bf16(pa1, PK(l1, h1), od, 0, 0, 0);
  od = __builtin_amdgcn_mfma_f32_32x32x16_bf16(pa2, PK(l2, h2), od, 0, 0, 0);
  od = __builtin_amdgcn_mfma_f32_32x32x16_bf16(pa3, PK(l3, h3), od, 0, 0, 0);
#undef PK
}
__device__ __forceinline__ void pv_d0(f32x16* o, int vb, bf16x8 pa0, bf16x8 pa1, bf16x8 pa2, bf16x8 pa3) {
  pv_one<0>(o[0], vb, pa0, pa1, pa2, pa3); pv_one<1>(o[1], vb, pa0, pa1, pa2, pa3); pv_one<2>(o[2], vb, pa0, pa1, pa2, pa3); pv_one<3>(o[3], vb, pa0, pa1, pa2, pa3);
}

__device__ __forceinline__ void attn_half(f32x16 (&o)[4], const bf16_t* __restrict__ Qw, const bf16_t* __restrict__ Kc, const bf16_t* __restrict__ Vc,
                                          const bf16_t* __restrict__ Kn, const bf16_t* __restrict__ Vn, int ncache, int NT, char* lds) {
  const int tid = opaque_tid(), wid = tid >> 6, lane = tid & 63, r32 = lane & 31, hi = lane >> 5;
  char* V_lds = lds; char* K_lds = lds + 2 * SHM_V;
  float* wsf = (float*)(lds + 2 * SHM_V + 2 * SHM_K) + wid * 64; float* li_l = wsf; float* al_l = wsf + 32;
  float m_reg = -1e30f, l_reg = 0; bf16x8 qr[4];
#pragma unroll
  for (int d = 0; d < 4; ++d) o[d] = f32x16{};
#pragma unroll
  for (int d0 = 0; d0 < 4; ++d0) qr[d0] = *reinterpret_cast<const bf16x8*>(Qw + d0 * 16);
  const int sr = tid >> 4, sc = (tid & 15) * 8, vst0 = v_st(sr, sc), vst1 = v_st(32 + sr, sc);
  const int kr = tid >> 3, kc = (tid & 7) * 8, kst = KSWZ(kr, kc * 2);
  const int vb0 = (int)(uintptr_t)V_lds + v_rd_base(lane);
  struct { bf16x8 vs0, vs1, ks0; } sr_[2];
#define TPTR(jt, PC, PN) ((jt) < ncache ? (PC) + (size_t)(jt) * (64 * 512) : (PN) + (size_t)((jt) - ncache) * (64 * 512))
#define SLOAD(i, jt) do { const bf16_t* vt_ = TPTR(jt, Vc, Vn); const bf16_t* kt_ = TPTR(jt, Kc, Kn); \
    sr_[i].vs0 = *reinterpret_cast<const bf16x8*>(vt_ + (size_t)sr * 512 + sc); sr_[i].vs1 = *reinterpret_cast<const bf16x8*>(vt_ + (size_t)(32 + sr) * 512 + sc); \
    sr_[i].ks0 = *reinterpret_cast<const bf16x8*>(kt_ + (size_t)kr * 512 + kc); } while (0)
#define SWRITE(b, i) do { *(bf16x8*)(V_lds + (b) * SHM_V + vst0) = sr_[i].vs0; *(bf16x8*)(V_lds + (b) * SHM_V + vst1) = sr_[i].vs1; \
    *(bf16x8*)(K_lds + (b) * SHM_K + kst) = sr_[i].ks0; } while (0)
#define SWAIT() asm volatile("s_waitcnt vmcnt(3)" ::: "memory")
#define RESC(a) do { if (__any((a) < 1.f)) { if (hi == 0) al_l[r32] = (a); asm volatile("s_waitcnt lgkmcnt(0)" ::: "memory"); \
    _Pragma("unroll") for (int d = 0; d < 4; ++d) _Pragma("unroll") for (int r = 0; r < 16; ++r) o[d][r] *= al_l[crow(r, hi)]; } } while (0)
  f32x16 pA0, pA1, pB0, pB1; float mnA, mnB, alA, alB; bf16x8 pa0, pa1, pa2, pa3;
  constexpr int SE = 0, SO = 1;
  __syncthreads();
  SLOAD(SE, 0); asm volatile("s_waitcnt vmcnt(0)" ::: "memory"); SWRITE(0, SE); __syncthreads();
  qkt(pA0, pA1, K_lds, qr, r32, hi); partialSM(pA0, pA1, m_reg, mnA, alA);
  SLOAD(SO, 1); if (2 < NT) SLOAD(SE, 2);
  SWAIT(); SWRITE(1, SO); __syncthreads();
  for (int j = 1; j + 1 < NT; j += 2) {
    SBAR(); qkt(pB0, pB1, K_lds + SHM_K, qr, r32, hi);
    finishSM(pA0, pA1, alA, l_reg, pa0, pa1, pa2, pa3); SBAR();
    SLOAD(SO, j + 2); SBAR();
    pv_d0(o, vb0, pa0, pa1, pa2, pa3); partialSM(pB0, pB1, m_reg, mnB, alB);
    __syncthreads(); SWAIT(); SWRITE(0, SE);
    RESC(alB); __syncthreads();
    SBAR(); qkt(pA0, pA1, K_lds, qr, r32, hi);
    finishSM(pB0, pB1, alB, l_reg, pa0, pa1, pa2, pa3); SBAR();
    if (j + 3 < NT) SLOAD(SE, j + 3); SBAR();
    pv_d0(o, vb0 + SHM_V, pa0, pa1, pa2, pa3); partialSM(pA0, pA1, m_reg, mnA, alA);
    __syncthreads(); SWAIT(); SWRITE(1, SO);
    RESC(alA); __syncthreads();
  }
  SBAR(); qkt(pB0, pB1, K_lds + SHM_K, qr, r32, hi);
  finishSM(pA0, pA1, alA, l_reg, pa0, pa1, pa2, pa3); SBAR();
  pv_d0(o, vb0, pa0, pa1, pa2, pa3); partialSM(pB0, pB1, m_reg, mnB, alB);
  __syncthreads(); RESC(alB);
  finishSM(pB0, pB1, alB, l_reg, pa0, pa1, pa2, pa3); SBAR();
  pv_d0(o, vb0 + SHM_V, pa0, pa1, pa2, pa3);
  if (hi == 0) li_l[r32] = l_reg; asm volatile("s_waitcnt lgkmcnt(0)" ::: "memory");
#pragma unroll
  for (int r = 0; r < 16; ++r) { const float rl = __builtin_amdgcn_rcpf(li_l[crow(r, hi)]);
#pragma unroll
    for (int d = 0; d < 4; ++d) o[d][r] *= rl; }
#undef TPTR
#undef SLOAD
#undef SWRITE
#undef SWAIT
#undef RESC
}
}
typedef unsigned short bf16_t;
typedef float f32x4v __attribute__((ext_vector_type(4)));
typedef float f32x2v __attribute__((ext_vector_type(2)));
typedef unsigned u32x4v __attribute__((ext_vector_type(4)));
typedef unsigned u32x2v __attribute__((ext_vector_type(2)));
typedef short bf16x8v __attribute__((ext_vector_type(8)));
using att::f32x16;
#define LDS_WAIT() asm volatile("s_waitcnt lgkmcnt(0)" ::: "memory")
__device__ __forceinline__ unsigned pk2(float lo, float hi) { return pg8::cvt_pk_bf16(lo, hi); }
__device__ __forceinline__ float bf_lo(unsigned w) { return __uint_as_float(w << 16); }
__device__ __forceinline__ float bf_hi(unsigned w) { return __uint_as_float(w & 0xffff0000u); }
__device__ __forceinline__ float wave_sum(float v) {
#pragma unroll
    for (int o = 1; o < 64; o <<= 1) v += __shfl_xor(v, o);
    return v;
}
struct Args { const float* in[34]; float* out; unsigned char* ws; int ph_lo, ph_hi; };

__device__ __forceinline__ void p0_transpose_item(const float* __restrict__ W, int K, int N, bf16_t* __restrict__ WT, float* scr, int item, int lane) {
    const int nblk = N / 32, kb = item / nblk, nb = item % nblk, k0 = 64 * kb, n0 = 32 * nb;
#pragma unroll 8
    for (int i = 0; i < 32; ++i) { const int kk = 2 * i + (lane >> 5); scr[kk * 33 + (lane & 31)] = W[(size_t)(k0 + kk) * N + n0 + (lane & 31)]; }
    LDS_WAIT(); asm volatile("" ::: "memory");
    const int c = lane & 7;
#pragma unroll
    for (int j = 0; j < 4; ++j) { const int n = (lane >> 3) + 8 * j; const float* s = scr + (8 * c) * 33 + n;
        u32x4v o; o.x = pk2(s[0 * 33], s[1 * 33]); o.y = pk2(s[2 * 33], s[3 * 33]); o.z = pk2(s[4 * 33], s[5 * 33]); o.w = pk2(s[6 * 33], s[7 * 33]);
        *(u32x4v*)(WT + (size_t)(n0 + n) * K + k0 + 8 * c) = o; }
    LDS_WAIT(); asm volatile("" ::: "memory");
}
__device__ __forceinline__ void p0_adaln_item(const Args& a, int item, float* silu_tab  , int lane) {
    const int layer = item / 48, blk = item % 48, j0 = blk * 128 + 2 * lane;
    const float* wm = a.in[layer ? 23 : 6]; const float* bm = a.in[layer ? 24 : 7];
    for (int i = lane; i < NCOND * DM; i += 64) { const int c = i >> 10, k = i & 1023; const float x = c == 0 ? a.in[5][k] : a.in[4][(c - 1) * DM + k]; silu_tab[i] = x / (1.f + __expf(-x)); }
    LDS_WAIT(); asm volatile("" ::: "memory");
    f32x2v acc[NCOND];
#pragma unroll
    for (int c = 0; c < NCOND; ++c) acc[c] = (f32x2v){0.f, 0.f};
    for (int k = 0; k < DM; k += 8) {
        f32x2v w[8];
#pragma unroll
        for (int u = 0; u < 8; ++u) w[u] = *(const f32x2v*)(wm + (size_t)(k + u) * MODW + j0);
#pragma unroll
        for (int u = 0; u < 8; ++u)
#pragma unroll
            for (int c = 0; c < NCOND; ++c) acc[c] += w[u] * silu_tab[c * DM + k + u];
    }
    const f32x2v bv = *(const f32x2v*)(bm + j0);
    float* mod = (float*)(a.ws + WS_MOD) + (size_t)layer * NCOND * MODW;
#pragma unroll
    for (int c = 0; c < NCOND; ++c) *(f32x2v*)(mod + (size_t)c * MODW + j0) = acc[c] + bv;
    LDS_WAIT(); asm volatile("" ::: "memory");
}
__device__ __forceinline__ int row_cond(int row) { return row < MP ? 0 : 1 + ((row - MP) >> 12); }
__device__ __forceinline__ const float* x_in_row(const Args& a, int row) { return row < MP ? a.in[0] + (size_t)row * DM : a.in[1] + (size_t)(row - MP) * DM; }

__device__ __forceinline__ void p0_prologue(const Args& a, char* lds) {
    const int tid = opaque_tid(), wid = tid >> 6, lane = tid & 63, G = gridDim.x;
    float* scr = (float*)(lds + wid * 8704);
    if (wid == 0 && blockIdx.x < 96) p0_adaln_item(a, blockIdx.x, (float*)(lds + 73728), lane);
    const int gw = blockIdx.x * 8 + wid, NGW = G * 8;
    constexpr int I_IN0 = 16 * (IN0 / 32), I_OUT = 16 * 32, I_FF1 = 16 * (DFF / 32), I_FF2 = 64 * 32, I_IN1 = 16 * (IN1 / 32);
    constexpr int NITEMS = I_IN0 + I_OUT + I_FF1 + I_FF2 + I_IN1 + I_OUT + I_FF1 + I_FF2;
    for (int it = gw; it < NITEMS; it += NGW) {
        int r = it;
        if (r < I_IN0) { p0_transpose_item(a.in[8], DM, IN0, (bf16_t*)(a.ws + WS_WIN0), scr, r, lane); continue; } r -= I_IN0;
        if (r < I_OUT) { p0_transpose_item(a.in[16], DM, DM, (bf16_t*)(a.ws + WS_WOUT0), scr, r, lane); continue; } r -= I_OUT;
        if (r < I_FF1) { p0_transpose_item(a.in[19], DM, DFF, (bf16_t*)(a.ws + WS_WFF1_0), scr, r, lane); continue; } r -= I_FF1;
        if (r < I_FF2) { p0_transpose_item(a.in[20], DFF, DM, (bf16_t*)(a.ws + WS_WFF2_0), scr, r, lane); continue; } r -= I_FF2;
        if (r < I_IN1) { p0_transpose_item(a.in[25], DM, IN1, (bf16_t*)(a.ws + WS_WIN1), scr, r, lane); continue; } r -= I_IN1;
        if (r < I_OUT) { p0_transpose_item(a.in[27], DM, DM, (bf16_t*)(a.ws + WS_WOUT1), scr, r, lane); continue; } r -= I_OUT;
        if (r < I_FF1) { p0_transpose_item(a.in[30], DM, DFF, (bf16_t*)(a.ws + WS_WFF1_1), scr, r, lane); continue; } r -= I_FF1;
        p0_transpose_item(a.in[31], DFF, DM, (bf16_t*)(a.ws + WS_WFF2_1), scr, r, lane);
    }
    for (int i = blockIdx.x * 512 + tid; i < 2 * 131072 / 2; i += G * 512) {
        const bool isk = i < 65536; const int j = isk ? i : i - 65536;
        const float* src = (isk ? a.in[2] : a.in[3]) + (size_t)j * 8;
        const f32x4v x0 = *(const f32x4v*)src, x1 = *(const f32x4v*)(src + 4);
        u32x4v o; o.x = pk2(x0[0], x0[1]); o.y = pk2(x0[2], x0[3]); o.z = pk2(x1[0], x1[1]); o.w = pk2(x1[2], x1[3]);
        *(u32x4v*)((bf16_t*)(a.ws + (isk ? WS_CK : WS_CV)) + (size_t)j * 8) = o;
    }
    if (blockIdx.x == G - 1 && wid == 7) {
        const float s1 = wave_sum(a.in[9][lane] * a.in[10][lane]), s2 = wave_sum(a.in[11][lane] * a.in[12][lane]);
        if (lane == 0) ((float*)(a.ws + WS_MOD))[2 * NCOND * MODW] = __expf(s1) - __expf(s2) + LAMBDA_INIT;
    }
}
__device__ __forceinline__ void p_modulate0(const Args& a) {
    const int tid = opaque_tid(), wid = tid >> 6, lane = tid & 63;
    const float* mod = (const float*)(a.ws + WS_MOD); bf16_t* HB = (bf16_t*)(a.ws + WS_HB);
    for (int row = blockIdx.x * 8 + wid; row < MT; row += gridDim.x * 8) {
        const float* xr = x_in_row(a, row) + 4 * lane; const float* mc = mod + (size_t)row_cond(row) * MODW + 4 * lane;
        unsigned long long* o8 = (unsigned long long*)(HB + (size_t)row * DM) + lane;
#pragma unroll
        for (int j = 0; j < 4; ++j) { const f32x4v x = *(const f32x4v*)(xr + 256 * j), sh = *(const f32x4v*)(mc + 256 * j), sc = *(const f32x4v*)(mc + DM + 256 * j);
            const f32x4v h = x * (sc + 1.f) + sh; o8[64 * j] = (unsigned long long)pk2(h[0], h[1]) | ((unsigned long long)pk2(h[2], h[3]) << 32); }
    }
}
template <bool WRITE_H>
__device__ __forceinline__ void p_layernorm(float* X, const float* __restrict__ g, const float* __restrict__ b, const float* __restrict__ modn, bf16_t* HB) {
    const int tid = opaque_tid(), wid = tid >> 6, lane = tid & 63;
    for (int row = blockIdx.x * 8 + wid; row < MT; row += gridDim.x * 8) {
        float* xr = X + (size_t)row * DM + 4 * lane;
        f32x4v v[4]; float s = 0.f;
#pragma unroll
        for (int j = 0; j < 4; ++j) { v[j] = *(const f32x4v*)(xr + 256 * j); s += (v[j][0] + v[j][1]) + (v[j][2] + v[j][3]); }
        const float mean = wave_sum(s) * (1.f / DM); float s2 = 0.f;
#pragma unroll
        for (int j = 0; j < 4; ++j) { v[j] = v[j] - mean; s2 += (v[j][0] * v[j][0] + v[j][1] * v[j][1]) + (v[j][2] * v[j][2] + v[j][3] * v[j][3]); }
        const float rstd = 1.f / sqrtf(wave_sum(s2) * (1.f / DM) + LN_EPS_F);
        const float* mc = WRITE_H ? modn + (size_t)row_cond(row) * MODW + 4 * lane : nullptr;
        unsigned long long* o8 = WRITE_H ? (unsigned long long*)(HB + (size_t)row * DM) + lane : nullptr;
#pragma unroll
        for (int j = 0; j < 4; ++j) { const f32x4v gg = *(const f32x4v*)(g + 4 * lane + 256 * j), bb = *(const f32x4v*)(b + 4 * lane + 256 * j);
            const f32x4v y = v[j] * rstd * gg + bb; *(f32x4v*)(xr + 256 * j) = y;
            if (WRITE_H) { const f32x4v sh = *(const f32x4v*)(mc + 256 * j), sc = *(const f32x4v*)(mc + DM + 256 * j); const f32x4v h = y * (sc + 1.f) + sh;
                o8[64 * j] = (unsigned long long)pk2(h[0], h[1]) | ((unsigned long long)pk2(h[2], h[3]) << 32); } }
    }
}
__device__ __forceinline__ void p_conv(const Args& a) {
    const int tid = opaque_tid(), wid = tid >> 6, lane = tid & 63;
    const bf16_t* R = (const bf16_t*)(a.ws + WS_R1); bf16_t* MIX = (bf16_t*)(a.ws + WS_HB); const float* cw = a.in[26];
    for (int row = blockIdx.x * 8 + wid; row < MT; row += gridDim.x * 8) {
        const int pos = row < MP ? (row & 255) : ((row - MP) & 4095), len = row < MP ? 256 : 4096;
        const bool hasl = pos > 0, hasr = pos < len - 1;
#pragma unroll
        for (int j = 0; j < 2; ++j) {
            const int c8 = (lane + 64 * j) * 8; const bf16_t* p = R + (size_t)row * IN1 + c8;
            const u32x4v bg = *(const u32x4v*)p, c1 = *(const u32x4v*)(p + 1024), x1 = *(const u32x4v*)(p + 2048);
            u32x4v c0 = {0, 0, 0, 0}, x0 = c0, c2 = c0, x2 = c0;
            if (hasl) { c0 = *(const u32x4v*)(p - IN1 + 1024); x0 = *(const u32x4v*)(p - IN1 + 2048); }
            if (hasr) { c2 = *(const u32x4v*)(p + IN1 + 1024); x2 = *(const u32x4v*)(p + IN1 + 2048); }
            const f32x4v w0a = *(const f32x4v*)(cw + c8), w0b = *(const f32x4v*)(cw + c8 + 4), w1a = *(const f32x4v*)(cw + DM + c8), w1b = *(const f32x4v*)(cw + DM + c8 + 4),
                         w2a = *(const f32x4v*)(cw + 2 * DM + c8), w2b = *(const f32x4v*)(cw + 2 * DM + c8 + 4);
            u32x4v o;
#pragma unroll
            for (int e = 0; e < 4; ++e) {
                const float w0l = e < 2 ? w0a[2 * e] : w0b[2 * e - 4], w0h = e < 2 ? w0a[2 * e + 1] : w0b[2 * e - 3];
                const float w1l = e < 2 ? w1a[2 * e] : w1b[2 * e - 4], w1h = e < 2 ? w1a[2 * e + 1] : w1b[2 * e - 3];
                const float w2l = e < 2 ? w2a[2 * e] : w2b[2 * e - 4], w2h = e < 2 ? w2a[2 * e + 1] : w2b[2 * e - 3];
                const float yl = bf_lo(c0[e]) * bf_lo(x0[e]) * w0l + bf_lo(c1[e]) * bf_lo(x1[e]) * w1l + bf_lo(c2[e]) * bf_lo(x2[e]) * w2l;
                const float yh = bf_hi(c0[e]) * bf_hi(x0[e]) * w0h + bf_hi(c1[e]) * bf_hi(x1[e]) * w1h + bf_hi(c2[e]) * bf_hi(x2[e]) * w2h;
                o[e] = pk2(bf_lo(bg[e]) * yl, bf_hi(bg[e]) * yh);
            }
            *(u32x4v*)(MIX + (size_t)row * DM + c8) = o;
        }
    }
}
__device__ __forceinline__ void p_attention(const Args& a, char* lds) {
    const int tid = opaque_tid(), wid = tid >> 6, lane = tid & 63, r32 = lane & 31, hi = lane >> 5;
    const bf16_t* QB = (const bf16_t*)(a.ws + WS_R1); const bf16_t* KB = QB + (size_t)MT * 512; const bf16_t* VB = KB + (size_t)MT * 512;
    const bf16_t* CK = (const bf16_t*)(a.ws + WS_CK); const bf16_t* CV = (const bf16_t*)(a.ws + WS_CV);
    bf16_t* MIX = (bf16_t*)(a.ws + WS_HB);
    const float lam = ((const float*)(a.ws + WS_MOD))[2 * NCOND * MODW];
    float* o0s = a.out + (((size_t)blockIdx.x * 8 + wid) * 64 + lane) * 64;
    const float* subg = a.in[13];
    for (int ui = blockIdx.x; ui < 256 + 128; ui += gridDim.x) {
        int qrow0, h, ncache, NT; const bf16_t *Kc, *Vc, *Kn, *Vn;
        if (ui < 256) {
            const int xcd = ui & 7, slot = ui >> 3, bh = xcd * 2 + (slot >> 4), qb = slot & 15, b = bh >> 2; h = bh & 3;
            qrow0 = MP + b * 4096 + qb * 256; ncache = 4; NT = 68;
            Kc = CK + (size_t)(b * 256) * 512; Vc = CV + (size_t)(b * 256) * 512; Kn = KB + (size_t)(MP + b * 4096) * 512; Vn = VB + (size_t)(MP + b * 4096) * 512;
        } else { const int p = ui - 256, b = p >> 2; h = p & 3; qrow0 = b * 256; ncache = 0; NT = 4;
            Kn = KB + (size_t)(b * 256) * 512; Vn = VB + (size_t)(b * 256) * 512; Kc = Kn; Vc = Vn; }
        const bf16_t* Qw = QB + (size_t)(qrow0 + wid * 32 + r32) * 512 + h * 128 + hi * 8;
        f32x16 o[4];
        att::attn_half(o, Qw, Kc + h * 128, Vc + h * 128, Kn + h * 128, Vn + h * 128, ncache, NT, lds);
        { float* op = o0s; asm volatile("" : "+v"(op));
#pragma unroll
        for (int d = 0; d < 4; ++d)
#pragma unroll
            for (int r4 = 0; r4 < 4; ++r4) *(f32x4v*)(op + d * 16 + r4 * 4) = (f32x4v){o[d][4 * r4], o[d][4 * r4 + 1], o[d][4 * r4 + 2], o[d][4 * r4 + 3]}; }
        att::attn_half(o, Qw + 64, Kc + h * 128 + 64, Vc + h * 128, Kn + h * 128 + 64, Vn + h * 128, ncache, NT, lds);
        float ss[16];
#pragma unroll
        for (int r = 0; r < 16; ++r) ss[r] = 0.f;
        int hi_ = hi; const float* op = o0s; asm volatile("" : "+v"(op), "+v"(hi_));
#pragma unroll
        for (int d = 0; d < 4; ++d)
#pragma unroll
            for (int r4 = 0; r4 < 4; ++r4) { const f32x4v o0 = *(const f32x4v*)(op + d * 16 + r4 * 4);
#pragma unroll
                for (int e = 0; e < 4; ++e) { const int r = 4 * r4 + e; const float v = o0[e] - lam * o[d][r]; o[d][r] = v; ss[r] += v * v; } }
#pragma unroll
        for (int r = 0; r < 16; ++r) { float s = ss[r]; s += __shfl_xor(s, 1); s += __shfl_xor(s, 2); s += __shfl_xor(s, 4); s += __shfl_xor(s, 8); s += __shfl_xor(s, 16);
            ss[r] = (1.f - LAMBDA_INIT) / sqrtf(s * (1.f / 128.f) + LN_EPS_F); }
        bf16_t* mo = MIX + (size_t)(qrow0 + wid * 32) * DM + h * 128 + r32;
#pragma unroll
        for (int d = 0; d < 4; ++d) { const float gd = subg[d * 32 + r32];
#pragma unroll
            for (int r = 0; r < 16; ++r) { const float v = o[d][r] * ss[r] * gd; mo[(size_t)att::crow(r, hi_) * DM + d * 32] = (bf16_t)(pk2(v, v) & 0xffffu); } }
    }
}
__device__ __forceinline__ void p_sgu(const Args& a, char* lds) {
    const int tid = opaque_tid(), wid = tid >> 6, lane = tid & 63, r32 = lane & 31, hi = lane >> 5, G = gridDim.x;
    const bf16_t* UB = (const bf16_t*)(a.ws + WS_R1) + (size_t)3 * MT * 512; const bf16_t* GB = UB + (size_t)MT * 512;
    bf16_t* MIX = (bf16_t*)(a.ws + WS_HB);
    const float* sw = a.in[14]; const float* sb = a.in[15];
    bf16_t* Wl = (bf16_t*)lds; bf16_t* VT = (bf16_t*)(lds + 34816);
    int u0, nu; if (G == 256) { if ((int)blockIdx.x < 128) { u0 = blockIdx.x * 2; nu = 2; } else { u0 = 256 + (blockIdx.x - 128) * 4; nu = 4; } } else { u0 = 0; nu = 0; }
    for (int k = 0; (G == 256) ? (k < nu) : ((int)blockIdx.x + k * G < 768); ++k) {
        const int su = (G == 256) ? u0 + k : (int)blockIdx.x + k * G;
        const int chunk = su >> 2, g = su & 3, row0 = chunk * 128;
        __syncthreads();
        for (int it = 0; it < 8; ++it) { const int idx = (it * 512 + tid) * 4, p = idx >> 7, q = idx & 127;
            const f32x4v w = *(const f32x4v*)(sw + (size_t)g * 16384 + idx);
            u32x2v o; o.x = pk2(w[0], w[1]); o.y = pk2(w[2], w[3]); *(u32x2v*)(Wl + p * 136 + q) = o; }
#pragma unroll
        for (int it = 0; it < 4; ++it) { const int tok = wid * 16 + it * 4 + (lane >> 4), d0 = (lane & 15) * 8;
            const u32x4v x = *(const u32x4v*)(GB + (size_t)(row0 + tok) * 512 + g * 128 + d0);
            float f[8];
#pragma unroll
            for (int e = 0; e < 4; ++e) { f[2 * e] = bf_lo(x[e]); f[2 * e + 1] = bf_hi(x[e]); }
            float s = 0.f;
#pragma unroll
            for (int e = 0; e < 8; ++e) s += f[e];
            s += __shfl_xor(s, 1); s += __shfl_xor(s, 2); s += __shfl_xor(s, 4); s += __shfl_xor(s, 8);
            const float mean = s * (1.f / 128.f); float q2 = 0.f;
#pragma unroll
            for (int e = 0; e < 8; ++e) { f[e] -= mean; q2 += f[e] * f[e]; }
            q2 += __shfl_xor(q2, 1); q2 += __shfl_xor(q2, 2); q2 += __shfl_xor(q2, 4); q2 += __shfl_xor(q2, 8);
            const float rstd = 1.f / sqrtf(q2 * (1.f / 128.f) + LN_EPS_F);
#pragma unroll
            for (int e = 0; e < 8; ++e) VT[(d0 + e) * 136 + tok] = (bf16_t)(pk2(f[e] * rstd, 0.f) & 0xffffu);
        }
        __syncthreads();
        const int pbase = (wid & 3) * 32, dbase = (wid >> 2) * 64;
        f32x16 acc[2] = {f32x16{}, f32x16{}};
#pragma unroll
        for (int ks = 0; ks < 8; ++ks) {
            const bf16x8v bw = *(const bf16x8v*)(Wl + (pbase + r32) * 136 + ks * 16 + hi * 8);
#pragma unroll
            for (int ds = 0; ds < 2; ++ds) { const bf16x8v av = *(const bf16x8v*)(VT + (dbase + ds * 32 + r32) * 136 + ks * 16 + hi * 8);
                acc[ds] = __builtin_amdgcn_mfma_f32_32x32x16_bf16(av, bw, acc[ds], 0, 0, 0); }
        }
        const int p = pbase + r32; const float bias = sb[g * 128 + p];
        const bf16_t* up = UB + (size_t)(row0 + p) * 512 + g * 128; bf16_t* mo = MIX + (size_t)(row0 + p) * DM + 512 + g * 128;
#pragma unroll
        for (int ds = 0; ds < 2; ++ds)
#pragma unroll
            for (int rq = 0; rq < 4; ++rq) { const int d = dbase + ds * 32 + 8 * rq + 4 * hi;
                const u32x2v uu = *(const u32x2v*)(up + d);
                u32x2v o; o.x = pk2(bf_lo(uu.x) * (acc[ds][4 * rq] + bias), bf_hi(uu.x) * (acc[ds][4 * rq + 1] + bias));
                o.y = pk2(bf_lo(uu.y) * (acc[ds][4 * rq + 2] + bias), bf_hi(uu.y) * (acc[ds][4 * rq + 3] + bias));
                *(u32x2v*)(mo + d) = o; }
    }
}
constexpr int NPHASE = 20;
#ifndef PHMASK
#define PHMASK 0xfffff
#endif
#define PM(i) ((PHMASK >> (i)) & 1)
__global__ void __launch_bounds__(512, 2) mega_fwd(Args a) {
    extern __shared__ __attribute__((aligned(16))) unsigned char lds_raw[];
    char* lds = (char*)lds_raw;
    PG8_LAS unsigned char* glds = (PG8_LAS unsigned char*)lds_raw;
    cg::grid_group grid = cg::this_grid();
    const int lo = a.ph_lo, hi = a.ph_hi, G = gridDim.x, bx = blockIdx.x;
    float* const mod = (float*)(a.ws + WS_MOD);
    float* const X = a.out;
    bf16_t* const HB = (bf16_t*)(a.ws + WS_HB);
    bf16_t* const R1 = (bf16_t*)(a.ws + WS_R1);
#define IN(k) (lo <= (k) && (k) < hi)
#define SEAM(k) do { if (IN(k) && IN((k) + 1)) grid.sync(); } while (0)
    int ph = 0;
    if (PM(0) && IN(ph)) p0_prologue(a, lds);
    SEAM(ph); ++ph;
    if (PM(1) && IN(ph)) p_modulate0(a);
    SEAM(ph); ++ph;
#pragma unroll 1
    for (int layer = 0; layer < 2; ++layer) {
        const float* lmod = mod + (size_t)layer * NCOND * MODW;
        const bf16_t* w_in = (const bf16_t*)(a.ws + (layer ? WS_WIN1 : WS_WIN0)); const bf16_t* w_out = (const bf16_t*)(a.ws + (layer ? WS_WOUT1 : WS_WOUT0));
        const bf16_t* w_ff1 = (const bf16_t*)(a.ws + (layer ? WS_WFF1_1 : WS_WFF1_0)); const bf16_t* w_ff2 = (const bf16_t*)(a.ws + (layer ? WS_WFF2_1 : WS_WFF2_0));
        const float* g_mix = a.in[layer ? 28 : 17]; const float* b_mix = a.in[layer ? 29 : 18]; const float* g_ff = a.in[layer ? 32 : 21]; const float* b_ff = a.in[layer ? 33 : 22];
        if (IN(ph)) {
            if (PM(2) && layer == 0) { pg8::Gemm g{HB, w_in, MT, IN0, DM}; pg8::StaticOrder S; S.init(MT, IN0, G, bx);
                pg8::EpiInProj0 E{R1, a.out + (size_t)MT * DM, a.out + (size_t)MT * DM + (size_t)MP * 512};
                pg8::gemm_phase<pg8::EpiInProj0, pg8::StaticOrder, true, true>(glds, g, S, E);
            } else if (PM(3) && layer == 1) { pg8::Gemm g{HB, w_in, MT, IN1, DM}; pg8::StaticOrder S; S.init(MT, IN1, G, bx);
                pg8::EpiAct<0> E{R1, IN1};
                pg8::gemm_phase<pg8::EpiAct<0>, pg8::StaticOrder, true, true>(glds, g, S, E); }
        }
        SEAM(ph); ++ph;
        if (IN(ph)) { if (layer == 0) { if (PM(4)) p_attention(a, lds); if (PM(5)) p_sgu(a, lds); } else if (PM(6)) p_conv(a); }
        SEAM(ph); ++ph;
        if (PM(7) && IN(ph)) { pg8::Gemm g{HB, w_out, MT, DM, DM}; pg8::StaticOrder S; S.init(MT, DM, G, bx);
            pg8::EpiResid E{layer == 0 ? a.in[0] : X, layer == 0 ? a.in[1] : X + (size_t)MP * DM, X, lmod + 2 * DM, 0};
            pg8::gemm_phase<pg8::EpiResid, pg8::StaticOrder, true, true>(glds, g, S, E); }
        SEAM(ph); ++ph;
        if (PM(8) && IN(ph)) p_layernorm<true>(X, g_mix, b_mix, lmod + 3 * DM, HB);
        SEAM(ph); ++ph;
#pragma unroll 1
        for (int half = 0; half < 2; ++half) {
            if (PM(9) && IN(ph)) { pg8::Gemm g{HB + (size_t)half * MHALF * DM, w_ff1, MHALF, DFF, DM}; pg8::StaticOrder S; S.init(MHALF, DFF, G, bx);
                pg8::EpiAct<1> E{R1, DFF};
                pg8::gemm_phase<pg8::EpiAct<1>, pg8::StaticOrder, true, true>(glds, g, S, E); }
            SEAM(ph); ++ph;
            if (PM(10) && IN(ph)) { pg8::Gemm g{R1, w_ff2, MHALF, DM, DFF}; pg8::StaticOrder S; S.init(MHALF, DM, G, bx);
                pg8::EpiResid E{X, X + (size_t)MP * DM, X, lmod + 5 * DM, half * (MHALF / 256)};
                pg8::gemm_phase<pg8::EpiResid, pg8::StaticOrder, true, true>(glds, g, S, E); }
            SEAM(ph); ++ph;
        }
        if (PM(11) && IN(ph)) { if (layer == 0) p_layernorm<true>(X, g_ff, b_ff, mod + (size_t)NCOND * MODW, HB); else p_layernorm<false>(X, g_ff, b_ff, nullptr, nullptr); }
        if (layer == 0) SEAM(ph);
        ++ph;
    }
#undef IN
#undef SEAM
}

extern "C" void kernel_launch(void* const* d_in, const int* in_sizes, int n_in, void* d_out, int out_size, void* d_ws, size_t ws_size, hipStream_t stream) {
    static int ready = 0;
    if (ready == 0) {
        if (n_in != 34 || ws_size < WS_END) { fprintf(stderr, "kernel_launch: built for 34 inputs and >= %zu bytes of workspace; got n_in %d ws %zu\n", (size_t)WS_END, n_in, ws_size); ready = -1; return; }
        if (hipFuncSetAttribute((const void*)mega_fwd, hipFuncAttributeMaxDynamicSharedMemorySize, LDS_BYTES) != hipSuccess) { fprintf(stderr, "kernel_launch: hipFuncSetAttribute failed\n"); ready = -1; return; }
        int dev = 0, cus = 0, per_cu = 0;
        hipGetDevice(&dev); hipDeviceGetAttribute(&cus, hipDeviceAttributeMultiprocessorCount, dev);
        hipOccupancyMaxActiveBlocksPerMultiprocessor(&per_cu, (const void*)mega_fwd, 512, LDS_BYTES);
        if (cus * per_cu < 256) { fprintf(stderr, "kernel_launch: resident capacity %d x %d < 256 workgroups\n", cus, per_cu); ready = -1; return; }
        ready = 1;
    }
    if (ready < 0) return;
    Args a{};
    for (int i = 0; i < 34; ++i) a.in[i] = (const float*)d_in[i];
    a.out = (float*)d_out; a.ws = (unsigned char*)d_ws;
#if MK_PER_PHASE
    for (int p = 0; p < NPHASE; ++p) { a.ph_lo = p; a.ph_hi = p + 1; hipLaunchKernelGGL(mega_fwd, dim3(256), dim3(512), LDS_BYTES, stream, a); }
#else
    a.ph_lo = 0; a.ph_hi = NPHASE;
    void* args[] = {&a};
    hipError_t e = hipLaunchCooperativeKernel((const void*)mega_fwd, dim3(256), dim3(512), args, LDS_BYTES, stream);
    if (e != hipSuccess) fprintf(stderr, "cooperative launch failed: %s\n", hipGetErrorString(e));
#endif
}
```

```cpp
#include <hip/hip_runtime.h>
#include <hip/hip_cooperative_groups.h>
#include <hip/hip_bf16.h>
#include <cstdio>
#include <cstdint>
namespace cg = cooperative_groups;

#ifndef MK_PER_PHASE
#define MK_PER_PHASE 0
#endif

constexpr int DM = 1024, MP = 8192, MS = 16384, MT = MP + MS;
constexpr int NCOND = 5, MODW = 6 * DM;
constexpr int IN0 = 2560, IN1 = 3072, DFF = 4096;
constexpr float ALPHA_F = 1.4142135623730951f;
constexpr float LN_EPS_F = 1e-5f;
constexpr float LAMBDA_INIT = 0.2f;
constexpr int MHALF = MT / 2;

constexpr size_t WS_MOD  = 0;
constexpr size_t WS_CTL  = 246272;
constexpr size_t WS_CK   = 262144;
constexpr size_t WS_CV   = WS_CK + 1048576;
constexpr size_t WS_WIN0 = WS_CV + 1048576;
constexpr size_t WS_WOUT0 = WS_WIN0 + (size_t)IN0 * DM * 2;
constexpr size_t WS_WFF1_0 = WS_WOUT0 + (size_t)DM * DM * 2;
constexpr size_t WS_WFF2_0 = WS_WFF1_0 + (size_t)DFF * DM * 2;
constexpr size_t WS_WIN1 = WS_WFF2_0 + (size_t)DFF * DM * 2;
constexpr size_t WS_WOUT1 = WS_WIN1 + (size_t)IN1 * DM * 2;
constexpr size_t WS_WFF1_1 = WS_WOUT1 + (size_t)DM * DM * 2;
constexpr size_t WS_WFF2_1 = WS_WFF1_1 + (size_t)DFF * DM * 2;
constexpr size_t WS_HB   = WS_WFF2_1 + (size_t)DFF * DM * 2;
constexpr size_t WS_R1   = WS_HB + (size_t)MT * DM * 2;
constexpr size_t WS_END  = WS_R1 + (size_t)MT * IN1 * 2;
static_assert(WS_END <= 268435456ull, "workspace budget (256 MiB)");
static_assert((size_t)MHALF * DFF * 2 <= (size_t)MT * IN1 * 2, "hidden half fits R1");
constexpr int LDS_BYTES = 131072 + 4096;

__device__ __forceinline__ int opaque_tid() { int t = threadIdx.x; asm volatile("" : "+v"(t)); return t; }
namespace pg8 {
#define PG8_LAS __attribute__((address_space(3)))
typedef unsigned short bf16_t;
typedef short bf16x8 __attribute__((ext_vector_type(8)));
typedef float f32x4 __attribute__((ext_vector_type(4)));
typedef unsigned u32x4 __attribute__((ext_vector_type(4)));
constexpr int BM = 256, BK = 64, HALF = 128, HTB = HALF * BK * 2  , STAGE_BYTES = 8 * HTB, NXCD = 8, WGM = 8;

__host__ __device__ __forceinline__ int lds_byte(int r, int c) { const int st = (r >> 4) * 2 + (c >> 5), rr = r & 15, cc = c & 31, ob = rr * 64 + cc * 2; return st * 1024 + (ob ^ (((ob >> 9) & 1) << 5)); }
__host__ __device__ __forceinline__ void stage_rc(int b, int& R, int& C) { const int st = b / 1024, sb = b % 1024, swz = sb ^ (((sb >> 9) & 1) << 5); R = (st >> 1) * 16 + swz / 64; C = (st & 1) * 32 + (swz % 64) / 2; }
__host__ __device__ __forceinline__ int perm32(int rho) { const int n = rho >> 4, i = rho & 15; return 8 * (i >> 2) + 4 * n + (i & 3); }

struct Unit { int pm, pn; };
struct Gemm { const bf16_t* A; const bf16_t* Bt; int M, N, K; };

struct StaticOrder {
    int nM, nN, nwg, G, c;
    __host__ __device__ void init(int M, int N, int G_, int c_) { nM = M / BM; nN = N / BM; nwg = nM * nN; G = G_; c = c_; }
    __host__ __device__ bool next(int i, Unit& u) const {
        const long L = (long)i * G + c; if (L >= nwg) return false;
        int wgid = (int)L; { const int q = nwg / NXCD, r = nwg % NXCD, xcd = wgid % NXCD, off = wgid / NXCD; wgid = (xcd < r ? xcd * (q + 1) : r * (q + 1) + (xcd - r) * q) + off; }
        const int nig = WGM * nN, gid = wgid / nig, fm = gid * WGM, gsz = (nM - fm) < WGM ? (nM - fm) : WGM;
        u.pm = fm + ((wgid % nig) % gsz); u.pn = (wgid % nig) / gsz; return true;
    }
    __device__ __forceinline__ void a_ready(const Unit&) const {}
    __device__ __forceinline__ void done(const Unit&) const {}
};
__device__ __forceinline__ unsigned cvt_pk_bf16(float lo, float hi) { unsigned r; asm volatile("v_cvt_pk_bf16_f32 %0, %1, %2" : "=v"(r) : "v"(lo), "v"(hi)); return r; }
typedef float f32x2 __attribute__((ext_vector_type(2)));
typedef unsigned u32x2 __attribute__((ext_vector_type(2)));
struct EpiInProj0 {
    static constexpr bool PERM = false, AFTER_DRAIN = false;
    bf16_t* O; float* newk; float* newv;
    __device__ __forceinline__ void operator()(const f32x4 (&acc)[2][2][4][2], const Unit& u, int wr, int wc, int fr, int fq) const {
        const int t = u.pn >> 1;
        bf16_t* base = O + (size_t)t * ((size_t)MT * 512);
        const int colt = (u.pn & 1) * 256 + wc * 32 + 4 * fq;
        const bool rope = (t <= 1) && (u.pm >= MP / 256);
        float* f32o = (u.pm < MP / 256) ? (t == 1 ? newk : (t == 2 ? newv : nullptr)) : nullptr;
        float inv[4];
#pragma unroll
        for (int e = 0; e < 4; ++e) inv[e] = __builtin_amdgcn_exp2f(-(float)(4 * fq + e) * (13.287712379549449f / 16.0f));
#pragma unroll
        for (int ai = 0; ai < 2; ++ai)
#pragma unroll
            for (int m = 0; m < 4; ++m) {
                const int row = u.pm * BM + ai * HALF + wr * 64 + m * 16 + fr;
                f32x4 v[2][2];
#pragma unroll
                for (int bj = 0; bj < 2; ++bj) { v[bj][0] = acc[ai][bj][m][0]; v[bj][1] = acc[ai][bj][m][1]; }
                if (rope) {
                    const int tok = (row - MP) & 4095; const float pos = (float)((wc & 1) ? (tok & 63) : (tok >> 6));
                    f32x4 cs, sn;
#pragma unroll
                    for (int e = 0; e < 4; ++e) { const float a = pos * inv[e]; cs[e] = __cosf(a); sn[e] = __sinf(a); }
#pragma unroll
                    for (int bj = 0; bj < 2; ++bj) { const f32x4 x1 = v[bj][0], x2 = v[bj][1]; v[bj][0] = x1 * cs - x2 * sn; v[bj][1] = x1 * sn + x2 * cs; }
                }
                bf16_t* rowp = base + (size_t)row * 512 + colt;
#pragma unroll
                for (int bj = 0; bj < 2; ++bj)
#pragma unroll
                    for (int n = 0; n < 2; ++n) { u32x2 w; w.x = cvt_pk_bf16(v[bj][n][0], v[bj][n][1]); w.y = cvt_pk_bf16(v[bj][n][2], v[bj][n][3]); *(u32x2*)(rowp + bj * HALF + n * 16) = w; }
                if (f32o) { float* fp = f32o + (size_t)row * 512 + colt;
#pragma unroll
                    for (int bj = 0; bj < 2; ++bj)
#pragma unroll
                        for (int n = 0; n < 2; ++n) *(f32x4*)(fp + bj * HALF + n * 16) = v[bj][n]; }
            }
    }
};
struct EpiResid {
    static constexpr bool PERM = false, AFTER_DRAIN = false;
    const float* xp; const float* xs; float* out; const float* gate; int pm_off;
    __device__ __forceinline__ void operator()(const f32x4 (&acc)[2][2][4][2], const Unit& u, int wr, int wc, int fr, int fq) const {
        const int pm = u.pm + pm_off; const int cond = pm < MP / 256 ? 0 : 1 + ((pm - MP / 256) >> 4);
        const int col0 = u.pn * BM + wc * 32 + 4 * fq; const float* g = gate + (size_t)cond * MODW + col0;
        f32x4 gv[2][2];
#pragma unroll
        for (int bj = 0; bj < 2; ++bj)
#pragma unroll
            for (int n = 0; n < 2; ++n) gv[bj][n] = *(const f32x4*)(g + bj * HALF + n * 16);
#pragma unroll
        for (int ai = 0; ai < 2; ++ai)
#pragma unroll
            for (int m = 0; m < 4; ++m) {
                const int row = pm * BM + ai * HALF + wr * 64 + m * 16 + fr;
                const float* xin = (row < MP ? xp + (size_t)row * DM : xs + (size_t)(row - MP) * DM) + col0; float* op = out + (size_t)row * DM + col0;
#pragma unroll
                for (int bj = 0; bj < 2; ++bj)
#pragma unroll
                    for (int n = 0; n < 2; ++n) { const f32x4 x = *(const f32x4*)(xin + bj * HALF + n * 16); *(f32x4*)(op + bj * HALF + n * 16) = x * ALPHA_F + gv[bj][n] * acc[ai][bj][m][n]; }
            }
    }
};
template <int ACT> struct EpiAct {
    static constexpr bool PERM = true, AFTER_DRAIN = false;
    bf16_t* O; int ldc;
    __device__ __forceinline__ void operator()(const f32x4 (&acc)[2][2][4][2], const Unit& u, int wr, int wc, int fr, int fq) const {
        const int row0 = u.pm * BM + wr * 64 + fr; const int col0 = u.pn * BM + wc * 32 + 8 * fq;
#pragma unroll
        for (int ai = 0; ai < 2; ++ai)
#pragma unroll
            for (int m = 0; m < 4; ++m) { bf16_t* rowp = O + (size_t)(row0 + ai * HALF + m * 16) * ldc + col0;
#pragma unroll
                for (int bj = 0; bj < 2; ++bj) { f32x4 v0 = acc[ai][bj][m][0], v1 = acc[ai][bj][m][1];
                    if (ACT == 1) { v0 = __builtin_elementwise_max(v0, (f32x4){0.f, 0.f, 0.f, 0.f}); v1 = __builtin_elementwise_max(v1, (f32x4){0.f, 0.f, 0.f, 0.f}); v0 = v0 * v0; v1 = v1 * v1; }
                    u32x4 w; w.x = cvt_pk_bf16(v0[0], v0[1]); w.y = cvt_pk_bf16(v0[2], v0[3]); w.z = cvt_pk_bf16(v1[0], v1[1]); w.w = cvt_pk_bf16(v1[2], v1[3]);
                    *(u32x4*)(rowp + bj * HALF) = w; } }
    }
};
template <class Epi, class Sched, bool ALIGN_EPI = false, bool SP2 = false>
__device__ __forceinline__ void gemm_phase(PG8_LAS unsigned char* lds, const Gemm g, const Sched& S, const Epi& E) {
    const int tid = opaque_tid(), wid = __builtin_amdgcn_readfirstlane(tid >> 6), lane = tid & 63, wr = wid >> 2, wc = wid & 3, fr = lane & 15, fq = lane >> 4;
    const int K = g.K, nt = K / BK;
    unsigned voffA[2], voffB[2];
#pragma unroll
    for (int i = 0; i < 2; ++i) { int R, C; stage_rc(tid * 16 + i * 8192, R, C); const int Rb = Epi::PERM ? ((R & ~31) + perm32(R & 31)) : R;
        voffA[i] = (unsigned)(R * K + C) * 2u; voffB[i] = (unsigned)(Rb * K + C) * 2u; }
    const size_t kstep = (size_t)(BK * 2);
    const size_t hstep = (size_t)HALF * K * 2;
    const size_t tstep = 2 * hstep;
    const unsigned ldsw = (unsigned)wid * 1024u;
    const int aoff = lds_byte(wr * 64 + fr, fq * 8), boff = lds_byte(wc * 32 + fr, fq * 8);
#define PG8_SA(b, h) (((b) * 2 + (h)) * HTB)
#define PG8_SB(b, h) ((4 + (b) * 2 + (h)) * HTB)
#define PG8_STAGE(bufoff, gbase, voff) do { _Pragma("unroll") for (int _i = 0; _i < 2; ++_i) \
        __builtin_amdgcn_global_load_lds((const unsigned*)((const char*)(gbase) + (voff)[_i]), (PG8_LAS unsigned*)(lds + (bufoff) + ldsw + _i * 8192), 16, 0, 0); } while (0)
#define PG8_LDA(dst, b, h) do { _Pragma("unroll") for (int m = 0; m < 4; ++m) _Pragma("unroll") for (int k = 0; k < 2; ++k) dst[m][k] = *(const PG8_LAS bf16x8*)(lds + PG8_SA(b, h) + aoff + m * 2048 + k * 1024); } while (0)
#define PG8_LDB(dst, b, h) do { _Pragma("unroll") for (int n = 0; n < 2; ++n) _Pragma("unroll") for (int k = 0; k < 2; ++k) dst[n][k] = *(const PG8_LAS bf16x8*)(lds + PG8_SB(b, h) + boff + n * 2048 + k * 1024); } while (0)
#define PG8_MMA(ai, bj, At, Bt) do { __builtin_amdgcn_s_setprio(1); _Pragma("unroll") for (int m = 0; m < 4; ++m) _Pragma("unroll") for (int n = 0; n < 2; ++n) _Pragma("unroll") for (int k = 0; k < 2; ++k) \
        acc[ai][bj][m][n] = __builtin_amdgcn_mfma_f32_16x16x32_bf16(Bt[n][k], At[m][k], acc[ai][bj][m][n], 0, 0, 0); __builtin_amdgcn_s_setprio(0); } while (0)
#define PG8_WAIT_V(n) asm volatile("s_waitcnt vmcnt(" #n ")" ::: "memory")
#define PG8_WAIT_L(n) asm volatile("s_waitcnt lgkmcnt(" #n ")" ::: "memory")
#define PG8_BAR __builtin_amdgcn_s_barrier()
#define PG8_SCHED __builtin_amdgcn_sched_barrier(0)
    Unit cur, nxt; int ui = 0;
    if (!S.next(0, cur)) return;
    f32x4 acc[2][2][4][2];
#pragma unroll
    for (int a = 0; a < 2; ++a)
#pragma unroll
        for (int b = 0; b < 2; ++b)
#pragma unroll
            for (int m = 0; m < 4; ++m)
#pragma unroll
                for (int n = 0; n < 2; ++n) acc[a][b][m][n] = (f32x4){0.f, 0.f, 0.f, 0.f};
    bf16x8 At[4][2], B0[2][2], B1[2][2];
    const char* cA = (const char*)g.A + (size_t)cur.pm * tstep; const char* cB = (const char*)g.Bt + (size_t)cur.pn * tstep;
    S.a_ready(cur);
    if constexpr (SP2) {
        PG8_STAGE(PG8_SB(0, 0), cB, voffB); PG8_STAGE(PG8_SB(0, 1), cB + hstep, voffB); PG8_STAGE(PG8_SA(0, 0), cA, voffA); PG8_STAGE(PG8_SA(0, 1), cA + hstep, voffA);
        if (wr == 1) PG8_BAR;
        PG8_WAIT_V(2); PG8_BAR;
        PG8_STAGE(PG8_SB(1, 0), cB + kstep, voffB); PG8_STAGE(PG8_SA(1, 0), cA + kstep, voffA); PG8_STAGE(PG8_SB(1, 1), cB + hstep + kstep, voffB);
        PG8_WAIT_V(6); PG8_BAR;
    } else {
        PG8_STAGE(PG8_SB(0, 0), cB, voffB); PG8_STAGE(PG8_SA(0, 0), cA, voffA); PG8_STAGE(PG8_SB(0, 1), cB + hstep, voffB); PG8_STAGE(PG8_SA(0, 1), cA + hstep, voffA);
        if (wr == 1) PG8_BAR;
        PG8_WAIT_V(4); PG8_BAR;
        PG8_STAGE(PG8_SB(1, 0), cB + kstep, voffB); PG8_STAGE(PG8_SA(1, 0), cA + kstep, voffA); PG8_STAGE(PG8_SB(1, 1), cB + hstep + kstep, voffB);
        PG8_WAIT_V(6); PG8_BAR;
    }
    for (;;) {
        const bool has_next = S.next(ui + 1, nxt);
        const char* nA = has_next ? (const char*)g.A + (size_t)nxt.pm * tstep : cA; const char* nB = has_next ? (const char*)g.Bt + (size_t)nxt.pn * tstep : cB;
        for (int t = 0; t < nt; t += 2) {
            const bool last = (t == nt - 2);
            const char* a1 = cA + (size_t)(t + 1) * kstep;
            const char* a2 = last ? nA : cA + (size_t)(t + 2) * kstep; const char* b2 = last ? nB : cB + (size_t)(t + 2) * kstep;
            const char* a3 = a2 + kstep; const char* b3 = b2 + kstep;
            if (last && has_next) S.a_ready(nxt);
            if constexpr (SP2) {
            PG8_LDB(B0, 0, 0); PG8_LDB(B1, 0, 1); PG8_SCHED; PG8_LDA(At, 0, 0); PG8_STAGE(PG8_SA(1, 1), a1 + hstep, voffA);
            PG8_WAIT_V(8); PG8_WAIT_L(0); PG8_BAR; PG8_MMA(0, 0, At, B0); PG8_MMA(0, 1, At, B1); PG8_BAR; PG8_SCHED;
            PG8_LDA(At, 0, 1); PG8_STAGE(PG8_SB(0, 0), b2, voffB); PG8_STAGE(PG8_SB(0, 1), b2 + hstep, voffB); PG8_STAGE(PG8_SA(0, 0), a2, voffA);
            PG8_WAIT_V(8); PG8_WAIT_L(0); PG8_BAR; PG8_MMA(1, 0, At, B0); PG8_MMA(1, 1, At, B1); PG8_BAR; PG8_SCHED;
            PG8_LDB(B0, 1, 0); PG8_LDB(B1, 1, 1); PG8_SCHED; PG8_LDA(At, 1, 0); PG8_STAGE(PG8_SA(0, 1), a2 + hstep, voffA);
            PG8_WAIT_V(8); PG8_WAIT_L(0); PG8_BAR; PG8_MMA(0, 0, At, B0); PG8_MMA(0, 1, At, B1); PG8_BAR; PG8_SCHED;
            PG8_LDA(At, 1, 1); PG8_STAGE(PG8_SB(1, 0), b3, voffB); PG8_STAGE(PG8_SB(1, 1), b3 + hstep, voffB); PG8_STAGE(PG8_SA(1, 0), a3, voffA);
            PG8_WAIT_V(8); PG8_WAIT_L(0); PG8_BAR; PG8_MMA(1, 0, At, B0); PG8_MMA(1, 1, At, B1); PG8_BAR; PG8_SCHED;
            } else {
            PG8_LDB(B0, 0, 0); PG8_SCHED; PG8_LDA(At, 0, 0); PG8_STAGE(PG8_SA(1, 1), a1 + hstep, voffA);
            PG8_WAIT_L(8); PG8_BAR; PG8_WAIT_L(0); PG8_MMA(0, 0, At, B0); PG8_BAR; PG8_SCHED;
            PG8_LDB(B1, 0, 1); PG8_STAGE(PG8_SB(0, 0), b2, voffB);
            PG8_BAR; PG8_WAIT_L(0); PG8_MMA(0, 1, At, B1); PG8_BAR;
            PG8_LDA(At, 0, 1); PG8_STAGE(PG8_SA(0, 0), a2, voffA);
            PG8_BAR; PG8_WAIT_L(0); PG8_MMA(1, 0, At, B0); PG8_BAR; PG8_SCHED;
            PG8_STAGE(PG8_SB(0, 1), b2 + hstep, voffB);
            PG8_WAIT_V(6); PG8_BAR; PG8_MMA(1, 1, At, B1); PG8_BAR;
            PG8_LDB(B0, 1, 0); PG8_SCHED; PG8_LDA(At, 1, 0); PG8_STAGE(PG8_SA(0, 1), a2 + hstep, voffA);
            PG8_WAIT_L(8); PG8_BAR; PG8_WAIT_L(0); PG8_MMA(0, 0, At, B0); PG8_BAR; PG8_SCHED;
            PG8_LDB(B1, 1, 1); PG8_STAGE(PG8_SB(1, 0), b3, voffB);
            PG8_BAR; PG8_WAIT_L(0); PG8_MMA(0, 1, At, B1); PG8_BAR;
            PG8_LDA(At, 1, 1); PG8_STAGE(PG8_SA(1, 0), a3, voffA);
            PG8_BAR; PG8_WAIT_L(0); PG8_MMA(1, 0, At, B0); PG8_BAR; PG8_SCHED;
            PG8_STAGE(PG8_SB(1, 1), b3 + hstep, voffB);
            PG8_WAIT_V(6); PG8_BAR; PG8_MMA(1, 1, At, B1); PG8_BAR;
            }
        }
        if constexpr (ALIGN_EPI) { if (wr == 0) PG8_BAR; }
        if constexpr (!Epi::AFTER_DRAIN) { E(acc, cur, wr, wc, fr, fq); S.done(cur); }
        if (!has_next) break;
#pragma unroll
        for (int a = 0; a < 2; ++a)
#pragma unroll
            for (int b = 0; b < 2; ++b)
#pragma unroll
                for (int m = 0; m < 4; ++m)
#pragma unroll
                    for (int n = 0; n < 2; ++n) acc[a][b][m][n] = (f32x4){0.f, 0.f, 0.f, 0.f};
        cur = nxt; cA = nA; cB = nB; ++ui;
        if constexpr (ALIGN_EPI) { if (wr == 1) PG8_BAR; }
    }
    PG8_WAIT_V(0);
    if constexpr (!ALIGN_EPI) { if (wr == 0) PG8_BAR; }
    PG8_BAR;
    if constexpr (Epi::AFTER_DRAIN) { E.fused(acc, cur, wr, wc, fr, fq, lds, wid, lane); S.done(cur); }
#undef PG8_SA
#undef PG8_SB
#undef PG8_STAGE
#undef PG8_LDA
#undef PG8_LDB
#undef PG8_MMA
#undef PG8_WAIT_V
#undef PG8_WAIT_L
#undef PG8_BAR
#undef PG8_SCHED
}
}
namespace att {
using bf16x8 = __attribute__((ext_vector_type(8))) short;
using s16x4  = __attribute__((ext_vector_type(4))) short;
using f32x16 = __attribute__((ext_vector_type(16))) float;
using u32x4  = __attribute__((ext_vector_type(4))) unsigned;
typedef unsigned short bf16_t;
constexpr float SCALE = 0.125f;
constexpr float THR = 8.f;
constexpr int SHM_V = 64 * 128 * 2, SHM_K = 64 * 64 * 2;
constexpr int LDS_ATT = 2 * SHM_V + 2 * SHM_K + 8 * 64 * 4;
#define KSWZ(row, colB) ((row) * 128 + ((colB) ^ ((((row) >> 1) & 7) << 4)))
#define SBAR() __builtin_amdgcn_sched_barrier(0)
__device__ __forceinline__ int crow(int r, int hi) { return (r & 3) + 8 * (r >> 2) + 4 * hi; }
__device__ __forceinline__ unsigned cvtpk(float lo, float hi) { unsigned r; asm volatile("v_cvt_pk_bf16_f32 %0, %1, %2" : "=v"(r) : "v"(lo), "v"(hi)); return r; }

__device__ __forceinline__ void partialSM(f32x16& p0, f32x16& p1, float& m_reg, float& mn, float& alpha) {
  constexpr float C = SCALE * 1.4426950408889634f;
  float pmax = p0[0];
#pragma unroll
  for (int r = 1; r < 16; ++r) pmax = fmaxf(pmax, p0[r]);
#pragma unroll
  for (int r = 0; r < 16; ++r) pmax = fmaxf(pmax, p1[r]);
  { auto rr = __builtin_amdgcn_permlane32_swap(__float_as_uint(pmax), __float_as_uint(pmax), false, false);
    pmax = fmaxf(__uint_as_float(rr[0]), __uint_as_float(rr[1])); }
  if (__builtin_expect(__all(pmax - m_reg <= THR / SCALE), 1)) { mn = m_reg; alpha = 1.f; }
  else { mn = fmaxf(m_reg, pmax); alpha = __builtin_amdgcn_exp2f((m_reg - mn) * C); m_reg = mn; }
  float mnC = -mn * C;
#pragma unroll
  for (int r = 0; r < 16; ++r) p0[r] = fmaf(p0[r], C, mnC);
#pragma unroll
  for (int r = 0; r < 16; ++r) p1[r] = fmaf(p1[r], C, mnC);
#pragma unroll
  for (int r = 0; r < 16; ++r) p0[r] = __builtin_amdgcn_exp2f(p0[r]);
}
__device__ __forceinline__ void finishSM(f32x16& p0, f32x16& p1, float alpha, float& l_reg, bf16x8& pa0, bf16x8& pa1, bf16x8& pa2, bf16x8& pa3) {
#pragma unroll
  for (int r = 0; r < 16; ++r) p1[r] = __builtin_amdgcn_exp2f(p1[r]);
  float ps = 0;
#pragma unroll
  for (int r = 0; r < 16; ++r) ps += p0[r];
#pragma unroll
  for (int r = 0; r < 16; ++r) ps += p1[r];
  { auto rr = __builtin_amdgcn_permlane32_swap(__float_as_uint(ps), __float_as_uint(ps), false, false);
    ps = __uint_as_float(rr[0]) + __uint_as_float(rr[1]); }
  l_reg = l_reg * alpha + ps;
#define PK4(P, BASE, OUT) do { unsigned a0 = cvtpk(P[BASE + 0], P[BASE + 1]), a1 = cvtpk(P[BASE + 2], P[BASE + 3]);   \
    unsigned b0 = cvtpk(P[BASE + 4], P[BASE + 5]), b1 = cvtpk(P[BASE + 6], P[BASE + 7]);                              \
    auto r0 = __builtin_amdgcn_permlane32_swap(a0, b0, false, false); auto r1 = __builtin_amdgcn_permlane32_swap(a1, b1, false, false); \
    u32x4 w = {r0[0], r1[0], r0[1], r1[1]}; OUT = *reinterpret_cast<bf16x8*>(&w); } while (0)
  PK4(p0, 0, pa0); PK4(p0, 8, pa1); PK4(p1, 0, pa2); PK4(p1, 8, pa3);
#undef PK4
}
__device__ __forceinline__ void qkt(f32x16& p0, f32x16& p1, const char* Ks, const bf16x8* qr, int r32, int hi) {
  p0 = f32x16{}; p1 = f32x16{};
#pragma unroll
  for (int d0 = 0; d0 < 4; ++d0) { int cb = (d0 * 16 + hi * 8) * 2;
    bf16x8 b0 = *reinterpret_cast<const bf16x8*>(Ks + KSWZ(r32, cb));
    bf16x8 b1 = *reinterpret_cast<const bf16x8*>(Ks + KSWZ(32 + r32, cb));
    p0 = __builtin_amdgcn_mfma_f32_32x32x16_bf16(b0, qr[d0], p0, 0, 0, 0);
    p1 = __builtin_amdgcn_mfma_f32_32x32x16_bf16(b1, qr[d0], p1, 0, 0, 0); }
}
__device__ __forceinline__ int v_st(int k, int c) { const int kk = (k & ~0xC) | ((k & 4) << 1) | ((k & 8) >> 1); return ((kk >> 3) * 4 + (c >> 5)) * 512 + ((kk & 7) * 32 + (c & 31)) * 2; }
__device__ __forceinline__ int v_rd_base(int lane) { return ((lane & 3) << 3) | (((lane >> 2) & 3) << 6) | (((lane >> 4) & 1) << 5) | (((lane >> 5) & 1) << 8); }
constexpr int v_rd_off(int d0, int ks, int half) { return d0 * 512 + ks * 4096 + half * 2048; }
template <int OFF> __device__ __forceinline__ s16x4 tr_read(int vb) {
  s16x4 r; asm volatile("ds_read_b64_tr_b16 %0, %1 offset:%2" : "=&v"(r) : "v"(vb), "i"(OFF) : "memory"); return r;
}
template <int D0> __device__ __forceinline__ void pv_one(f32x16& od, int vb, bf16x8 pa0, bf16x8 pa1, bf16x8 pa2, bf16x8 pa3) {
  const s16x4 l0 = tr_read<v_rd_off(D0, 0, 0)>(vb), h0 = tr_read<v_rd_off(D0, 0, 1)>(vb), l1 = tr_read<v_rd_off(D0, 1, 0)>(vb), h1 = tr_read<v_rd_off(D0, 1, 1)>(vb);
  const s16x4 l2 = tr_read<v_rd_off(D0, 2, 0)>(vb), h2 = tr_read<v_rd_off(D0, 2, 1)>(vb), l3 = tr_read<v_rd_off(D0, 3, 0)>(vb), h3 = tr_read<v_rd_off(D0, 3, 1)>(vb);
  asm volatile("s_waitcnt lgkmcnt(0)" ::: "memory"); SBAR();
#define PK(L, H) (bf16x8){L[0], L[1], L[2], L[3], H[0], H[1], H[2], H[3]}
  od = __builtin_amdgcn_mfma_f32_32x32x16_bf16(pa0, PK(l0, h0), od, 0, 0, 0);
  od = __builtin_amdgcn_mfma_f32_32x32x16_bf16(pa1, PK(l1, h1), od, 0, 0, 0);
  od = __builtin_amdgcn_mfma_f32_32x32x16_bf16(pa2, PK(l2, h2), od, 0, 0, 0);
  od = __builtin_amdgcn_mfma_f32_32x32x16_bf16(pa3, PK(l3, h3), od, 0, 0, 0);
#undef PK
}
__device__ __forceinline__ void pv_d0(f32x16* o, int vb, bf16x8 pa0, bf16x8 pa1, bf16x8 pa2, bf16x8 pa3) {
  pv_one<0>(o[0], vb, pa0, pa1, pa2, pa3); pv_one<1>(o[1], vb, pa0, pa1, pa2, pa3); pv_one<2>(o[2], vb, pa0, pa1, pa2, pa3); pv_one<3>(o[3], vb, pa0, pa1, pa2, pa3);
}

__device__ __forceinline__ void attn_half(f32x16 (&o)[4], const bf16_t* __restrict__ Qw, const bf16_t* __restrict__ Kc, const bf16_t* __restrict__ Vc,
                                          const bf16_t* __restrict__ Kn, const bf16_t* __restrict__ Vn, int ncache, int NT, char* lds) {
  const int tid = opaque_tid(), wid = tid >> 6, lane = tid & 63, r32 = lane & 31, hi = lane >> 5;
  char* V_lds = lds; char* K_lds = lds + 2 * SHM_V;
  float* wsf = (float*)(lds + 2 * SHM_V + 2 * SHM_K) + wid * 64; float* li_l = wsf; float* al_l = wsf + 32;
  float m_reg = -1e30f, l_reg = 0; bf16x8 qr[4];
#pragma unroll
  for (int d = 0; d < 4; ++d) o[d] = f32x16{};
#pragma unroll
  for (int d0 = 0; d0 < 4; ++d0) qr[d0] = *reinterpret_cast<const bf16x8*>(Qw + d0 * 16);
  const int sr = tid >> 4, sc = (tid & 15) * 8, vst0 = v_st(sr, sc), vst1 = v_st(32 + sr, sc);
  const int kr = tid >> 3, kc = (tid & 7) * 8, kst = KSWZ(kr, kc * 2);
  const int vb0 = (int)(uintptr_t)V_lds + v_rd_base(lane);
  struct { bf16x8 vs0, vs1, ks0; } sr_[2];
#define TPTR(jt, PC, PN) ((jt) < ncache ? (PC) + (size_t)(jt) * (64 * 512) : (PN) + (size_t)((jt) - ncache) * (64 * 512))
#define SLOAD(i, jt) do { const bf16_t* vt_ = TPTR(jt, Vc, Vn); const bf16_t* kt_ = TPTR(jt, Kc, Kn); \
    sr_[i].vs0 = *reinterpret_cast<const bf16x8*>(vt_ + (size_t)sr * 512 + sc); sr_[i].vs1 = *reinterpret_cast<const bf16x8*>(vt_ + (size_t)(32 + sr) * 512 + sc); \
    sr_[i].ks0 = *reinterpret_cast<const bf16x8*>(kt_ + (size_t)kr * 512 + kc); } while (0)
#define SWRITE(b, i) do { *(bf16x8*)(V_lds + (b) * SHM_V + vst0) = sr_[i].vs0; *(bf16x8*)(V_lds + (b) * SHM_V + vst1) = sr_[i].vs1; \
    *(bf16x8*)(K_lds + (b) * SHM_K + kst) = sr_[i].ks0; } while (0)
#define SWAIT() asm volatile("s_waitcnt vmcnt(3)" ::: "memory")
#define RESC(a) do { if (__any((a) < 1.f)) { if (hi == 0) al_l[r32] = (a); asm volatile("s_waitcnt lgkmcnt(0)" ::: "memory"); \
    _Pragma("unroll") for (int d = 0; d < 4; ++d) _Pragma("unroll") for (int r = 0; r < 16; ++r) o[d][r] *= al_l[crow(r, hi)]; } } while (0)
  f32x16 pA0, pA1, pB0, pB1; float mnA, mnB, alA, alB; bf16x8 pa0, pa1, pa2, pa3;
  constexpr int SE = 0, SO = 1;
  __syncthreads();
  SLOAD(SE, 0); asm volatile("s_waitcnt vmcnt(0)" ::: "memory"); SWRITE(0, SE); __syncthreads();
  qkt(pA0, pA1, K_lds, qr, r32, hi); partialSM(pA0, pA1, m_reg, mnA, alA);
  SLOAD(SO, 1); if (2 < NT) SLOAD(SE, 2);
  SWAIT(); SWRITE(1, SO); __syncthreads();
  for (int j = 1; j + 1 < NT; j += 2) {
    SBAR(); qkt(pB0, pB1, K_lds + SHM_K, qr, r32, hi);
    finishSM(pA0, pA1, alA, l_reg, pa0, pa1, pa2, pa3); SBAR();
    SLOAD(SO, j + 2); SBAR();
    pv_d0(o, vb0, pa0, pa1, pa2, pa3); partialSM(pB0, pB1, m_reg, mnB, alB);
    __syncthreads(); SWAIT(); SWRITE(0, SE);
    RESC(alB); __syncthreads();
    SBAR(); qkt(pA0, pA1, K_lds, qr, r32, hi);
    finishSM(pB0, pB1, alB, l_reg, pa0, pa1, pa2, pa3); SBAR();
    if (j + 3 < NT) SLOAD(SE, j + 3); SBAR();
    pv_d0(o, vb0 + SHM_V, pa0, pa1, pa2, pa3); partialSM(pA0, pA1, m_reg, mnA, alA);
    __syncthreads(); SWAIT(); SWRITE(1, SO);
    RESC(alA); __syncthreads();
  }
  SBAR(); qkt(pB0, pB1, K_lds + SHM_K, qr, r32, hi);
  finishSM(pA0, pA1, alA, l_reg, pa0, pa1, pa2, pa3); SBAR();
  pv_d0(o, vb0, pa0, pa1, pa2, pa3); partialSM(pB0, pB1, m_reg, mnB, alB);
  __syncthreads(); RESC(alB);
  finishSM(pB0, pB1, alB, l_reg, pa0, pa1, pa2, pa3); SBAR();
  pv_d0(o, vb0 + SHM_V, pa0, pa1, pa2, pa3);
  if (hi == 0) li_l[r32] = l_reg; asm volatile("s_waitcnt lgkmcnt(0)" ::: "memory");
#pragma unroll
  for (int r = 0; r < 16; ++r) { const float rl = __builtin_amdgcn_rcpf(li_l[crow(r, hi)]);
#pragma unroll
    for (int d = 0; d < 4; ++d) o[d][r] *= rl; }
#undef TPTR
#undef SLOAD
#undef SWRITE
#undef SWAIT
#undef RESC
}
}
typedef unsigned short bf16_t;
typedef float f32x4v __attribute__((ext_vector_type(4)));
typedef float f32x2v __attribute__((ext_vector_type(2)));
typedef unsigned u32x4v __attribute__((ext_vector_type(4)));
typedef unsigned u32x2v __attribute__((ext_vector_type(2)));
typedef short bf16x8v __attribute__((ext_vector_type(8)));
using att::f32x16;
#define LDS_WAIT() asm volatile("s_waitcnt lgkmcnt(0)" ::: "memory")
__device__ __forceinline__ unsigned pk2(float lo, float hi) { return pg8::cvt_pk_bf16(lo, hi); }
__device__ __forceinline__ float bf_lo(unsigned w) { return __uint_as_float(w << 16); }
__device__ __forceinline__ float bf_hi(unsigned w) { return __uint_as_float(w & 0xffff0000u); }
__device__ __forceinline__ float wave_sum(float v) {
#pragma unroll
    for (int o = 1; o < 64; o <<= 1) v += __shfl_xor(v, o);
    return v;
}
#define LAS __attribute__((address_space(3)))
#define XB_TMO      128
#define XB_XCNT(j)  (256  + 64 * (j))
#define XB_XSUB(j)  (1280 + 64 * (j))
#define XB_XGEN(j)  (2304 + 64 * (j))
#define XB_TOP      3328
#define XB_TOPGEN   3392
#define XCD_BAR_WORDS 3456
#define XB_SPIN_CAP (1u << 18)

__device__ __forceinline__ unsigned xb_ld(unsigned* p)              { return __hip_atomic_load(p, __ATOMIC_RELAXED, __HIP_MEMORY_SCOPE_AGENT); }
__device__ __forceinline__ unsigned xb_add(unsigned* p, unsigned v) { return __hip_atomic_fetch_add(p, v, __ATOMIC_RELAXED, __HIP_MEMORY_SCOPE_AGENT); }
__device__ __forceinline__ unsigned xb_xcc_id() { return (unsigned)__builtin_amdgcn_s_getreg((3 << 11) | 20) & 0xFu; }
#define XB_SPIN(cond, bar) do { unsigned _sp = 0; while (cond) { __builtin_amdgcn_s_sleep(1); \
    if ((++_sp & 255u) == 0u) { if (xb_ld(&(bar)[XB_TMO])) break; if (_sp > XB_SPIN_CAP) { atomicAdd(&(bar)[XB_TMO], 1u); break; } } } } while (0)

struct XcdBarrier {
    unsigned* bar; unsigned x;
    volatile LAS unsigned* st;
};

__device__ __forceinline__ XcdBarrier xcd_barrier_post(unsigned* bar, volatile LAS unsigned* st) {
    XcdBarrier b; b.bar = bar; b.x = xb_xcc_id(); b.st = st;
    if (threadIdx.x == 0) (void)xb_add(&bar[XB_XCNT(b.x)], 1u);
    return b;
}
__device__ __forceinline__ void xcd_barrier_complete(unsigned* bar, unsigned x, unsigned& nloc, unsigned& nx) {
    const unsigned G = gridDim.x * gridDim.y * gridDim.z;
    unsigned sum, cnt, mine, sp = 0u;
    for (;;) {
        sum = 0u; cnt = 0u; mine = 0u;
#pragma unroll
        for (unsigned j = 0; j < 16; ++j) { const unsigned c = xb_ld(&bar[XB_XCNT(j)]); sum += c; cnt += (c > 0u) ? 1u : 0u; mine = (j == x) ? c : mine; }
        if (sum == G) break;
        __builtin_amdgcn_s_sleep(1);
        if ((++sp & 255u) == 0u) { if (xb_ld(&bar[XB_TMO])) break; if (sp > XB_SPIN_CAP) { atomicAdd(&bar[XB_TMO], 1u); break; } }
    }
    nloc = mine > 0u ? mine : 1u; nx = cnt > 0u ? cnt : 1u;
}

__device__ __forceinline__ void xcd_barrier(const XcdBarrier& b) {
    asm volatile("s_waitcnt vmcnt(0)" ::: "memory");
    __syncthreads();
    if (threadIdx.x == 0) {
        unsigned* bar = b.bar;
        __builtin_amdgcn_s_waitcnt(0);
        unsigned nloc = b.st[0], nx = b.st[1];
        if (nloc == 0u) { xcd_barrier_complete(bar, b.x, nloc, nx); b.st[0] = nloc; b.st[1] = nx; }
        const unsigned old = xb_add(&bar[XB_XSUB(b.x)], 1u);
        const unsigned gen = old / nloc;
        if (old + 1u == (gen + 1u) * nloc) {
            __builtin_amdgcn_fence(__ATOMIC_RELEASE, "agent");
            asm volatile("s_waitcnt vmcnt(0)" ::: "memory");
            const unsigned og = xb_add(&bar[XB_TOP], 1u);
            const unsigned tg = og / nx;
            if (og + 1u == (tg + 1u) * nx) xb_add(&bar[XB_TOPGEN], 1u);
            else XB_SPIN(xb_ld(&bar[XB_TOPGEN]) == tg, bar);
            __builtin_amdgcn_fence(__ATOMIC_ACQUIRE, "agent");
            xb_add(&bar[XB_XGEN(b.x)], 1u);
            asm volatile("s_waitcnt vmcnt(0)" ::: "memory");
        } else {
            XB_SPIN(xb_ld(&bar[XB_XGEN(b.x)]) == gen, bar);
            __builtin_amdgcn_fence(__ATOMIC_ACQUIRE, "agent");
            asm volatile("s_waitcnt vmcnt(0)" ::: "memory");
        }
    }
    __syncthreads();
}

struct Args { const float* in[34]; float* out; unsigned char* ws; int ph_lo, ph_hi; };

__device__ __forceinline__ void p0_transpose_item(const float* __restrict__ W, int K, int N, bf16_t* __restrict__ WT, float* scr, int item, int lane) {
    const int nblk = N / 32, kb = item / nblk, nb = item % nblk, k0 = 64 * kb, n0 = 32 * nb;
#pragma unroll 8
    for (int i = 0; i < 32; ++i) { const int kk = 2 * i + (lane >> 5); scr[kk * 33 + (lane & 31)] = W[(size_t)(k0 + kk) * N + n0 + (lane & 31)]; }
    LDS_WAIT(); asm volatile("" ::: "memory");
    const int c = lane & 7;
#pragma unroll
    for (int j = 0; j < 4; ++j) { const int n = (lane >> 3) + 8 * j; const float* s = scr + (8 * c) * 33 + n;
        u32x4v o; o.x = pk2(s[0 * 33], s[1 * 33]); o.y = pk2(s[2 * 33], s[3 * 33]); o.z = pk2(s[4 * 33], s[5 * 33]); o.w = pk2(s[6 * 33], s[7 * 33]);
        *(u32x4v*)(WT + (size_t)(n0 + n) * K + k0 + 8 * c) = o; }
    LDS_WAIT(); asm volatile("" ::: "memory");
}
__device__ __forceinline__ void p0_adaln_item(const Args& a, int item, float* silu_tab  , int lane) {
    const int layer = item / 48, blk = item % 48, j0 = blk * 128 + 2 * lane;
    const float* wm = a.in[layer ? 23 : 6]; const float* bm = a.in[layer ? 24 : 7];
    for (int i = lane; i < NCOND * DM; i += 64) { const int c = i >> 10, k = i & 1023; const float x = c == 0 ? a.in[5][k] : a.in[4][(c - 1) * DM + k]; silu_tab[i] = x / (1.f + __expf(-x)); }
    LDS_WAIT(); asm volatile("" ::: "memory");
    f32x2v acc[NCOND];
#pragma unroll
    for (int c = 0; c < NCOND; ++c) acc[c] = (f32x2v){0.f, 0.f};
    for (int k = 0; k < DM; k += 8) {
        f32x2v w[8];
#pragma unroll
        for (int u = 0; u < 8; ++u) w[u] = *(const f32x2v*)(wm + (size_t)(k + u) * MODW + j0);
#pragma unroll
        for (int u = 0; u < 8; ++u)
#pragma unroll
            for (int c = 0; c < NCOND; ++c) acc[c] += w[u] * silu_tab[c * DM + k + u];
    }
    const f32x2v bv = *(const f32x2v*)(bm + j0);
    float* mod = (float*)(a.ws + WS_MOD) + (size_t)layer * NCOND * MODW;
#pragma unroll
    for (int c = 0; c < NCOND; ++c) *(f32x2v*)(mod + (size_t)c * MODW + j0) = acc[c] + bv;
    LDS_WAIT(); asm volatile("" ::: "memory");
}
__device__ __forceinline__ int row_cond(int row) { return row < MP ? 0 : 1 + ((row - MP) >> 12); }
__device__ __forceinline__ const float* x_in_row(const Args& a, int row) { return row < MP ? a.in[0] + (size_t)row * DM : a.in[1] + (size_t)(row - MP) * DM; }

__device__ __forceinline__ void p0_prologue(const Args& a, char* lds) {
    const int tid = opaque_tid(), wid = tid >> 6, lane = tid & 63, G = gridDim.x;
    float* scr = (float*)(lds + wid * 8704);
    if (wid == 0 && blockIdx.x < 96) p0_adaln_item(a, blockIdx.x, (float*)(lds + 73728), lane);
    const int gw = blockIdx.x * 8 + wid, NGW = G * 8;
    constexpr int I_IN0 = 16 * (IN0 / 32), I_OUT = 16 * 32, I_FF1 = 16 * (DFF / 32), I_FF2 = 64 * 32, I_IN1 = 16 * (IN1 / 32);
    constexpr int NITEMS = I_IN0 + I_OUT + I_FF1 + I_FF2 + I_IN1 + I_OUT + I_FF1 + I_FF2;
    for (int it = gw; it < NITEMS; it += NGW) {
        int r = it;
        if (r < I_IN0) { p0_transpose_item(a.in[8], DM, IN0, (bf16_t*)(a.ws + WS_WIN0), scr, r, lane); continue; } r -= I_IN0;
        if (r < I_OUT) { p0_transpose_item(a.in[16], DM, DM, (bf16_t*)(a.ws + WS_WOUT0), scr, r, lane); continue; } r -= I_OUT;
        if (r < I_FF1) { p0_transpose_item(a.in[19], DM, DFF, (bf16_t*)(a.ws + WS_WFF1_0), scr, r, lane); continue; } r -= I_FF1;
        if (r < I_FF2) { p0_transpose_item(a.in[20], DFF, DM, (bf16_t*)(a.ws + WS_WFF2_0), scr, r, lane); continue; } r -= I_FF2;
        if (r < I_IN1) { p0_transpose_item(a.in[25], DM, IN1, (bf16_t*)(a.ws + WS_WIN1), scr, r, lane); continue; } r -= I_IN1;
        if (r < I_OUT) { p0_transpose_item(a.in[27], DM, DM, (bf16_t*)(a.ws + WS_WOUT1), scr, r, lane); continue; } r -= I_OUT;
        if (r < I_FF1) { p0_transpose_item(a.in[30], DM, DFF, (bf16_t*)(a.ws + WS_WFF1_1), scr, r, lane); continue; } r -= I_FF1;
        p0_transpose_item(a.in[31], DFF, DM, (bf16_t*)(a.ws + WS_WFF2_1), scr, r, lane);
    }
    for (int i = blockIdx.x * 512 + tid; i < 2 * 131072 / 2; i += G * 512) {
        const bool isk = i < 65536; const int j = isk ? i : i - 65536;
        const float* src = (isk ? a.in[2] : a.in[3]) + (size_t)j * 8;
        const f32x4v x0 = *(const f32x4v*)src, x1 = *(const f32x4v*)(src + 4);
        u32x4v o; o.x = pk2(x0[0], x0[1]); o.y = pk2(x0[2], x0[3]); o.z = pk2(x1[0], x1[1]); o.w = pk2(x1[2], x1[3]);
        *(u32x4v*)((bf16_t*)(a.ws + (isk ? WS_CK : WS_CV)) + (size_t)j * 8) = o;
    }
    if (blockIdx.x == G - 1 && wid == 7) {
        const float s1 = wave_sum(a.in[9][lane] * a.in[10][lane]), s2 = wave_sum(a.in[11][lane] * a.in[12][lane]);
        if (lane == 0) ((float*)(a.ws + WS_MOD))[2 * NCOND * MODW] = __expf(s1) - __expf(s2) + LAMBDA_INIT;
    }
}
__device__ __forceinline__ void p_modulate0(const Args& a) {
    const int tid = opaque_tid(), wid = tid >> 6, lane = tid & 63;
    const float* mod = (const float*)(a.ws + WS_MOD); bf16_t* HB = (bf16_t*)(a.ws + WS_HB);
    for (int row = blockIdx.x * 8 + wid; row < MT; row += gridDim.x * 8) {
        const float* xr = x_in_row(a, row) + 4 * lane; const float* mc = mod + (size_t)row_cond(row) * MODW + 4 * lane;
        unsigned long long* o8 = (unsigned long long*)(HB + (size_t)row * DM) + lane;
#pragma unroll
        for (int j = 0; j < 4; ++j) { const f32x4v x = *(const f32x4v*)(xr + 256 * j), sh = *(const f32x4v*)(mc + 256 * j), sc = *(const f32x4v*)(mc + DM + 256 * j);
            const f32x4v h = x * (sc + 1.f) + sh; o8[64 * j] = (unsigned long long)pk2(h[0], h[1]) | ((unsigned long long)pk2(h[2], h[3]) << 32); }
    }
}
template <bool WRITE_H>
__device__ __forceinline__ void p_layernorm(float* X, const float* __restrict__ g, const float* __restrict__ b, const float* __restrict__ modn, bf16_t* HB) {
    const int tid = opaque_tid(), wid = tid >> 6, lane = tid & 63;
    for (int row = blockIdx.x * 8 + wid; row < MT; row += gridDim.x * 8) {
        float* xr = X + (size_t)row * DM + 4 * lane;
        f32x4v v[4]; float s = 0.f;
#pragma unroll
        for (int j = 0; j < 4; ++j) { v[j] = *(const f32x4v*)(xr + 256 * j); s += (v[j][0] + v[j][1]) + (v[j][2] + v[j][3]); }
        const float mean = wave_sum(s) * (1.f / DM); float s2 = 0.f;
#pragma unroll
        for (int j = 0; j < 4; ++j) { v[j] = v[j] - mean; s2 += (v[j][0] * v[j][0] + v[j][1] * v[j][1]) + (v[j][2] * v[j][2] + v[j][3] * v[j][3]); }
        const float rstd = 1.f / sqrtf(wave_sum(s2) * (1.f / DM) + LN_EPS_F);
        const float* mc = WRITE_H ? modn + (size_t)row_cond(row) * MODW + 4 * lane : nullptr;
        unsigned long long* o8 = WRITE_H ? (unsigned long long*)(HB + (size_t)row * DM) + lane : nullptr;
#pragma unroll
        for (int j = 0; j < 4; ++j) { const f32x4v gg = *(const f32x4v*)(g + 4 * lane + 256 * j), bb = *(const f32x4v*)(b + 4 * lane + 256 * j);
            const f32x4v y = v[j] * rstd * gg + bb; *(f32x4v*)(xr + 256 * j) = y;
            if (WRITE_H) { const f32x4v sh = *(const f32x4v*)(mc + 256 * j), sc = *(const f32x4v*)(mc + DM + 256 * j); const f32x4v h = y * (sc + 1.f) + sh;
                o8[64 * j] = (unsigned long long)pk2(h[0], h[1]) | ((unsigned long long)pk2(h[2], h[3]) << 32); } }
    }
}
__device__ __forceinline__ void p_conv(const Args& a) {
    const int tid = opaque_tid(), wid = tid >> 6, lane = tid & 63;
    const bf16_t* R = (const bf16_t*)(a.ws + WS_R1); bf16_t* MIX = (bf16_t*)(a.ws + WS_HB); const float* cw = a.in[26];
    for (int row = blockIdx.x * 8 + wid; row < MT; row += gridDim.x * 8) {
        const int pos = row < MP ? (row & 255) : ((row - MP) & 4095), len = row < MP ? 256 : 4096;
        const bool hasl = pos > 0, hasr = pos < len - 1;
#pragma unroll
        for (int j = 0; j < 2; ++j) {
            const int c8 = (lane + 64 * j) * 8; const bf16_t* p = R + (size_t)row * IN1 + c8;
            const u32x4v bg = *(const u32x4v*)p, c1 = *(const u32x4v*)(p + 1024), x1 = *(const u32x4v*)(p + 2048);
            u32x4v c0 = {0, 0, 0, 0}, x0 = c0, c2 = c0, x2 = c0;
            if (hasl) { c0 = *(const u32x4v*)(p - IN1 + 1024); x0 = *(const u32x4v*)(p - IN1 + 2048); }
            if (hasr) { c2 = *(const u32x4v*)(p + IN1 + 1024); x2 = *(const u32x4v*)(p + IN1 + 2048); }
            const f32x4v w0a = *(const f32x4v*)(cw + c8), w0b = *(const f32x4v*)(cw + c8 + 4), w1a = *(const f32x4v*)(cw + DM + c8), w1b = *(const f32x4v*)(cw + DM + c8 + 4),
                         w2a = *(const f32x4v*)(cw + 2 * DM + c8), w2b = *(const f32x4v*)(cw + 2 * DM + c8 + 4);
            u32x4v o;
#pragma unroll
            for (int e = 0; e < 4; ++e) {
                const float w0l = e < 2 ? w0a[2 * e] : w0b[2 * e - 4], w0h = e < 2 ? w0a[2 * e + 1] : w0b[2 * e - 3];
                const float w1l = e < 2 ? w1a[2 * e] : w1b[2 * e - 4], w1h = e < 2 ? w1a[2 * e + 1] : w1b[2 * e - 3];
                const float w2l = e < 2 ? w2a[2 * e] : w2b[2 * e - 4], w2h = e < 2 ? w2a[2 * e + 1] : w2b[2 * e - 3];
                const float yl = bf_lo(c0[e]) * bf_lo(x0[e]) * w0l + bf_lo(c1[e]) * bf_lo(x1[e]) * w1l + bf_lo(c2[e]) * bf_lo(x2[e]) * w2l;
                const float yh = bf_hi(c0[e]) * bf_hi(x0[e]) * w0h + bf_hi(c1[e]) * bf_hi(x1[e]) * w1h + bf_hi(c2[e]) * bf_hi(x2[e]) * w2h;
                o[e] = pk2(bf_lo(bg[e]) * yl, bf_hi(bg[e]) * yh);
            }
            *(u32x4v*)(MIX + (size_t)row * DM + c8) = o;
        }
    }
}
__device__ __forceinline__ void p_attention(const Args& a, char* lds) {
    const int tid = opaque_tid(), wid = tid >> 6, lane = tid & 63, r32 = lane & 31, hi = lane >> 5;
    const bf16_t* QB = (const bf16_t*)(a.ws + WS_R1); const bf16_t* KB = QB + (size_t)MT * 512; const bf16_t* VB = KB + (size_t)MT * 512;
    const bf16_t* CK = (const bf16_t*)(a.ws + WS_CK); const bf16_t* CV = (const bf16_t*)(a.ws + WS_CV);
    bf16_t* MIX = (bf16_t*)(a.ws + WS_HB);
    const float lam = ((const float*)(a.ws + WS_MOD))[2 * NCOND * MODW];
    float* o0s = a.out + (((size_t)blockIdx.x * 8 + wid) * 64 + lane) * 64;
    const float* subg = a.in[13];
    for (int ui = blockIdx.x; ui < 256 + 128; ui += gridDim.x) {
        int qrow0, h, ncache, NT; const bf16_t *Kc, *Vc, *Kn, *Vn;
        if (ui < 256) {
            const int xcd = ui & 7, slot = ui >> 3, bh = xcd * 2 + (slot >> 4), qb = slot & 15, b = bh >> 2; h = bh & 3;
            qrow0 = MP + b * 4096 + qb * 256; ncache = 4; NT = 68;
            Kc = CK + (size_t)(b * 256) * 512; Vc = CV + (size_t)(b * 256) * 512; Kn = KB + (size_t)(MP + b * 4096) * 512; Vn = VB + (size_t)(MP + b * 4096) * 512;
        } else { const int p = ui - 256, b = p >> 2; h = p & 3; qrow0 = b * 256; ncache = 0; NT = 4;
            Kn = KB + (size_t)(b * 256) * 512; Vn = VB + (size_t)(b * 256) * 512; Kc = Kn; Vc = Vn; }
        const bf16_t* Qw = QB + (size_t)(qrow0 + wid * 32 + r32) * 512 + h * 128 + hi * 8;
        f32x16 o[4];
        att::attn_half(o, Qw, Kc + h * 128, Vc + h * 128, Kn + h * 128, Vn + h * 128, ncache, NT, lds);
        { float* op = o0s; asm volatile("" : "+v"(op));
#pragma unroll
        for (int d = 0; d < 4; ++d)
#pragma unroll
            for (int r4 = 0; r4 < 4; ++r4) *(f32x4v*)(op + d * 16 + r4 * 4) = (f32x4v){o[d][4 * r4], o[d][4 * r4 + 1], o[d][4 * r4 + 2], o[d][4 * r4 + 3]}; }
        att::attn_half(o, Qw + 64, Kc + h * 128 + 64, Vc + h * 128, Kn + h * 128 + 64, Vn + h * 128, ncache, NT, lds);
        float ss[16];
#pragma unroll
        for (int r = 0; r < 16; ++r) ss[r] = 0.f;
        int hi_ = hi; const float* op = o0s; asm volatile("" : "+v"(op), "+v"(hi_));
#pragma unroll
        for (int d = 0; d < 4; ++d)
#pragma unroll
            for (int r4 = 0; r4 < 4; ++r4) { const f32x4v o0 = *(const f32x4v*)(op + d * 16 + r4 * 4);
#pragma unroll
                for (int e = 0; e < 4; ++e) { const int r = 4 * r4 + e; const float v = o0[e] - lam * o[d][r]; o[d][r] = v; ss[r] += v * v; } }
#pragma unroll
        for (int r = 0; r < 16; ++r) { float s = ss[r]; s += __shfl_xor(s, 1); s += __shfl_xor(s, 2); s += __shfl_xor(s, 4); s += __shfl_xor(s, 8); s += __shfl_xor(s, 16);
            ss[r] = (1.f - LAMBDA_INIT) / sqrtf(s * (1.f / 128.f) + LN_EPS_F); }
        bf16_t* mo = MIX + (size_t)(qrow0 + wid * 32) * DM + h * 128 + r32;
#pragma unroll
        for (int d = 0; d < 4; ++d) { const float gd = subg[d * 32 + r32];
#pragma unroll
            for (int r = 0; r < 16; ++r) { const float v = o[d][r] * ss[r] * gd; mo[(size_t)att::crow(r, hi_) * DM + d * 32] = (bf16_t)(pk2(v, v) & 0xffffu); } }
    }
}
__device__ __forceinline__ void p_sgu(const Args& a, char* lds) {
    const int tid = opaque_tid(), wid = tid >> 6, lane = tid & 63, r32 = lane & 31, hi = lane >> 5, G = gridDim.x;
    const bf16_t* UB = (const bf16_t*)(a.ws + WS_R1) + (size_t)3 * MT * 512; const bf16_t* GB = UB + (size_t)MT * 512;
    bf16_t* MIX = (bf16_t*)(a.ws + WS_HB);
    const float* sw = a.in[14]; const float* sb = a.in[15];
    bf16_t* Wl = (bf16_t*)lds; bf16_t* VT = (bf16_t*)(lds + 34816);
    int u0, nu; if (G == 256) { if ((int)blockIdx.x < 128) { u0 = blockIdx.x * 2; nu = 2; } else { u0 = 256 + (blockIdx.x - 128) * 4; nu = 4; } } else { u0 = 0; nu = 0; }
    for (int k = 0; (G == 256) ? (k < nu) : ((int)blockIdx.x + k * G < 768); ++k) {
        const int su = (G == 256) ? u0 + k : (int)blockIdx.x + k * G;
        const int chunk = su >> 2, g = su & 3, row0 = chunk * 128;
        __syncthreads();
        for (int it = 0; it < 8; ++it) { const int idx = (it * 512 + tid) * 4, p = idx >> 7, q = idx & 127;
            const f32x4v w = *(const f32x4v*)(sw + (size_t)g * 16384 + idx);
            u32x2v o; o.x = pk2(w[0], w[1]); o.y = pk2(w[2], w[3]); *(u32x2v*)(Wl + p * 136 + q) = o; }
#pragma unroll
        for (int it = 0; it < 4; ++it) { const int tok = wid * 16 + it * 4 + (lane >> 4), d0 = (lane & 15) * 8;
            const u32x4v x = *(const u32x4v*)(GB + (size_t)(row0 + tok) * 512 + g * 128 + d0);
            float f[8];
#pragma unroll
            for (int e = 0; e < 4; ++e) { f[2 * e] = bf_lo(x[e]); f[2 * e + 1] = bf_hi(x[e]); }
            float s = 0.f;
#pragma unroll
            for (int e = 0; e < 8; ++e) s += f[e];
            s += __shfl_xor(s, 1); s += __shfl_xor(s, 2); s += __shfl_xor(s, 4); s += __shfl_xor(s, 8);
            const float mean = s * (1.f / 128.f); float q2 = 0.f;
#pragma unroll
            for (int e = 0; e < 8; ++e) { f[e] -= mean; q2 += f[e] * f[e]; }
            q2 += __shfl_xor(q2, 1); q2 += __shfl_xor(q2, 2); q2 += __shfl_xor(q2, 4); q2 += __shfl_xor(q2, 8);
            const float rstd = 1.f / sqrtf(q2 * (1.f / 128.f) + LN_EPS_F);
#pragma unroll
            for (int e = 0; e < 8; ++e) VT[(d0 + e) * 136 + tok] = (bf16_t)(pk2(f[e] * rstd, 0.f) & 0xffffu);
        }
        __syncthreads();
        const int pbase = (wid & 3) * 32, dbase = (wid >> 2) * 64;
        f32x16 acc[2] = {f32x16{}, f32x16{}};
#pragma unroll
        for (int ks = 0; ks < 8; ++ks) {
            const bf16x8v bw = *(const bf16x8v*)(Wl + (pbase + r32) * 136 + ks * 16 + hi * 8);
#pragma unroll
            for (int ds = 0; ds < 2; ++ds) { const bf16x8v av = *(const bf16x8v*)(VT + (dbase + ds * 32 + r32) * 136 + ks * 16 + hi * 8);
                acc[ds] = __builtin_amdgcn_mfma_f32_32x32x16_bf16(av, bw, acc[ds], 0, 0, 0); }
        }
        const int p = pbase + r32; const float bias = sb[g * 128 + p];
        const bf16_t* up = UB + (size_t)(row0 + p) * 512 + g * 128; bf16_t* mo = MIX + (size_t)(row0 + p) * DM + 512 + g * 128;
#pragma unroll
        for (int ds = 0; ds < 2; ++ds)
#pragma unroll
            for (int rq = 0; rq < 4; ++rq) { const int d = dbase + ds * 32 + 8 * rq + 4 * hi;
                const u32x2v uu = *(const u32x2v*)(up + d);
                u32x2v o; o.x = pk2(bf_lo(uu.x) * (acc[ds][4 * rq] + bias), bf_hi(uu.x) * (acc[ds][4 * rq + 1] + bias));
                o.y = pk2(bf_lo(uu.y) * (acc[ds][4 * rq + 2] + bias), bf_hi(uu.y) * (acc[ds][4 * rq + 3] + bias));
                *(u32x2v*)(mo + d) = o; }
    }
}
constexpr int NPHASE = 20;
#ifndef PHMASK
#define PHMASK 0xfffff
#endif
#define PM(i) ((PHMASK >> (i)) & 1)
#ifndef PROBE_REP
#define PROBE_REP 0
#endif
#define NREP(i) (1 + ((PROBE_REP >> (i)) & 1))
__global__ void __launch_bounds__(512, 2) mega_fwd(Args a) {
    extern __shared__ __attribute__((aligned(16))) unsigned char lds_raw[];
    char* lds = (char*)lds_raw;
    PG8_LAS unsigned char* glds = (PG8_LAS unsigned char*)lds_raw;
    cg::grid_group grid = cg::this_grid();
    volatile LAS unsigned* MISC = (volatile LAS unsigned*)(glds + 131072);
    if (threadIdx.x < 16) MISC[threadIdx.x] = 0u;
    __syncthreads();
    unsigned* const barw = (unsigned*)(a.ws + WS_CTL);
    XcdBarrier xbar; xbar.bar = barw; xbar.x = 0; xbar.st = nullptr;
    const int lo = a.ph_lo, hi = a.ph_hi, G = gridDim.x, bx = blockIdx.x;
    float* const mod = (float*)(a.ws + WS_MOD);
    float* const X = a.out;
    bf16_t* const HB = (bf16_t*)(a.ws + WS_HB);
    bf16_t* const R1 = (bf16_t*)(a.ws + WS_R1);
#define IN(k) (lo <= (k) && (k) < hi)
#define SEAM(k) do { if (IN(k) && IN((k) + 1)) { xcd_barrier(xbar); if ((PROBE_REP >> 20) & 1) xcd_barrier(xbar); } } while (0)
    int ph = 0;
    if (PM(0) && IN(ph)) p0_prologue(a, lds);
    if (IN(ph) && bx == 0) for (int i = threadIdx.x; i < XCD_BAR_WORDS; i += 512) __hip_atomic_store(barw + i, 0u, __ATOMIC_RELAXED, __HIP_MEMORY_SCOPE_AGENT);
    if (IN(ph) && IN(ph + 1)) { grid.sync();
        xbar = xcd_barrier_post(barw, MISC + 8); }
    ++ph;
    if (PM(1) && IN(ph)) p_modulate0(a);
    SEAM(ph); ++ph;
#pragma unroll 1
    for (int layer = 0; layer < 2; ++layer) {
        const float* lmod = mod + (size_t)layer * NCOND * MODW;
        const bf16_t* w_in = (const bf16_t*)(a.ws + (layer ? WS_WIN1 : WS_WIN0)); const bf16_t* w_out = (const bf16_t*)(a.ws + (layer ? WS_WOUT1 : WS_WOUT0));
        const bf16_t* w_ff1 = (const bf16_t*)(a.ws + (layer ? WS_WFF1_1 : WS_WFF1_0)); const bf16_t* w_ff2 = (const bf16_t*)(a.ws + (layer ? WS_WFF2_1 : WS_WFF2_0));
        const float* g_mix = a.in[layer ? 28 : 17]; const float* b_mix = a.in[layer ? 29 : 18]; const float* g_ff = a.in[layer ? 32 : 21]; const float* b_ff = a.in[layer ? 33 : 22];
        if (IN(ph)) {
            if (PM(2) && layer == 0) { pg8::Gemm g{HB, w_in, MT, IN0, DM}; pg8::StaticOrder S; S.init(MT, IN0, G, bx);
                pg8::EpiInProj0 E{R1, a.out + (size_t)MT * DM, a.out + (size_t)MT * DM + (size_t)MP * 512};
                pg8::gemm_phase<pg8::EpiInProj0, pg8::StaticOrder, true, true>(glds, g, S, E);
            } else if (PM(3) && layer == 1) { pg8::Gemm g{HB, w_in, MT, IN1, DM}; pg8::StaticOrder S; S.init(MT, IN1, G, bx);
                pg8::EpiAct<0> E{R1, IN1};
                pg8::gemm_phase<pg8::EpiAct<0>, pg8::StaticOrder, true, true>(glds, g, S, E); }
        }
        SEAM(ph); ++ph;
        if (IN(ph)) { if (layer == 0) { for (int rep = 0; rep < NREP(4); ++rep) { if (PM(4)) p_attention(a, lds); } for (int rep = 0; rep < NREP(5); ++rep) { if (PM(5)) p_sgu(a, lds); } } else if (PM(6)) p_conv(a); }
        SEAM(ph); ++ph;
        if (PM(7) && IN(ph)) { pg8::Gemm g{HB, w_out, MT, DM, DM}; pg8::StaticOrder S; S.init(MT, DM, G, bx);
            pg8::EpiResid E{layer == 0 ? a.in[0] : X, layer == 0 ? a.in[1] : X + (size_t)MP * DM, X, lmod + 2 * DM, 0};
            pg8::gemm_phase<pg8::EpiResid, pg8::StaticOrder, true, true>(glds, g, S, E); }
        SEAM(ph); ++ph;
        if (PM(8) && IN(ph)) p_layernorm<true>(X, g_mix, b_mix, lmod + 3 * DM, HB);
        SEAM(ph); ++ph;
#pragma unroll 1
        for (int half = 0; half < 2; ++half) {
            for (int rep = 0; rep < NREP(9); ++rep) if (PM(9) && IN(ph)) { pg8::Gemm g{HB + (size_t)half * MHALF * DM, w_ff1, MHALF, DFF, DM}; pg8::StaticOrder S; S.init(MHALF, DFF, G, bx);
                pg8::EpiAct<1> E{R1, DFF};
                pg8::gemm_phase<pg8::EpiAct<1>, pg8::StaticOrder, true, true>(glds, g, S, E); }
            SEAM(ph); ++ph;
            if (PM(10) && IN(ph)) { pg8::Gemm g{R1, w_ff2, MHALF, DM, DFF}; pg8::StaticOrder S; S.init(MHALF, DM, G, bx);
                pg8::EpiResid E{X, X + (size_t)MP * DM, X, lmod + 5 * DM, half * (MHALF / 256)};
                pg8::gemm_phase<pg8::EpiResid, pg8::StaticOrder, true, true>(glds, g, S, E); }
            SEAM(ph); ++ph;
        }
        if (PM(11) && IN(ph)) { if (layer == 0) p_layernorm<true>(X, g_ff, b_ff, mod + (size_t)NCOND * MODW, HB); else p_layernorm<false>(X, g_ff, b_ff, nullptr, nullptr); }
        if (layer == 0) SEAM(ph);
        ++ph;
    }
#undef IN
#undef SEAM
}

extern "C" void kernel_launch(void* const* d_in, const int* in_sizes, int n_in, void* d_out, int out_size, void* d_ws, size_t ws_size, hipStream_t stream) {
    static int ready = 0;
    if (ready == 0) {
        if (n_in != 34 || ws_size < WS_END) { fprintf(stderr, "kernel_launch: built for 34 inputs and >= %zu bytes of workspace; got n_in %d ws %zu\n", (size_t)WS_END, n_in, ws_size); ready = -1; return; }
        if (hipFuncSetAttribute((const void*)mega_fwd, hipFuncAttributeMaxDynamicSharedMemorySize, LDS_BYTES) != hipSuccess) { fprintf(stderr, "kernel_launch: hipFuncSetAttribute failed\n"); ready = -1; return; }
        int dev = 0, cus = 0, per_cu = 0;
        hipGetDevice(&dev); hipDeviceGetAttribute(&cus, hipDeviceAttributeMultiprocessorCount, dev);
        hipOccupancyMaxActiveBlocksPerMultiprocessor(&per_cu, (const void*)mega_fwd, 512, LDS_BYTES);
        if (cus * per_cu < 256) { fprintf(stderr, "kernel_launch: resident capacity %d x %d < 256 workgroups\n", cus, per_cu); ready = -1; return; }
        ready = 1;
    }
    if (ready < 0) return;
    Args a{};
    for (int i = 0; i < 34; ++i) a.in[i] = (const float*)d_in[i];
    a.out = (float*)d_out; a.ws = (unsigned char*)d_ws;
#if MK_PER_PHASE
    for (int p = 0; p < NPHASE; ++p) { a.ph_lo = p; a.ph_hi = p + 1; hipLaunchKernelGGL(mega_fwd, dim3(256), dim3(512), LDS_BYTES, stream, a); }
#else
    a.ph_lo = 0; a.ph_hi = NPHASE;
    void* args[] = {&a};
    hipError_t e = hipLaunchCooperativeKernel((const void*)mega_fwd, dim3(256), dim3(512), args, LDS_BYTES, stream);
    if (e != hipSuccess) fprintf(stderr, "cooperative launch failed: %s\n", hipGetErrorString(e));
#endif
}
```

```cpp
#include <hip/hip_runtime.h>
#include <hip/hip_cooperative_groups.h>
#include <hip/hip_bf16.h>
#include <cstdio>
#include <cstdint>
namespace cg = cooperative_groups;

#ifndef MK_PER_PHASE
#define MK_PER_PHASE 0
#endif

constexpr int DM = 1024, MP = 8192, MS = 16384, MT = MP + MS;
constexpr int NCOND = 5, MODW = 6 * DM;
constexpr int IN0 = 2560, IN1 = 3072, DFF = 4096;
constexpr float ALPHA_F = 1.4142135623730951f;
constexpr float LN_EPS_F = 1e-5f;
constexpr float LAMBDA_INIT = 0.2f;
constexpr int MHALF = MT / 2;

constexpr size_t WS_MOD  = 0;
constexpr size_t WS_CTL  = 246272;
constexpr size_t WS_CK   = 262144;
constexpr size_t WS_CV   = WS_CK + 1048576;
constexpr size_t WS_WIN0 = WS_CV + 1048576;
constexpr size_t WS_WOUT0 = WS_WIN0 + (size_t)IN0 * DM * 2;
constexpr size_t WS_WFF1_0 = WS_WOUT0 + (size_t)DM * DM * 2;
constexpr size_t WS_WFF2_0 = WS_WFF1_0 + (size_t)DFF * DM * 2;
constexpr size_t WS_WIN1 = WS_WFF2_0 + (size_t)DFF * DM * 2;
constexpr size_t WS_WOUT1 = WS_WIN1 + (size_t)IN1 * DM * 2;
constexpr size_t WS_WFF1_1 = WS_WOUT1 + (size_t)DM * DM * 2;
constexpr size_t WS_WFF2_1 = WS_WFF1_1 + (size_t)DFF * DM * 2;
constexpr size_t WS_HB   = WS_WFF2_1 + (size_t)DFF * DM * 2;
constexpr size_t WS_R1   = WS_HB + (size_t)MT * DM * 2;
constexpr size_t WS_END  = WS_R1 + (size_t)MT * IN1 * 2;
static_assert(WS_END <= 268435456ull, "workspace budget (256 MiB)");
static_assert((size_t)MHALF * DFF * 2 <= (size_t)MT * IN1 * 2, "hidden half fits R1");
constexpr int LDS_BYTES = 131072 + 4096;

__device__ __forceinline__ int opaque_tid() { int t = threadIdx.x; asm volatile("" : "+v"(t)); return t; }
namespace pg8 {
#define PG8_LAS __attribute__((address_space(3)))
typedef unsigned short bf16_t;
typedef short bf16x8 __attribute__((ext_vector_type(8)));
typedef float f32x4 __attribute__((ext_vector_type(4)));
typedef unsigned u32x4 __attribute__((ext_vector_type(4)));
constexpr int BM = 256, BK = 64, HALF = 128, HTB = HALF * BK * 2  , STAGE_BYTES = 8 * HTB, NXCD = 8, WGM = 8;

__host__ __device__ __forceinline__ int lds_byte(int r, int c) { const int st = (r >> 4) * 2 + (c >> 5), rr = r & 15, cc = c & 31, ob = rr * 64 + cc * 2; return st * 1024 + (ob ^ (((ob >> 9) & 1) << 5)); }
__host__ __device__ __forceinline__ void stage_rc(int b, int& R, int& C) { const int st = b / 1024, sb = b % 1024, swz = sb ^ (((sb >> 9) & 1) << 5); R = (st >> 1) * 16 + swz / 64; C = (st & 1) * 32 + (swz % 64) / 2; }
__host__ __device__ __forceinline__ int perm32(int rho) { const int n = rho >> 4, i = rho & 15; return 8 * (i >> 2) + 4 * n + (i & 3); }

struct Unit { int pm, pn; };
struct Gemm { const bf16_t* A; const bf16_t* Bt; int M, N, K; };

struct StaticOrder {
    int nM, nN, nwg, G, c;
    __host__ __device__ void init(int M, int N, int G_, int c_) { nM = M / BM; nN = N / BM; nwg = nM * nN; G = G_; c = c_; }
    __host__ __device__ bool next(int i, Unit& u) const {
        const long L = (long)i * G + c; if (L >= nwg) return false;
        int wgid = (int)L; { const int q = nwg / NXCD, r = nwg % NXCD, xcd = wgid % NXCD, off = wgid / NXCD; wgid = (xcd < r ? xcd * (q + 1) : r * (q + 1) + (xcd - r) * q) + off; }
        const int nig = WGM * nN, gid = wgid / nig, fm = gid * WGM, gsz = (nM - fm) < WGM ? (nM - fm) : WGM;
        u.pm = fm + ((wgid % nig) % gsz); u.pn = (wgid % nig) / gsz; return true;
    }
    __device__ __forceinline__ void a_ready(const Unit&) const {}
    __device__ __forceinline__ void done(const Unit&) const {}
};
__device__ __forceinline__ unsigned cvt_pk_bf16(float lo, float hi) { unsigned r; asm volatile("v_cvt_pk_bf16_f32 %0, %1, %2" : "=v"(r) : "v"(lo), "v"(hi)); return r; }
typedef float f32x2 __attribute__((ext_vector_type(2)));
typedef unsigned u32x2 __attribute__((ext_vector_type(2)));
struct EpiInProj0 {
    static constexpr bool PERM = false, AFTER_DRAIN = false;
    bf16_t* O; float* newk; float* newv;
    __device__ __forceinline__ void operator()(const f32x4 (&acc)[2][2][4][2], const Unit& u, int wr, int wc, int fr, int fq) const {
        const int t = u.pn >> 1;
        bf16_t* base = O + (size_t)t * ((size_t)MT * 512);
        const int colt = (u.pn & 1) * 256 + wc * 32 + 4 * fq;
        const bool rope = (t <= 1) && (u.pm >= MP / 256);
        float* f32o = (u.pm < MP / 256) ? (t == 1 ? newk : (t == 2 ? newv : nullptr)) : nullptr;
        float inv[4];
#pragma unroll
        for (int e = 0; e < 4; ++e) inv[e] = __builtin_amdgcn_exp2f(-(float)(4 * fq + e) * (13.287712379549449f / 16.0f));
#pragma unroll
        for (int ai = 0; ai < 2; ++ai)
#pragma unroll
            for (int m = 0; m < 4; ++m) {
                const int row = u.pm * BM + ai * HALF + wr * 64 + m * 16 + fr;
                f32x4 v[2][2];
#pragma unroll
                for (int bj = 0; bj < 2; ++bj) { v[bj][0] = acc[ai][bj][m][0]; v[bj][1] = acc[ai][bj][m][1]; }
                if (rope) {
                    const int tok = (row - MP) & 4095; const float pos = (float)((wc & 1) ? (tok & 63) : (tok >> 6));
                    f32x4 cs, sn;
#pragma unroll
                    for (int e = 0; e < 4; ++e) { const float a = pos * inv[e]; cs[e] = __cosf(a); sn[e] = __sinf(a); }
#pragma unroll
                    for (int bj = 0; bj < 2; ++bj) { const f32x4 x1 = v[bj][0], x2 = v[bj][1]; v[bj][0] = x1 * cs - x2 * sn; v[bj][1] = x1 * sn + x2 * cs; }
                }
                bf16_t* rowp = base + (size_t)row * 512 + colt;
#pragma unroll
                for (int bj = 0; bj < 2; ++bj)
#pragma unroll
                    for (int n = 0; n < 2; ++n) { u32x2 w; w.x = cvt_pk_bf16(v[bj][n][0], v[bj][n][1]); w.y = cvt_pk_bf16(v[bj][n][2], v[bj][n][3]); *(u32x2*)(rowp + bj * HALF + n * 16) = w; }
                if (f32o) { float* fp = f32o + (size_t)row * 512 + colt;
#pragma unroll
                    for (int bj = 0; bj < 2; ++bj)
#pragma unroll
                        for (int n = 0; n < 2; ++n) *(f32x4*)(fp + bj * HALF + n * 16) = v[bj][n]; }
            }
    }
};
struct EpiResid {
    static constexpr bool PERM = false, AFTER_DRAIN = false;
    const float* xp; const float* xs; float* out; const float* gate; int pm_off;
    __device__ __forceinline__ void operator()(const f32x4 (&acc)[2][2][4][2], const Unit& u, int wr, int wc, int fr, int fq) const {
        const int pm = u.pm + pm_off; const int cond = pm < MP / 256 ? 0 : 1 + ((pm - MP / 256) >> 4);
        const int col0 = u.pn * BM + wc * 32 + 4 * fq; const float* g = gate + (size_t)cond * MODW + col0;
        f32x4 gv[2][2];
#pragma unroll
        for (int bj = 0; bj < 2; ++bj)
#pragma unroll
            for (int n = 0; n < 2; ++n) gv[bj][n] = *(const f32x4*)(g + bj * HALF + n * 16);
#pragma unroll
        for (int ai = 0; ai < 2; ++ai)
#pragma unroll
            for (int m = 0; m < 4; ++m) {
                const int row = pm * BM + ai * HALF + wr * 64 + m * 16 + fr;
                const float* xin = (row < MP ? xp + (size_t)row * DM : xs + (size_t)(row - MP) * DM) + col0; float* op = out + (size_t)row * DM + col0;
#pragma unroll
                for (int bj = 0; bj < 2; ++bj)
#pragma unroll
                    for (int n = 0; n < 2; ++n) { const f32x4 x = *(const f32x4*)(xin + bj * HALF + n * 16); *(f32x4*)(op + bj * HALF + n * 16) = x * ALPHA_F + gv[bj][n] * acc[ai][bj][m][n]; }
            }
    }
};
template <int ACT> struct EpiAct {
    static constexpr bool PERM = true, AFTER_DRAIN = false;
    bf16_t* O; int ldc;
    __device__ __forceinline__ void operator()(const f32x4 (&acc)[2][2][4][2], const Unit& u, int wr, int wc, int fr, int fq) const {
        const int row0 = u.pm * BM + wr * 64 + fr; const int col0 = u.pn * BM + wc * 32 + 8 * fq;
#pragma unroll
        for (int ai = 0; ai < 2; ++ai)
#pragma unroll
            for (int m = 0; m < 4; ++m) { bf16_t* rowp = O + (size_t)(row0 + ai * HALF + m * 16) * ldc + col0;
#pragma unroll
                for (int bj = 0; bj < 2; ++bj) { f32x4 v0 = acc[ai][bj][m][0], v1 = acc[ai][bj][m][1];
                    if (ACT == 1) { v0 = __builtin_elementwise_max(v0, (f32x4){0.f, 0.f, 0.f, 0.f}); v1 = __builtin_elementwise_max(v1, (f32x4){0.f, 0.f, 0.f, 0.f}); v0 = v0 * v0; v1 = v1 * v1; }
                    u32x4 w; w.x = cvt_pk_bf16(v0[0], v0[1]); w.y = cvt_pk_bf16(v0[2], v0[3]); w.z = cvt_pk_bf16(v1[0], v1[1]); w.w = cvt_pk_bf16(v1[2], v1[3]);
                    *(u32x4*)(rowp + bj * HALF) = w; } }
    }
};
template <class Epi, class Sched, bool ALIGN_EPI = false, bool SP2 = false>
__device__ __forceinline__ void gemm_phase(PG8_LAS unsigned char* lds, const Gemm g, const Sched& S, const Epi& E) {
    const int tid = opaque_tid(), wid = __builtin_amdgcn_readfirstlane(tid >> 6), lane = tid & 63, wr = wid >> 2, wc = wid & 3, fr = lane & 15, fq = lane >> 4;
    const int K = g.K, nt = K / BK;
    unsigned voffA[2], voffB[2];
#pragma unroll
    for (int i = 0; i < 2; ++i) { int R, C; stage_rc(tid * 16 + i * 8192, R, C); const int Rb = Epi::PERM ? ((R & ~31) + perm32(R & 31)) : R;
        voffA[i] = (unsigned)(R * K + C) * 2u; voffB[i] = (unsigned)(Rb * K + C) * 2u; }
    const size_t kstep = (size_t)(BK * 2);
    const size_t hstep = (size_t)HALF * K * 2;
    const size_t tstep = 2 * hstep;
    const unsigned ldsw = (unsigned)wid * 1024u;
    const int aoff = lds_byte(wr * 64 + fr, fq * 8), boff = lds_byte(wc * 32 + fr, fq * 8);
#define PG8_SA(b, h) (((b) * 2 + (h)) * HTB)
#define PG8_SB(b, h) ((4 + (b) * 2 + (h)) * HTB)
#define PG8_STAGE(bufoff, gbase, voff) do { _Pragma("unroll") for (int _i = 0; _i < 2; ++_i) \
        __builtin_amdgcn_global_load_lds((const unsigned*)((const char*)(gbase) + (voff)[_i]), (PG8_LAS unsigned*)(lds + (bufoff) + ldsw + _i * 8192), 16, 0, 0); } while (0)
#define PG8_LDA(dst, b, h) do { _Pragma("unroll") for (int m = 0; m < 4; ++m) _Pragma("unroll") for (int k = 0; k < 2; ++k) dst[m][k] = *(const PG8_LAS bf16x8*)(lds + PG8_SA(b, h) + aoff + m * 2048 + k * 1024); } while (0)
#define PG8_LDB(dst, b, h) do { _Pragma("unroll") for (int n = 0; n < 2; ++n) _Pragma("unroll") for (int k = 0; k < 2; ++k) dst[n][k] = *(const PG8_LAS bf16x8*)(lds + PG8_SB(b, h) + boff + n * 2048 + k * 1024); } while (0)
#define PG8_MMA(ai, bj, At, Bt) do { __builtin_amdgcn_s_setprio(1); _Pragma("unroll") for (int m = 0; m < 4; ++m) _Pragma("unroll") for (int n = 0; n < 2; ++n) _Pragma("unroll") for (int k = 0; k < 2; ++k) \
        acc[ai][bj][m][n] = __builtin_amdgcn_mfma_f32_16x16x32_bf16(Bt[n][k], At[m][k], acc[ai][bj][m][n], 0, 0, 0); __builtin_amdgcn_s_setprio(0); } while (0)
#define PG8_WAIT_V(n) asm volatile("s_waitcnt vmcnt(" #n ")" ::: "memory")
#define PG8_WAIT_L(n) asm volatile("s_waitcnt lgkmcnt(" #n ")" ::: "memory")
#define PG8_BAR __builtin_amdgcn_s_barrier()
#define PG8_SCHED __builtin_amdgcn_sched_barrier(0)
    Unit cur, nxt; int ui = 0;
    if (!S.next(0, cur)) return;
    f32x4 acc[2][2][4][2];
#pragma unroll
    for (int a = 0; a < 2; ++a)
#pragma unroll
        for (int b = 0; b < 2; ++b)
#pragma unroll
            for (int m = 0; m < 4; ++m)
#pragma unroll
                for (int n = 0; n < 2; ++n) acc[a][b][m][n] = (f32x4){0.f, 0.f, 0.f, 0.f};
    bf16x8 At[4][2], B0[2][2], B1[2][2];
    const char* cA = (const char*)g.A + (size_t)cur.pm * tstep; const char* cB = (const char*)g.Bt + (size_t)cur.pn * tstep;
    S.a_ready(cur);
    if constexpr (SP2) {
        PG8_STAGE(PG8_SB(0, 0), cB, voffB); PG8_STAGE(PG8_SB(0, 1), cB + hstep, voffB); PG8_STAGE(PG8_SA(0, 0), cA, voffA); PG8_STAGE(PG8_SA(0, 1), cA + hstep, voffA);
        if (wr == 1) PG8_BAR;
        PG8_WAIT_V(2); PG8_BAR;
        PG8_STAGE(PG8_SB(1, 0), cB + kstep, voffB); PG8_STAGE(PG8_SA(1, 0), cA + kstep, voffA); PG8_STAGE(PG8_SB(1, 1), cB + hstep + kstep, voffB);
        PG8_WAIT_V(6); PG8_BAR;
    } else {
        PG8_STAGE(PG8_SB(0, 0), cB, voffB); PG8_STAGE(PG8_SA(0, 0), cA, voffA); PG8_STAGE(PG8_SB(0, 1), cB + hstep, voffB); PG8_STAGE(PG8_SA(0, 1), cA + hstep, voffA);
        if (wr == 1) PG8_BAR;
        PG8_WAIT_V(4); PG8_BAR;
        PG8_STAGE(PG8_SB(1, 0), cB + kstep, voffB); PG8_STAGE(PG8_SA(1, 0), cA + kstep, voffA); PG8_STAGE(PG8_SB(1, 1), cB + hstep + kstep, voffB);
        PG8_WAIT_V(6); PG8_BAR;
    }
    for (;;) {
        const bool has_next = S.next(ui + 1, nxt);
        const char* nA = has_next ? (const char*)g.A + (size_t)nxt.pm * tstep : cA; const char* nB = has_next ? (const char*)g.Bt + (size_t)nxt.pn * tstep : cB;
        for (int t = 0; t < nt; t += 2) {
            const bool last = (t == nt - 2);
            const char* a1 = cA + (size_t)(t + 1) * kstep;
            const char* a2 = last ? nA : cA + (size_t)(t + 2) * kstep; const char* b2 = last ? nB : cB + (size_t)(t + 2) * kstep;
            const char* a3 = a2 + kstep; const char* b3 = b2 + kstep;
            if (last && has_next) S.a_ready(nxt);
            if constexpr (SP2) {
            PG8_LDB(B0, 0, 0); PG8_LDB(B1, 0, 1); PG8_SCHED; PG8_LDA(At, 0, 0); PG8_STAGE(PG8_SA(1, 1), a1 + hstep, voffA);
            PG8_WAIT_V(8); PG8_WAIT_L(0); PG8_BAR; PG8_MMA(0, 0, At, B0); PG8_MMA(0, 1, At, B1); PG8_BAR; PG8_SCHED;
            PG8_LDA(At, 0, 1); PG8_STAGE(PG8_SB(0, 0), b2, voffB); PG8_STAGE(PG8_SB(0, 1), b2 + hstep, voffB); PG8_STAGE(PG8_SA(0, 0), a2, voffA);
            PG8_WAIT_V(8); PG8_WAIT_L(0); PG8_BAR; PG8_MMA(1, 0, At, B0); PG8_MMA(1, 1, At, B1); PG8_BAR; PG8_SCHED;
            PG8_LDB(B0, 1, 0); PG8_LDB(B1, 1, 1); PG8_SCHED; PG8_LDA(At, 1, 0); PG8_STAGE(PG8_SA(0, 1), a2 + hstep, voffA);
            PG8_WAIT_V(8); PG8_WAIT_L(0); PG8_BAR; PG8_MMA(0, 0, At, B0); PG8_MMA(0, 1, At, B1); PG8_BAR; PG8_SCHED;
            PG8_LDA(At, 1, 1); PG8_STAGE(PG8_SB(1, 0), b3, voffB); PG8_STAGE(PG8_SB(1, 1), b3 + hstep, voffB); PG8_STAGE(PG8_SA(1, 0), a3, voffA);
            PG8_WAIT_V(8); PG8_WAIT_L(0); PG8_BAR; PG8_MMA(1, 0, At, B0); PG8_MMA(1, 1, At, B1); PG8_BAR; PG8_SCHED;
            } else {
            PG8_LDB(B0, 0, 0); PG8_SCHED; PG8_LDA(At, 0, 0); PG8_STAGE(PG8_SA(1, 1), a1 + hstep, voffA);
            PG8_WAIT_L(8); PG8_BAR; PG8_WAIT_L(0); PG8_MMA(0, 0, At, B0); PG8_BAR; PG8_SCHED;
            PG8_LDB(B1, 0, 1); PG8_STAGE(PG8_SB(0, 0), b2, voffB);
            PG8_BAR; PG8_WAIT_L(0); PG8_MMA(0, 1, At, B1); PG8_BAR;
            PG8_LDA(At, 0, 1); PG8_STAGE(PG8_SA(0, 0), a2, voffA);
            PG8_BAR; PG8_WAIT_L(0); PG8_MMA(1, 0, At, B0); PG8_BAR; PG8_SCHED;
            PG8_STAGE(PG8_SB(0, 1), b2 + hstep, voffB);
            PG8_WAIT_V(6); PG8_BAR; PG8_MMA(1, 1, At, B1); PG8_BAR;
            PG8_LDB(B0, 1, 0); PG8_SCHED; PG8_LDA(At, 1, 0); PG8_STAGE(PG8_SA(0, 1), a2 + hstep, voffA);
            PG8_WAIT_L(8); PG8_BAR; PG8_WAIT_L(0); PG8_MMA(0, 0, At, B0); PG8_BAR; PG8_SCHED;
            PG8_LDB(B1, 1, 1); PG8_STAGE(PG8_SB(1, 0), b3, voffB);
            PG8_BAR; PG8_WAIT_L(0); PG8_MMA(0, 1, At, B1); PG8_BAR;
            PG8_LDA(At, 1, 1); PG8_STAGE(PG8_SA(1, 0), a3, voffA);
            PG8_BAR; PG8_WAIT_L(0); PG8_MMA(1, 0, At, B0); PG8_BAR; PG8_SCHED;
            PG8_STAGE(PG8_SB(1, 1), b3 + hstep, voffB);
            PG8_WAIT_V(6); PG8_BAR; PG8_MMA(1, 1, At, B1); PG8_BAR;
            }
        }
        if constexpr (ALIGN_EPI) { if (wr == 0) PG8_BAR; }
        if constexpr (!Epi::AFTER_DRAIN) { E(acc, cur, wr, wc, fr, fq); S.done(cur); }
        if (!has_next) break;
#pragma unroll
        for (int a = 0; a < 2; ++a)
#pragma unroll
            for (int b = 0; b < 2; ++b)
#pragma unroll
                for (int m = 0; m < 4; ++m)
#pragma unroll
                    for (int n = 0; n < 2; ++n) acc[a][b][m][n] = (f32x4){0.f, 0.f, 0.f, 0.f};
        cur = nxt; cA = nA; cB = nB; ++ui;
        if constexpr (ALIGN_EPI) { if (wr == 1) PG8_BAR; }
    }
    PG8_WAIT_V(0);
    if constexpr (!ALIGN_EPI) { if (wr == 0) PG8_BAR; }
    PG8_BAR;
    if constexpr (Epi::AFTER_DRAIN) { E.fused(acc, cur, wr, wc, fr, fq, lds, wid, lane); S.done(cur); }
#undef PG8_SA
#undef PG8_SB
#undef PG8_STAGE
#undef PG8_LDA
#undef PG8_LDB
#undef PG8_MMA
#undef PG8_WAIT_V
#undef PG8_WAIT_L
#undef PG8_BAR
#undef PG8_SCHED
}
}
namespace att {
using bf16x8 = __attribute__((ext_vector_type(8))) short;
using s16x4  = __attribute__((ext_vector_type(4))) short;
using f32x16 = __attribute__((ext_vector_type(16))) float;
using u32x4  = __attribute__((ext_vector_type(4))) unsigned;
typedef unsigned short bf16_t;
constexpr float SCALE = 0.125f;
constexpr float THR = 8.f;
constexpr int SHM_V = 64 * 128 * 2, SHM_K = 64 * 64 * 2;
constexpr int LDS_ATT = 2 * SHM_V + 2 * SHM_K + 8 * 64 * 4;
#define KSWZ(row, colB) ((row) * 128 + ((colB) ^ ((((row) >> 1) & 7) << 4)))
#define SBAR() __builtin_amdgcn_sched_barrier(0)
__device__ __forceinline__ int crow(int r, int hi) { return (r & 3) + 8 * (r >> 2) + 4 * hi; }
__device__ __forceinline__ unsigned cvtpk(float lo, float hi) { unsigned r; asm volatile("v_cvt_pk_bf16_f32 %0, %1, %2" : "=v"(r) : "v"(lo), "v"(hi)); return r; }

__device__ __forceinline__ void partialSM(f32x16& p0, f32x16& p1, float& m_reg, float& mn, float& alpha) {
  constexpr float C = SCALE * 1.4426950408889634f;
  float pmax = p0[0];
#pragma unroll
  for (int r = 1; r < 16; ++r) pmax = fmaxf(pmax, p0[r]);
#pragma unroll
  for (int r = 0; r < 16; ++r) pmax = fmaxf(pmax, p1[r]);
  { auto rr = __builtin_amdgcn_permlane32_swap(__float_as_uint(pmax), __float_as_uint(pmax), false, false);
    pmax = fmaxf(__uint_as_float(rr[0]), __uint_as_float(rr[1])); }
  if (__builtin_expect(__all(pmax - m_reg <= THR / SCALE), 1)) { mn = m_reg; alpha = 1.f; }
  else { mn = fmaxf(m_reg, pmax); alpha = __builtin_amdgcn_exp2f((m_reg - mn) * C); m_reg = mn; }
  float mnC = -mn * C;
#pragma unroll
  for (int r = 0; r < 16; ++r) p0[r] = fmaf(p0[r], C, mnC);
#pragma unroll
  for (int r = 0; r < 16; ++r) p1[r] = fmaf(p1[r], C, mnC);
#pragma unroll
  for (int r = 0; r < 16; ++r) p0[r] = __builtin_amdgcn_exp2f(p0[r]);
}
__device__ __forceinline__ void finishSM(f32x16& p0, f32x16& p1, float alpha, float& l_reg, bf16x8& pa0, bf16x8& pa1, bf16x8& pa2, bf16x8& pa3) {
#pragma unroll
  for (int r = 0; r < 16; ++r) p1[r] = __builtin_amdgcn_exp2f(p1[r]);
  float ps = 0;
#pragma unroll
  for (int r = 0; r < 16; ++r) ps += p0[r];
#pragma unroll
  for (int r = 0; r < 16; ++r) ps += p1[r];
  { auto rr = __builtin_amdgcn_permlane32_swap(__float_as_uint(ps), __float_as_uint(ps), false, false);
    ps = __uint_as_float(rr[0]) + __uint_as_float(rr[1]); }
  l_reg = l_reg * alpha + ps;
#define PK4(P, BASE, OUT) do { unsigned a0 = cvtpk(P[BASE + 0], P[BASE + 1]), a1 = cvtpk(P[BASE + 2], P[BASE + 3]);   \
    unsigned b0 = cvtpk(P[BASE + 4], P[BASE + 5]), b1 = cvtpk(P[BASE + 6], P[BASE + 7]);                              \
    auto r0 = __builtin_amdgcn_permlane32_swap(a0, b0, false, false); auto r1 = __builtin_amdgcn_permlane32_swap(a1, b1, false, false); \
    u32x4 w = {r0[0], r1[0], r0[1], r1[1]}; OUT = *reinterpret_cast<bf16x8*>(&w); } while (0)
  PK4(p0, 0, pa0); PK4(p0, 8, pa1); PK4(p1, 0, pa2); PK4(p1, 8, pa3);
#undef PK4
}
__device__ __forceinline__ void qkt(f32x16& p0, f32x16& p1, const char* Ks, const bf16x8* qr, int r32, int hi) {
  p0 = f32x16{}; p1 = f32x16{};
#pragma unroll
  for (int d0 = 0; d0 < 4; ++d0) { int cb = (d0 * 16 + hi * 8) * 2;
    bf16x8 b0 = *reinterpret_cast<const bf16x8*>(Ks + KSWZ(r32, cb));
    bf16x8 b1 = *reinterpret_cast<const bf16x8*>(Ks + KSWZ(32 + r32, cb));
    p0 = __builtin_amdgcn_mfma_f32_32x32x16_bf16(b0, qr[d0], p0, 0, 0, 0);
    p1 = __builtin_amdgcn_mfma_f32_32x32x16_bf16(b1, qr[d0], p1, 0, 0, 0); }
}
__device__ __forceinline__ int v_st(int k, int c) { const int kk = (k & ~0xC) | ((k & 4) << 1) | ((k & 8) >> 1); return ((kk >> 3) * 4 + (c >> 5)) * 512 + ((kk & 7) * 32 + (c & 31)) * 2; }
__device__ __forceinline__ int v_rd_base(int lane) { return ((lane & 3) << 3) | (((lane >> 2) & 3) << 6) | (((lane >> 4) & 1) << 5) | (((lane >> 5) & 1) << 8); }
constexpr int v_rd_off(int d0, int ks, int half) { return d0 * 512 + ks * 4096 + half * 2048; }
template <int OFF> __device__ __forceinline__ s16x4 tr_read(int vb) {
  s16x4 r; asm volatile("ds_read_b64_tr_b16 %0, %1 offset:%2" : "=&v"(r) : "v"(vb), "i"(OFF) : "memory"); return r;
}
template <int D0> __device__ __forceinline__ void pv_one(f32x16& od, int vb, bf16x8 pa0, bf16x8 pa1, bf16x8 pa2, bf16x8 pa3) {
  const s16x4 l0 = tr_read<v_rd_off(D0, 0, 0)>(vb), h0 = tr_read<v_rd_off(D0, 0, 1)>(vb), l1 = tr_read<v_rd_off(D0, 1, 0)>(vb), h1 = tr_read<v_rd_off(D0, 1, 1)>(vb);
  const s16x4 l2 = tr_read<v_rd_off(D0, 2, 0)>(vb), h2 = tr_read<v_rd_off(D0, 2, 1)>(vb), l3 = tr_read<v_rd_off(D0, 3, 0)>(vb), h3 = tr_read<v_rd_off(D0, 3, 1)>(vb);
  asm volatile("s_waitcnt lgkmcnt(0)" ::: "memory"); SBAR();
#define PK(L, H) (bf16x8){L[0], L[1], L[2], L[3], H[0], H[1], H[2], H[3]}
  od = __builtin_amdgcn_mfma_f32_32x32x16_bf16(pa0, PK(l0, h0), od, 0, 0, 0);
  od = __builtin_amdgcn_mfma_f32_32x32x16_bf16(pa1, PK(l1, h1), od, 0, 0, 0);
  od = __builtin_amdgcn_mfma_f32_32x32x16_bf16(pa2, PK(l2, h2), od, 0, 0, 0);
  od = __builtin_amdgcn_mfma_f32_32x32x16_bf16(pa3, PK(l3, h3), od, 0, 0, 0);
#undef PK
}
__device__ __forceinline__ void pv_d0(f32x16* o, int vb, bf16x8 pa0, bf16x8 pa1, bf16x8 pa2, bf16x8 pa3) {
  pv_one<0>(o[0], vb, pa0, pa1, pa2, pa3); pv_one<1>(o[1], vb, pa0, pa1, pa2, pa3); pv_one<2>(o[2], vb, pa0, pa1, pa2, pa3); pv_one<3>(o[3], vb, pa0, pa1, pa2, pa3);
}

__device__ __forceinline__ void attn_half(f32x16 (&o)[4], const bf16_t* __restrict__ Qw, const bf16_t* __restrict__ Kc, const bf16_t* __restrict__ Vc,
                                          const bf16_t* __restrict__ Kn, const bf16_t* __restrict__ Vn, int ncache, int NT, char* lds) {
  const int tid = opaque_tid(), wid = tid >> 6, lane = tid & 63, r32 = lane & 31, hi = lane >> 5;
  char* V_lds = lds; char* K_lds = lds + 2 * SHM_V;
  float* wsf = (float*)(lds + 2 * SHM_V + 2 * SHM_K) + wid * 64; float* li_l = wsf; float* al_l = wsf + 32;
  float m_reg = -1e30f, l_reg = 0; bf16x8 qr[4];
#pragma unroll
  for (int d = 0; d < 4; ++d) o[d] = f32x16{};
#pragma unroll
  for (int d0 = 0; d0 < 4; ++d0) qr[d0] = *reinterpret_cast<const bf16x8*>(Qw + d0 * 16);
  const int sr = tid >> 4, sc = (tid & 15) * 8, vst0 = v_st(sr, sc), vst1 = v_st(32 + sr, sc);
  const int kr = tid >> 3, kc = (tid & 7) * 8, kst = KSWZ(kr, kc * 2);
  const int vb0 = (int)(uintptr_t)V_lds + v_rd_base(lane);
  struct { bf16x8 vs0, vs1, ks0; } sr_[2];
#define TPTR(jt, PC, PN) ((jt) < ncache ? (PC) + (size_t)(jt) * (64 * 512) : (PN) + (size_t)((jt) - ncache) * (64 * 512))
#define SLOAD(i, jt) do { const bf16_t* vt_ = TPTR(jt, Vc, Vn); const bf16_t* kt_ = TPTR(jt, Kc, Kn); \
    sr_[i].vs0 = *reinterpret_cast<const bf16x8*>(vt_ + (size_t)sr * 512 + sc); sr_[i].vs1 = *reinterpret_cast<const bf16x8*>(vt_ + (size_t)(32 + sr) * 512 + sc); \
    sr_[i].ks0 = *reinterpret_cast<const bf16x8*>(kt_ + (size_t)kr * 512 + kc); } while (0)
#define SWRITE(b, i) do { *(bf16x8*)(V_lds + (b) * SHM_V + vst0) = sr_[i].vs0; *(bf16x8*)(V_lds + (b) * SHM_V + vst1) = sr_[i].vs1; \
    *(bf16x8*)(K_lds + (b) * SHM_K + kst) = sr_[i].ks0; } while (0)
#define SWAIT() asm volatile("s_waitcnt vmcnt(3)" ::: "memory")
#define RESC(a) do { if (__any((a) < 1.f)) { if (hi == 0) al_l[r32] = (a); asm volatile("s_waitcnt lgkmcnt(0)" ::: "memory"); \
    _Pragma("unroll") for (int d = 0; d < 4; ++d) _Pragma("unroll") for (int r = 0; r < 16; ++r) o[d][r] *= al_l[crow(r, hi)]; } } while (0)
  f32x16 pA0, pA1, pB0, pB1; float mnA, mnB, alA, alB; bf16x8 pa0, pa1, pa2, pa3;
  constexpr int SE = 0, SO = 1;
  __syncthreads();
  SLOAD(SE, 0); asm volatile("s_waitcnt vmcnt(0)" ::: "memory"); SWRITE(0, SE); __syncthreads();
  qkt(pA0, pA1, K_lds, qr, r32, hi); partialSM(pA0, pA1, m_reg, mnA, alA);
  SLOAD(SO, 1); if (2 < NT) SLOAD(SE, 2);
  SWAIT(); SWRITE(1, SO); __syncthreads();
  for (int j = 1; j + 1 < NT; j += 2) {
    SBAR(); qkt(pB0, pB1, K_lds + SHM_K, qr, r32, hi);
    finishSM(pA0, pA1, alA, l_reg, pa0, pa1, pa2, pa3); SBAR();
    SLOAD(SO, j + 2); SBAR();
    pv_d0(o, vb0, pa0, pa1, pa2, pa3); partialSM(pB0, pB1, m_reg, mnB, alB);
    __syncthreads(); SWAIT(); SWRITE(0, SE);
    RESC(alB); __syncthreads();
    SBAR(); qkt(pA0, pA1, K_lds, qr, r32, hi);
    finishSM(pB0, pB1, alB, l_reg, pa0, pa1, pa2, pa3); SBAR();
    if (j + 3 < NT) SLOAD(SE, j + 3); SBAR();
    pv_d0(o, vb0 + SHM_V, pa0, pa1, pa2, pa3); partialSM(pA0, pA1, m_reg, mnA, alA);
    __syncthreads(); SWAIT(); SWRITE(1, SO);
    RESC(alA); __syncthreads();
  }
  SBAR(); qkt(pB0, pB1, K_lds + SHM_K, qr, r32, hi);
  finishSM(pA0, pA1, alA, l_reg, pa0, pa1, pa2, pa3); SBAR();
  pv_d0(o, vb0, pa0, pa1, pa2, pa3); partialSM(pB0, pB1, m_reg, mnB, alB);
  __syncthreads(); RESC(alB);
  finishSM(pB0, pB1, alB, l_reg, pa0, pa1, pa2, pa3); SBAR();
  pv_d0(o, vb0 + SHM_V, pa0, pa1, pa2, pa3);
  if (hi == 0) li_l[r32] = l_reg; asm volatile("s_waitcnt lgkmcnt(0)" ::: "memory");
#pragma unroll
  for (int r = 0; r < 16; ++r) { const float rl = __builtin_amdgcn_rcpf(li_l[crow(r, hi)]);
#pragma unroll
    for (int d = 0; d < 4; ++d) o[d][r] *= rl; }
#undef TPTR
#undef SLOAD
#undef SWRITE
#undef SWAIT
#undef RESC
}
}
typedef unsigned short bf16_t;
typedef float f32x4v __attribute__((ext_vector_type(4)));
typedef float f32x2v __attribute__((ext_vector_type(2)));
typedef unsigned u32x4v __attribute__((ext_vector_type(4)));
typedef unsigned u32x2v __attribute__((ext_vector_type(2)));
typedef short bf16x8v __attribute__((ext_vector_type(8)));
using att::f32x16;
#define LDS_WAIT() asm volatile("s_waitcnt lgkmcnt(0)" ::: "memory")
__device__ __forceinline__ unsigned pk2(float lo, float hi) { return pg8::cvt_pk_bf16(lo, hi); }
__device__ __forceinline__ float bf_lo(unsigned w) { return __uint_as_float(w << 16); }
__device__ __forceinline__ float bf_hi(unsigned w) { return __uint_as_float(w & 0xffff0000u); }
__device__ __forceinline__ float wave_sum(float v) {
#pragma unroll
    for (int o = 1; o < 64; o <<= 1) v += __shfl_xor(v, o);
    return v;
}
#define LAS __attribute__((address_space(3)))
#define XB_TMO      128
#define XB_XCNT(j)  (256  + 64 * (j))
#define XB_XSUB(j)  (1280 + 64 * (j))
#define XB_XGEN(j)  (2304 + 64 * (j))
#define XB_TOP      3328
#define XB_TOPGEN   3392
#define XCD_BAR_WORDS 3456
#define XB_SPIN_CAP (1u << 18)

__device__ __forceinline__ unsigned xb_ld(unsigned* p)              { return __hip_atomic_load(p, __ATOMIC_RELAXED, __HIP_MEMORY_SCOPE_AGENT); }
__device__ __forceinline__ unsigned xb_add(unsigned* p, unsigned v) { return __hip_atomic_fetch_add(p, v, __ATOMIC_RELAXED, __HIP_MEMORY_SCOPE_AGENT); }
__device__ __forceinline__ unsigned xb_xcc_id() { return (unsigned)__builtin_amdgcn_s_getreg((3 << 11) | 20) & 0xFu; }
#define XB_SPIN(cond, bar) do { unsigned _sp = 0; while (cond) { __builtin_amdgcn_s_sleep(1); \
    if ((++_sp & 255u) == 0u) { if (xb_ld(&(bar)[XB_TMO])) break; if (_sp > XB_SPIN_CAP) { atomicAdd(&(bar)[XB_TMO], 1u); break; } } } } while (0)

struct XcdBarrier {
    unsigned* bar; unsigned x;
    volatile LAS unsigned* st;
};

__device__ __forceinline__ XcdBarrier xcd_barrier_post(unsigned* bar, volatile LAS unsigned* st) {
    XcdBarrier b; b.bar = bar; b.x = xb_xcc_id(); b.st = st;
    if (threadIdx.x == 0) (void)xb_add(&bar[XB_XCNT(b.x)], 1u);
    return b;
}
__device__ __forceinline__ void xcd_barrier_complete(unsigned* bar, unsigned x, unsigned& nloc, unsigned& nx) {
    const unsigned G = gridDim.x * gridDim.y * gridDim.z;
    unsigned sum, cnt, mine, sp = 0u;
    for (;;) {
        sum = 0u; cnt = 0u; mine = 0u;
#pragma unroll
        for (unsigned j = 0; j < 16; ++j) { const unsigned c = xb_ld(&bar[XB_XCNT(j)]); sum += c; cnt += (c > 0u) ? 1u : 0u; mine = (j == x) ? c : mine; }
        if (sum == G) break;
        __builtin_amdgcn_s_sleep(1);
        if ((++sp & 255u) == 0u) { if (xb_ld(&bar[XB_TMO])) break; if (sp > XB_SPIN_CAP) { atomicAdd(&bar[XB_TMO], 1u); break; } }
    }
    nloc = mine > 0u ? mine : 1u; nx = cnt > 0u ? cnt : 1u;
}

__device__ __forceinline__ void xcd_barrier(const XcdBarrier& b) {
    asm volatile("s_waitcnt vmcnt(0)" ::: "memory");
    __syncthreads();
    if (threadIdx.x == 0) {
        unsigned* bar = b.bar;
        __builtin_amdgcn_s_waitcnt(0);
        unsigned nloc = b.st[0], nx = b.st[1];
        if (nloc == 0u) { xcd_barrier_complete(bar, b.x, nloc, nx); b.st[0] = nloc; b.st[1] = nx; }
        const unsigned old = xb_add(&bar[XB_XSUB(b.x)], 1u);
        const unsigned gen = old / nloc;
        if (old + 1u == (gen + 1u) * nloc) {
            __builtin_amdgcn_fence(__ATOMIC_RELEASE, "agent");
            asm volatile("s_waitcnt vmcnt(0)" ::: "memory");
            const unsigned og = xb_add(&bar[XB_TOP], 1u);
            const unsigned tg = og / nx;
            if (og + 1u == (tg + 1u) * nx) xb_add(&bar[XB_TOPGEN], 1u);
            else XB_SPIN(xb_ld(&bar[XB_TOPGEN]) == tg, bar);
            __builtin_amdgcn_fence(__ATOMIC_ACQUIRE, "agent");
            xb_add(&bar[XB_XGEN(b.x)], 1u);
            asm volatile("s_waitcnt vmcnt(0)" ::: "memory");
        } else {
            XB_SPIN(xb_ld(&bar[XB_XGEN(b.x)]) == gen, bar);
            __builtin_amdgcn_fence(__ATOMIC_ACQUIRE, "agent");
            asm volatile("s_waitcnt vmcnt(0)" ::: "memory");
        }
    }
    __syncthreads();
}

struct Args { const float* in[34]; float* out; unsigned char* ws; int ph_lo, ph_hi; };

__device__ __forceinline__ void p0_transpose_item(const float* __restrict__ W, int K, int N, bf16_t* __restrict__ WT, float* scr, int item, int lane) {
    const int nblk = N / 32, kb = item / nblk, nb = item % nblk, k0 = 64 * kb, n0 = 32 * nb;
#pragma unroll 8
    for (int i = 0; i < 32; ++i) { const int kk = 2 * i + (lane >> 5); scr[kk * 33 + (lane & 31)] = W[(size_t)(k0 + kk) * N + n0 + (lane & 31)]; }
    LDS_WAIT(); asm volatile("" ::: "memory");
    const int c = lane & 7;
#pragma unroll
    for (int j = 0; j < 4; ++j) { const int n = (lane >> 3) + 8 * j; const float* s = scr + (8 * c) * 33 + n;
        u32x4v o; o.x = pk2(s[0 * 33], s[1 * 33]); o.y = pk2(s[2 * 33], s[3 * 33]); o.z = pk2(s[4 * 33], s[5 * 33]); o.w = pk2(s[6 * 33], s[7 * 33]);
        *(u32x4v*)(WT + (size_t)(n0 + n) * K + k0 + 8 * c) = o; }
    LDS_WAIT(); asm volatile("" ::: "memory");
}
__device__ __forceinline__ void p0_adaln_item(const Args& a, int item, float* silu_tab  , float* part  , int tid) {
    const int wid = tid >> 6, lane = tid & 63;
    const int layer = item / 48, blk = item % 48, j0 = blk * 128 + 2 * lane;
    const float* wm = a.in[layer ? 23 : 6]; const float* bm = a.in[layer ? 24 : 7];
    for (int i = tid; i < NCOND * DM; i += 512) { const int c = i >> 10, k = i & 1023; const float x = c == 0 ? a.in[5][k] : a.in[4][(c - 1) * DM + k]; silu_tab[i] = x / (1.f + __expf(-x)); }
    __syncthreads();
    f32x2v acc[NCOND];
#pragma unroll
    for (int c = 0; c < NCOND; ++c) acc[c] = (f32x2v){0.f, 0.f};
    const int kb = wid * 128;
    for (int k = kb; k < kb + 128; k += 16) {
        f32x2v w[16];
#pragma unroll
        for (int u = 0; u < 16; ++u) w[u] = *(const f32x2v*)(wm + (size_t)(k + u) * MODW + j0);
#pragma unroll
        for (int u = 0; u < 16; ++u)
#pragma unroll
            for (int c = 0; c < NCOND; ++c) acc[c] += w[u] * silu_tab[c * DM + k + u];
    }
#pragma unroll
    for (int c = 0; c < NCOND; ++c) *(f32x2v*)(part + (wid * NCOND + c) * 128 + 2 * lane) = acc[c];
    __syncthreads();
    float* mod = (float*)(a.ws + WS_MOD) + (size_t)layer * NCOND * MODW;
    for (int o = tid; o < NCOND * 128; o += 512) { const int c = o >> 7, j = o & 127; float s = bm[blk * 128 + j];
#pragma unroll
        for (int w8 = 0; w8 < 8; ++w8) s += part[(w8 * NCOND + c) * 128 + j];
        mod[(size_t)c * MODW + blk * 128 + j] = s; }
    __syncthreads();
}
__device__ __forceinline__ int row_cond(int row) { return row < MP ? 0 : 1 + ((row - MP) >> 12); }
__device__ __forceinline__ const float* x_in_row(const Args& a, int row) { return row < MP ? a.in[0] + (size_t)row * DM : a.in[1] + (size_t)(row - MP) * DM; }

__device__ __forceinline__ void p0_prologue(const Args& a, char* lds) {
    const int tid = opaque_tid(), wid = tid >> 6, lane = tid & 63, G = gridDim.x;
    float* scr = (float*)(lds + wid * 8704);
    if (blockIdx.x < 96) p0_adaln_item(a, blockIdx.x, (float*)(lds + 73728), (float*)(lds + 73728 + 20480), tid);
    const int gw = blockIdx.x * 8 + wid, NGW = G * 8;
    constexpr int I_IN0 = 16 * (IN0 / 32), I_OUT = 16 * 32, I_FF1 = 16 * (DFF / 32), I_FF2 = 64 * 32, I_IN1 = 16 * (IN1 / 32);
    constexpr int NITEMS = I_IN0 + I_OUT + I_FF1 + I_FF2 + I_IN1 + I_OUT + I_FF1 + I_FF2;
    constexpr int PASS1_PER_WAVE = 5;
    const int n_late = (G > 96) ? (G - 96) * 8 : 0, pass1 = n_late * PASS1_PER_WAVE < NITEMS ? n_late * PASS1_PER_WAVE : NITEMS;
#pragma unroll 1
    for (int pass = 0; pass < 2; ++pass) {
        int it0, it1, stride, first;
        if (pass == 0) { it0 = 0; it1 = pass1; stride = n_late; first = (int)blockIdx.x >= 96 ? (gw - 96 * 8) : it1; }
        else { it0 = pass1; it1 = NITEMS; stride = NGW; first = gw; }
        if (stride <= 0) continue;
#pragma unroll 1
        for (int it = it0 + first; it < it1; it += stride) {
        int r = it;
        if (r < I_IN0) { p0_transpose_item(a.in[8], DM, IN0, (bf16_t*)(a.ws + WS_WIN0), scr, r, lane); continue; } r -= I_IN0;
        if (r < I_OUT) { p0_transpose_item(a.in[16], DM, DM, (bf16_t*)(a.ws + WS_WOUT0), scr, r, lane); continue; } r -= I_OUT;
        if (r < I_FF1) { p0_transpose_item(a.in[19], DM, DFF, (bf16_t*)(a.ws + WS_WFF1_0), scr, r, lane); continue; } r -= I_FF1;
        if (r < I_FF2) { p0_transpose_item(a.in[20], DFF, DM, (bf16_t*)(a.ws + WS_WFF2_0), scr, r, lane); continue; } r -= I_FF2;
        if (r < I_IN1) { p0_transpose_item(a.in[25], DM, IN1, (bf16_t*)(a.ws + WS_WIN1), scr, r, lane); continue; } r -= I_IN1;
        if (r < I_OUT) { p0_transpose_item(a.in[27], DM, DM, (bf16_t*)(a.ws + WS_WOUT1), scr, r, lane); continue; } r -= I_OUT;
        if (r < I_FF1) { p0_transpose_item(a.in[30], DM, DFF, (bf16_t*)(a.ws + WS_WFF1_1), scr, r, lane); continue; } r -= I_FF1;
        p0_transpose_item(a.in[31], DFF, DM, (bf16_t*)(a.ws + WS_WFF2_1), scr, r, lane);
            }
    }
    for (int i = blockIdx.x * 512 + tid; i < 2 * 131072 / 2; i += G * 512) {
        const bool isk = i < 65536; const int j = isk ? i : i - 65536;
        const float* src = (isk ? a.in[2] : a.in[3]) + (size_t)j * 8;
        const f32x4v x0 = *(const f32x4v*)src, x1 = *(const f32x4v*)(src + 4);
        u32x4v o; o.x = pk2(x0[0], x0[1]); o.y = pk2(x0[2], x0[3]); o.z = pk2(x1[0], x1[1]); o.w = pk2(x1[2], x1[3]);
        *(u32x4v*)((bf16_t*)(a.ws + (isk ? WS_CK : WS_CV)) + (size_t)j * 8) = o;
    }
    if (blockIdx.x == G - 1 && wid == 7) {
        const float s1 = wave_sum(a.in[9][lane] * a.in[10][lane]), s2 = wave_sum(a.in[11][lane] * a.in[12][lane]);
        if (lane == 0) ((float*)(a.ws + WS_MOD))[2 * NCOND * MODW] = __expf(s1) - __expf(s2) + LAMBDA_INIT;
    }
}
__device__ __forceinline__ void p_modulate0(const Args& a) {
    const int tid = opaque_tid(), wid = tid >> 6, lane = tid & 63;
    const float* mod = (const float*)(a.ws + WS_MOD); bf16_t* HB = (bf16_t*)(a.ws + WS_HB);
    for (int row = blockIdx.x * 8 + wid; row < MT; row += gridDim.x * 8) {
        const float* xr = x_in_row(a, row) + 4 * lane; const float* mc = mod + (size_t)row_cond(row) * MODW + 4 * lane;
        unsigned long long* o8 = (unsigned long long*)(HB + (size_t)row * DM) + lane;
#pragma unroll
        for (int j = 0; j < 4; ++j) { const f32x4v x = *(const f32x4v*)(xr + 256 * j), sh = *(const f32x4v*)(mc + 256 * j), sc = *(const f32x4v*)(mc + DM + 256 * j);
            const f32x4v h = x * (sc + 1.f) + sh; o8[64 * j] = (unsigned long long)pk2(h[0], h[1]) | ((unsigned long long)pk2(h[2], h[3]) << 32); }
    }
}
template <bool WRITE_H>
__device__ __forceinline__ void p_layernorm(float* X, const float* __restrict__ g, const float* __restrict__ b, const float* __restrict__ modn, bf16_t* HB) {
    const int tid = opaque_tid(), wid = tid >> 6, lane = tid & 63;
    for (int row = blockIdx.x * 8 + wid; row < MT; row += gridDim.x * 8) {
        float* xr = X + (size_t)row * DM + 4 * lane;
        f32x4v v[4]; float s = 0.f;
#pragma unroll
        for (int j = 0; j < 4; ++j) { v[j] = *(const f32x4v*)(xr + 256 * j); s += (v[j][0] + v[j][1]) + (v[j][2] + v[j][3]); }
        const float mean = wave_sum(s) * (1.f / DM); float s2 = 0.f;
#pragma unroll
        for (int j = 0; j < 4; ++j) { v[j] = v[j] - mean; s2 += (v[j][0] * v[j][0] + v[j][1] * v[j][1]) + (v[j][2] * v[j][2] + v[j][3] * v[j][3]); }
        const float rstd = 1.f / sqrtf(wave_sum(s2) * (1.f / DM) + LN_EPS_F);
        const float* mc = WRITE_H ? modn + (size_t)row_cond(row) * MODW + 4 * lane : nullptr;
        unsigned long long* o8 = WRITE_H ? (unsigned long long*)(HB + (size_t)row * DM) + lane : nullptr;
#pragma unroll
        for (int j = 0; j < 4; ++j) { const f32x4v gg = *(const f32x4v*)(g + 4 * lane + 256 * j), bb = *(const f32x4v*)(b + 4 * lane + 256 * j);
            const f32x4v y = v[j] * rstd * gg + bb; *(f32x4v*)(xr + 256 * j) = y;
            if (WRITE_H) { const f32x4v sh = *(const f32x4v*)(mc + 256 * j), sc = *(const f32x4v*)(mc + DM + 256 * j); const f32x4v h = y * (sc + 1.f) + sh;
                o8[64 * j] = (unsigned long long)pk2(h[0], h[1]) | ((unsigned long long)pk2(h[2], h[3]) << 32); } }
    }
}
__device__ __forceinline__ void p_conv(const Args& a) {
    const int tid = opaque_tid(), wid = tid >> 6, lane = tid & 63;
    const bf16_t* R = (const bf16_t*)(a.ws + WS_R1); bf16_t* MIX = (bf16_t*)(a.ws + WS_HB); const float* cw = a.in[26];
    for (int row = blockIdx.x * 8 + wid; row < MT; row += gridDim.x * 8) {
        const int pos = row < MP ? (row & 255) : ((row - MP) & 4095), len = row < MP ? 256 : 4096;
        const bool hasl = pos > 0, hasr = pos < len - 1;
#pragma unroll
        for (int j = 0; j < 2; ++j) {
            const int c8 = (lane + 64 * j) * 8; const bf16_t* p = R + (size_t)row * IN1 + c8;
            const u32x4v bg = *(const u32x4v*)p, c1 = *(const u32x4v*)(p + 1024), x1 = *(const u32x4v*)(p + 2048);
            u32x4v c0 = {0, 0, 0, 0}, x0 = c0, c2 = c0, x2 = c0;
            if (hasl) { c0 = *(const u32x4v*)(p - IN1 + 1024); x0 = *(const u32x4v*)(p - IN1 + 2048); }
            if (hasr) { c2 = *(const u32x4v*)(p + IN1 + 1024); x2 = *(const u32x4v*)(p + IN1 + 2048); }
            const f32x4v w0a = *(const f32x4v*)(cw + c8), w0b = *(const f32x4v*)(cw + c8 + 4), w1a = *(const f32x4v*)(cw + DM + c8), w1b = *(const f32x4v*)(cw + DM + c8 + 4),
                         w2a = *(const f32x4v*)(cw + 2 * DM + c8), w2b = *(const f32x4v*)(cw + 2 * DM + c8 + 4);
            u32x4v o;
#pragma unroll
            for (int e = 0; e < 4; ++e) {
                const float w0l = e < 2 ? w0a[2 * e] : w0b[2 * e - 4], w0h = e < 2 ? w0a[2 * e + 1] : w0b[2 * e - 3];
                const float w1l = e < 2 ? w1a[2 * e] : w1b[2 * e - 4], w1h = e < 2 ? w1a[2 * e + 1] : w1b[2 * e - 3];
                const float w2l = e < 2 ? w2a[2 * e] : w2b[2 * e - 4], w2h = e < 2 ? w2a[2 * e + 1] : w2b[2 * e - 3];
                const float yl = bf_lo(c0[e]) * bf_lo(x0[e]) * w0l + bf_lo(c1[e]) * bf_lo(x1[e]) * w1l + bf_lo(c2[e]) * bf_lo(x2[e]) * w2l;
                const float yh = bf_hi(c0[e]) * bf_hi(x0[e]) * w0h + bf_hi(c1[e]) * bf_hi(x1[e]) * w1h + bf_hi(c2[e]) * bf_hi(x2[e]) * w2h;
                o[e] = pk2(bf_lo(bg[e]) * yl, bf_hi(bg[e]) * yh);
            }
            *(u32x4v*)(MIX + (size_t)row * DM + c8) = o;
        }
    }
}
__device__ __forceinline__ void p_attention(const Args& a, char* lds) {
    const int tid = opaque_tid(), wid = tid >> 6, lane = tid & 63, r32 = lane & 31, hi = lane >> 5;
    const bf16_t* QB = (const bf16_t*)(a.ws + WS_R1); const bf16_t* KB = QB + (size_t)MT * 512; const bf16_t* VB = KB + (size_t)MT * 512;
    const bf16_t* CK = (const bf16_t*)(a.ws + WS_CK); const bf16_t* CV = (const bf16_t*)(a.ws + WS_CV);
    bf16_t* MIX = (bf16_t*)(a.ws + WS_HB);
    const float lam = ((const float*)(a.ws + WS_MOD))[2 * NCOND * MODW];
    float* o0s = a.out + (((size_t)blockIdx.x * 8 + wid) * 64 + lane) * 64;
    const float* subg = a.in[13];
    for (int ui = blockIdx.x; ui < 256 + 128; ui += gridDim.x) {
        int qrow0, h, ncache, NT; const bf16_t *Kc, *Vc, *Kn, *Vn;
        if (ui < 256) {
            const int xcd = ui & 7, slot = ui >> 3, bh = xcd * 2 + (slot >> 4), qb = slot & 15, b = bh >> 2; h = bh & 3;
            qrow0 = MP + b * 4096 + qb * 256; ncache = 4; NT = 68;
            Kc = CK + (size_t)(b * 256) * 512; Vc = CV + (size_t)(b * 256) * 512; Kn = KB + (size_t)(MP + b * 4096) * 512; Vn = VB + (size_t)(MP + b * 4096) * 512;
        } else { const int p = ui - 256, b = p >> 2; h = p & 3; qrow0 = b * 256; ncache = 0; NT = 4;
            Kn = KB + (size_t)(b * 256) * 512; Vn = VB + (size_t)(b * 256) * 512; Kc = Kn; Vc = Vn; }
        const bf16_t* Qw = QB + (size_t)(qrow0 + wid * 32 + r32) * 512 + h * 128 + hi * 8;
        f32x16 o[4];
        att::attn_half(o, Qw, Kc + h * 128, Vc + h * 128, Kn + h * 128, Vn + h * 128, ncache, NT, lds);
        { float* op = o0s; asm volatile("" : "+v"(op));
#pragma unroll
        for (int d = 0; d < 4; ++d)
#pragma unroll
            for (int r4 = 0; r4 < 4; ++r4) *(f32x4v*)(op + d * 16 + r4 * 4) = (f32x4v){o[d][4 * r4], o[d][4 * r4 + 1], o[d][4 * r4 + 2], o[d][4 * r4 + 3]}; }
        att::attn_half(o, Qw + 64, Kc + h * 128 + 64, Vc + h * 128, Kn + h * 128 + 64, Vn + h * 128, ncache, NT, lds);
        float ss[16];
#pragma unroll
        for (int r = 0; r < 16; ++r) ss[r] = 0.f;
        int hi_ = hi; const float* op = o0s; asm volatile("" : "+v"(op), "+v"(hi_));
#pragma unroll
        for (int d = 0; d < 4; ++d)
#pragma unroll
            for (int r4 = 0; r4 < 4; ++r4) { const f32x4v o0 = *(const f32x4v*)(op + d * 16 + r4 * 4);
#pragma unroll
                for (int e = 0; e < 4; ++e) { const int r = 4 * r4 + e; const float v = o0[e] - lam * o[d][r]; o[d][r] = v; ss[r] += v * v; } }
#pragma unroll
        for (int r = 0; r < 16; ++r) { float s = ss[r]; s += __shfl_xor(s, 1); s += __shfl_xor(s, 2); s += __shfl_xor(s, 4); s += __shfl_xor(s, 8); s += __shfl_xor(s, 16);
            ss[r] = (1.f - LAMBDA_INIT) / sqrtf(s * (1.f / 128.f) + LN_EPS_F); }
        bf16_t* mo = MIX + (size_t)(qrow0 + wid * 32) * DM + h * 128 + r32;
#pragma unroll
        for (int d = 0; d < 4; ++d) { const float gd = subg[d * 32 + r32];
#pragma unroll
            for (int r = 0; r < 16; ++r) { const float v = o[d][r] * ss[r] * gd; mo[(size_t)att::crow(r, hi_) * DM + d * 32] = (bf16_t)(pk2(v, v) & 0xffffu); } }
    }
}
__device__ __forceinline__ void p_sgu(const Args& a, char* lds) {
    const int tid = opaque_tid(), wid = tid >> 6, lane = tid & 63, r32 = lane & 31, hi = lane >> 5, G = gridDim.x;
    const bf16_t* UB = (const bf16_t*)(a.ws + WS_R1) + (size_t)3 * MT * 512; const bf16_t* GB = UB + (size_t)MT * 512;
    bf16_t* MIX = (bf16_t*)(a.ws + WS_HB);
    const float* sw = a.in[14]; const float* sb = a.in[15];
    bf16_t* Wl = (bf16_t*)lds; bf16_t* VT = (bf16_t*)(lds + 34816);
    int u0, nu; if (G == 256) { if ((int)blockIdx.x < 128) { u0 = blockIdx.x * 2; nu = 2; } else { u0 = 256 + (blockIdx.x - 128) * 4; nu = 4; } } else { u0 = 0; nu = 0; }
    for (int k = 0; (G == 256) ? (k < nu) : ((int)blockIdx.x + k * G < 768); ++k) {
        const int su = (G == 256) ? u0 + k : (int)blockIdx.x + k * G;
        const int chunk = su >> 2, g = su & 3, row0 = chunk * 128;
        __syncthreads();
        for (int it = 0; it < 8; ++it) { const int idx = (it * 512 + tid) * 4, p = idx >> 7, q = idx & 127;
            const f32x4v w = *(const f32x4v*)(sw + (size_t)g * 16384 + idx);
            u32x2v o; o.x = pk2(w[0], w[1]); o.y = pk2(w[2], w[3]); *(u32x2v*)(Wl + p * 136 + q) = o; }
#pragma unroll
        for (int it = 0; it < 4; ++it) { const int tok = wid * 16 + it * 4 + (lane >> 4), d0 = (lane & 15) * 8;
            const u32x4v x = *(const u32x4v*)(GB + (size_t)(row0 + tok) * 512 + g * 128 + d0);
            float f[8];
#pragma unroll
            for (int e = 0; e < 4; ++e) { f[2 * e] = bf_lo(x[e]); f[2 * e + 1] = bf_hi(x[e]); }
            float s = 0.f;
#pragma unroll
            for (int e = 0; e < 8; ++e) s += f[e];
            s += __shfl_xor(s, 1); s += __shfl_xor(s, 2); s += __shfl_xor(s, 4); s += __shfl_xor(s, 8);
            const float mean = s * (1.f / 128.f); float q2 = 0.f;
#pragma unroll
            for (int e = 0; e < 8; ++e) { f[e] -= mean; q2 += f[e] * f[e]; }
            q2 += __shfl_xor(q2, 1); q2 += __shfl_xor(q2, 2); q2 += __shfl_xor(q2, 4); q2 += __shfl_xor(q2, 8);
            const float rstd = 1.f / sqrtf(q2 * (1.f / 128.f) + LN_EPS_F);
#pragma unroll
            for (int e = 0; e < 8; ++e) VT[(d0 + e) * 136 + tok] = (bf16_t)(pk2(f[e] * rstd, 0.f) & 0xffffu);
        }
        __syncthreads();
        const int pbase = (wid & 3) * 32, dbase = (wid >> 2) * 64;
        f32x16 acc[2] = {f32x16{}, f32x16{}};
#pragma unroll
        for (int ks = 0; ks < 8; ++ks) {
            const bf16x8v bw = *(const bf16x8v*)(Wl + (pbase + r32) * 136 + ks * 16 + hi * 8);
#pragma unroll
            for (int ds = 0; ds < 2; ++ds) { const bf16x8v av = *(const bf16x8v*)(VT + (dbase + ds * 32 + r32) * 136 + ks * 16 + hi * 8);
                acc[ds] = __builtin_amdgcn_mfma_f32_32x32x16_bf16(av, bw, acc[ds], 0, 0, 0); }
        }
        const int p = pbase + r32; const float bias = sb[g * 128 + p];
        const bf16_t* up = UB + (size_t)(row0 + p) * 512 + g * 128; bf16_t* mo = MIX + (size_t)(row0 + p) * DM + 512 + g * 128;
#pragma unroll
        for (int ds = 0; ds < 2; ++ds)
#pragma unroll
            for (int rq = 0; rq < 4; ++rq) { const int d = dbase + ds * 32 + 8 * rq + 4 * hi;
                const u32x2v uu = *(const u32x2v*)(up + d);
                u32x2v o; o.x = pk2(bf_lo(uu.x) * (acc[ds][4 * rq] + bias), bf_hi(uu.x) * (acc[ds][4 * rq + 1] + bias));
                o.y = pk2(bf_lo(uu.y) * (acc[ds][4 * rq + 2] + bias), bf_hi(uu.y) * (acc[ds][4 * rq + 3] + bias));
                *(u32x2v*)(mo + d) = o; }
    }
}
constexpr int NPHASE = 20;
#ifndef PHMASK
#define PHMASK 0xfffff
#endif
#define PM(i) ((PHMASK >> (i)) & 1)
#ifndef PROBE_REP
#define PROBE_REP 0
#endif
#define NREP(i) (1 + ((PROBE_REP >> (i)) & 1))
__global__ void __launch_bounds__(512, 2) mega_fwd(Args a) {
    extern __shared__ __attribute__((aligned(16))) unsigned char lds_raw[];
    char* lds = (char*)lds_raw;
    PG8_LAS unsigned char* glds = (PG8_LAS unsigned char*)lds_raw;
    cg::grid_group grid = cg::this_grid();
    volatile LAS unsigned* MISC = (volatile LAS unsigned*)(glds + 131072);
    if (threadIdx.x < 16) MISC[threadIdx.x] = 0u;
    __syncthreads();
    unsigned* const barw = (unsigned*)(a.ws + WS_CTL);
    XcdBarrier xbar; xbar.bar = barw; xbar.x = 0; xbar.st = nullptr;
    const int lo = a.ph_lo, hi = a.ph_hi, G = gridDim.x, bx = blockIdx.x;
    float* const mod = (float*)(a.ws + WS_MOD);
    float* const X = a.out;
    bf16_t* const HB = (bf16_t*)(a.ws + WS_HB);
    bf16_t* const R1 = (bf16_t*)(a.ws + WS_R1);
#define IN(k) (lo <= (k) && (k) < hi)
#define SEAM(k) do { if (IN(k) && IN((k) + 1)) { xcd_barrier(xbar); if ((PROBE_REP >> 20) & 1) xcd_barrier(xbar); } } while (0)
    int ph = 0;
    for (int rep = 0; rep < NREP(0); ++rep) { if (PM(0) && IN(ph)) p0_prologue(a, lds); __syncthreads(); }
    if (IN(ph) && bx == 0) for (int i = threadIdx.x; i < XCD_BAR_WORDS; i += 512) __hip_atomic_store(barw + i, 0u, __ATOMIC_RELAXED, __HIP_MEMORY_SCOPE_AGENT);
    if (IN(ph) && IN(ph + 1)) { grid.sync();
        xbar = xcd_barrier_post(barw, MISC + 8); }
    ++ph;
    for (int rep = 0; rep < NREP(1); ++rep) if (PM(1) && IN(ph)) p_modulate0(a);
    SEAM(ph); ++ph;
#pragma unroll 1
    for (int layer = 0; layer < 2; ++layer) {
        const float* lmod = mod + (size_t)layer * NCOND * MODW;
        const bf16_t* w_in = (const bf16_t*)(a.ws + (layer ? WS_WIN1 : WS_WIN0)); const bf16_t* w_out = (const bf16_t*)(a.ws + (layer ? WS_WOUT1 : WS_WOUT0));
        const bf16_t* w_ff1 = (const bf16_t*)(a.ws + (layer ? WS_WFF1_1 : WS_WFF1_0)); const bf16_t* w_ff2 = (const bf16_t*)(a.ws + (layer ? WS_WFF2_1 : WS_WFF2_0));
        const float* g_mix = a.in[layer ? 28 : 17]; const float* b_mix = a.in[layer ? 29 : 18]; const float* g_ff = a.in[layer ? 32 : 21]; const float* b_ff = a.in[layer ? 33 : 22];
        for (int rep = 0; rep < NREP(2); ++rep) if (IN(ph)) {
            if (PM(2) && layer == 0) { pg8::Gemm g{HB, w_in, MT, IN0, DM}; pg8::StaticOrder S; S.init(MT, IN0, G, bx);
                pg8::EpiInProj0 E{R1, a.out + (size_t)MT * DM, a.out + (size_t)MT * DM + (size_t)MP * 512};
                pg8::gemm_phase<pg8::EpiInProj0, pg8::StaticOrder, true, true>(glds, g, S, E);
            } else if (PM(3) && layer == 1) { pg8::Gemm g{HB, w_in, MT, IN1, DM}; pg8::StaticOrder S; S.init(MT, IN1, G, bx);
                pg8::EpiAct<0> E{R1, IN1};
                pg8::gemm_phase<pg8::EpiAct<0>, pg8::StaticOrder, true, true>(glds, g, S, E); }
        }
        SEAM(ph); ++ph;
        if (IN(ph)) { if (layer == 0) { for (int rep = 0; rep < NREP(4); ++rep) { if (PM(4)) p_attention(a, lds); } for (int rep = 0; rep < NREP(5); ++rep) { if (PM(5)) p_sgu(a, lds); } } else for (int rep = 0; rep < NREP(6); ++rep) { if (PM(6)) p_conv(a); } }
        SEAM(ph); ++ph;
        if (PM(7) && IN(ph)) { pg8::Gemm g{HB, w_out, MT, DM, DM}; pg8::StaticOrder S; S.init(MT, DM, G, bx);
            pg8::EpiResid E{layer == 0 ? a.in[0] : X, layer == 0 ? a.in[1] : X + (size_t)MP * DM, X, lmod + 2 * DM, 0};
            pg8::gemm_phase<pg8::EpiResid, pg8::StaticOrder, true, true>(glds, g, S, E); }
        SEAM(ph); ++ph;
        if (PM(8) && IN(ph)) p_layernorm<true>(X, g_mix, b_mix, lmod + 3 * DM, HB);
        SEAM(ph); ++ph;
#pragma unroll 1
        for (int half = 0; half < 2; ++half) {
            for (int rep = 0; rep < NREP(9); ++rep) if (PM(9) && IN(ph)) { pg8::Gemm g{HB + (size_t)half * MHALF * DM, w_ff1, MHALF, DFF, DM}; pg8::StaticOrder S; S.init(MHALF, DFF, G, bx);
                pg8::EpiAct<1> E{R1, DFF};
                pg8::gemm_phase<pg8::EpiAct<1>, pg8::StaticOrder, true, true>(glds, g, S, E); }
            SEAM(ph); ++ph;
            if (PM(10) && IN(ph)) { pg8::Gemm g{R1, w_ff2, MHALF, DM, DFF}; pg8::StaticOrder S; S.init(MHALF, DM, G, bx);
                pg8::EpiResid E{X, X + (size_t)MP * DM, X, lmod + 5 * DM, half * (MHALF / 256)};
                pg8::gemm_phase<pg8::EpiResid, pg8::StaticOrder, true, true>(glds, g, S, E); }
            SEAM(ph); ++ph;
        }
        if (PM(11) && IN(ph)) { if (layer == 0) p_layernorm<true>(X, g_ff, b_ff, mod + (size_t)NCOND * MODW, HB); else p_layernorm<false>(X, g_ff, b_ff, nullptr, nullptr); }
        if (layer == 0) SEAM(ph);
        ++ph;
    }
#undef IN
#undef SEAM
}

extern "C" void kernel_launch(void* const* d_in, const int* in_sizes, int n_in, void* d_out, int out_size, void* d_ws, size_t ws_size, hipStream_t stream) {
    static int ready = 0;
    if (ready == 0) {
        if (n_in != 34 || ws_size < WS_END) { fprintf(stderr, "kernel_launch: built for 34 inputs and >= %zu bytes of workspace; got n_in %d ws %zu\n", (size_t)WS_END, n_in, ws_size); ready = -1; return; }
        if (hipFuncSetAttribute((const void*)mega_fwd, hipFuncAttributeMaxDynamicSharedMemorySize, LDS_BYTES) != hipSuccess) { fprintf(stderr, "kernel_launch: hipFuncSetAttribute failed\n"); ready = -1; return; }
        int dev = 0, cus = 0, per_cu = 0;
        hipGetDevice(&dev); hipDeviceGetAttribute(&cus, hipDeviceAttributeMultiprocessorCount, dev);
        hipOccupancyMaxActiveBlocksPerMultiprocessor(&per_cu, (const void*)mega_fwd, 512, LDS_BYTES);
        if (cus * per_cu < 256) { fprintf(stderr, "kernel_launch: resident capacity %d x %d < 256 workgroups\n", cus, per_cu); ready = -1; return; }
        ready = 1;
    }
    if (ready < 0) return;
    Args a{};
    for (int i = 0; i < 34; ++i) a.in[i] = (const float*)d_in[i];
    a.out = (float*)d_out; a.ws = (unsigned char*)d_ws;
#if MK_PER_PHASE
    for (int p = 0; p < NPHASE; ++p) { a.ph_lo = p; a.ph_hi = p + 1; hipLaunchKernelGGL(mega_fwd, dim3(256), dim3(512), LDS_BYTES, stream, a); }
#else
    a.ph_lo = 0; a.ph_hi = NPHASE;
    void* args[] = {&a};
    hipError_t e = hipLaunchCooperativeKernel((const void*)mega_fwd, dim3(256), dim3(512), args, LDS_BYTES, stream);
    if (e != hipSuccess) fprintf(stderr, "cooperative launch failed: %s\n", hipGetErrorString(e));
#endif
}
```

```cpp
#include <hip/hip_runtime.h>
#include <hip/hip_cooperative_groups.h>
#include <hip/hip_bf16.h>
#include <cstdio>
#include <cstdint>
namespace cg = cooperative_groups;

#ifndef MK_PER_PHASE
#define MK_PER_PHASE 0
#endif

constexpr int DM = 1024, MP = 8192, MS = 16384, MT = MP + MS;
constexpr int NCOND = 5, MODW = 6 * DM;
constexpr int IN0 = 2560, IN1 = 3072, DFF = 4096;
constexpr float ALPHA_F = 1.4142135623730951f;
constexpr float LN_EPS_F = 1e-5f;
constexpr float LAMBDA_INIT = 0.2f;
constexpr int MHALF = MT / 2;

constexpr size_t WS_MOD  = 0;
constexpr size_t WS_CTL  = 246272;
constexpr size_t WS_CK   = 262144;
constexpr size_t WS_CV   = WS_CK + 1048576;
constexpr size_t WS_WIN0 = WS_CV + 1048576;
constexpr size_t WS_WOUT0 = WS_WIN0 + (size_t)IN0 * DM * 2;
constexpr size_t WS_WFF1_0 = WS_WOUT0 + (size_t)DM * DM * 2;
constexpr size_t WS_WFF2_0 = WS_WFF1_0 + (size_t)DFF * DM * 2;
constexpr size_t WS_WIN1 = WS_WFF2_0 + (size_t)DFF * DM * 2;
constexpr size_t WS_WOUT1 = WS_WIN1 + (size_t)IN1 * DM * 2;
constexpr size_t WS_WFF1_1 = WS_WOUT1 + (size_t)DM * DM * 2;
constexpr size_t WS_WFF2_1 = WS_WFF1_1 + (size_t)DFF * DM * 2;
constexpr size_t WS_HB   = WS_WFF2_1 + (size_t)DFF * DM * 2;
constexpr size_t WS_R1   = WS_HB + (size_t)MT * DM * 2;
constexpr size_t WS_END  = WS_R1 + (size_t)MT * IN1 * 2;
static_assert(WS_END <= 268435456ull, "workspace budget (256 MiB)");
static_assert((size_t)MHALF * DFF * 2 <= (size_t)MT * IN1 * 2, "hidden half fits R1");
constexpr int LDS_BYTES = 131072 + 4096;

__device__ __forceinline__ int opaque_tid() { int t = threadIdx.x; asm volatile("" : "+v"(t)); return t; }
namespace pg8 {
#define PG8_LAS __attribute__((address_space(3)))
typedef unsigned short bf16_t;
typedef short bf16x8 __attribute__((ext_vector_type(8)));
typedef float f32x4 __attribute__((ext_vector_type(4)));
typedef unsigned u32x4 __attribute__((ext_vector_type(4)));
constexpr int BM = 256, BK = 64, HALF = 128, HTB = HALF * BK * 2  , STAGE_BYTES = 8 * HTB, NXCD = 8, WGM = 8;

__host__ __device__ __forceinline__ int lds_byte(int r, int c) { const int st = (r >> 4) * 2 + (c >> 5), rr = r & 15, cc = c & 31, ob = rr * 64 + cc * 2; return st * 1024 + (ob ^ (((ob >> 9) & 1) << 5)); }
__host__ __device__ __forceinline__ void stage_rc(int b, int& R, int& C) { const int st = b / 1024, sb = b % 1024, swz = sb ^ (((sb >> 9) & 1) << 5); R = (st >> 1) * 16 + swz / 64; C = (st & 1) * 32 + (swz % 64) / 2; }
__host__ __device__ __forceinline__ int perm32(int rho) { const int n = rho >> 4, i = rho & 15; return 8 * (i >> 2) + 4 * n + (i & 3); }

struct Unit { int pm, pn; };
struct Gemm { const bf16_t* A; const bf16_t* Bt; int M, N, K, ld; };

struct StaticOrder {
    int nM, nN, nwg, G, c;
    __host__ __device__ void init(int M, int N, int G_, int c_) { nM = M / BM; nN = N / BM; nwg = nM * nN; G = G_; c = c_; }
    __host__ __device__ bool next(int i, Unit& u) const {
        const long L = (long)i * G + c; if (L >= nwg) return false;
        int wgid = (int)L; { const int q = nwg / NXCD, r = nwg % NXCD, xcd = wgid % NXCD, off = wgid / NXCD; wgid = (xcd < r ? xcd * (q + 1) : r * (q + 1) + (xcd - r) * q) + off; }
        const int nig = WGM * nN, gid = wgid / nig, fm = gid * WGM, gsz = (nM - fm) < WGM ? (nM - fm) : WGM;
        u.pm = fm + ((wgid % nig) % gsz); u.pn = (wgid % nig) / gsz; return true;
    }
    __device__ __forceinline__ void a_ready(const Unit&) const {}
    __device__ __forceinline__ void done(const Unit&) const {}
};
__device__ __forceinline__ unsigned cvt_pk_bf16(float lo, float hi) { unsigned r; asm volatile("v_cvt_pk_bf16_f32 %0, %1, %2" : "=v"(r) : "v"(lo), "v"(hi)); return r; }
typedef float f32x2 __attribute__((ext_vector_type(2)));
typedef unsigned u32x2 __attribute__((ext_vector_type(2)));
struct EpiInProj0 {
    static constexpr bool PERM = false, AFTER_DRAIN = false;
    bf16_t* O; float* newk; float* newv;
    __device__ __forceinline__ void operator()(const f32x4 (&acc)[2][2][4][2], const Unit& u, int wr, int wc, int fr, int fq) const {
        const int t = u.pn >> 1;
        bf16_t* base = O + (size_t)t * ((size_t)MT * 512);
        const int colt = (u.pn & 1) * 256 + wc * 32 + 4 * fq;
        const bool rope = (t <= 1) && (u.pm >= MP / 256);
        float* f32o = (u.pm < MP / 256) ? (t == 1 ? newk : (t == 2 ? newv : nullptr)) : nullptr;
        float inv[4];
#pragma unroll
        for (int e = 0; e < 4; ++e) inv[e] = __builtin_amdgcn_exp2f(-(float)(4 * fq + e) * (13.287712379549449f / 16.0f));
#pragma unroll
        for (int ai = 0; ai < 2; ++ai)
#pragma unroll
            for (int m = 0; m < 4; ++m) {
                const int row = u.pm * BM + ai * HALF + wr * 64 + m * 16 + fr;
                f32x4 v[2][2];
#pragma unroll
                for (int bj = 0; bj < 2; ++bj) { v[bj][0] = acc[ai][bj][m][0]; v[bj][1] = acc[ai][bj][m][1]; }
                if (rope) {
                    const int tok = (row - MP) & 4095; const float pos = (float)((wc & 1) ? (tok & 63) : (tok >> 6));
                    f32x4 cs, sn;
#pragma unroll
                    for (int e = 0; e < 4; ++e) { const float a = pos * inv[e]; cs[e] = __cosf(a); sn[e] = __sinf(a); }
#pragma unroll
                    for (int bj = 0; bj < 2; ++bj) { const f32x4 x1 = v[bj][0], x2 = v[bj][1]; v[bj][0] = x1 * cs - x2 * sn; v[bj][1] = x1 * sn + x2 * cs; }
                }
                bf16_t* rowp = base + (size_t)row * 512 + colt;
#pragma unroll
                for (int bj = 0; bj < 2; ++bj)
#pragma unroll
                    for (int n = 0; n < 2; ++n) { u32x2 w; w.x = cvt_pk_bf16(v[bj][n][0], v[bj][n][1]); w.y = cvt_pk_bf16(v[bj][n][2], v[bj][n][3]); *(u32x2*)(rowp + bj * HALF + n * 16) = w; }
                if (f32o) { float* fp = f32o + (size_t)row * 512 + colt;
#pragma unroll
                    for (int bj = 0; bj < 2; ++bj)
#pragma unroll
                        for (int n = 0; n < 2; ++n) *(f32x4*)(fp + bj * HALF + n * 16) = v[bj][n]; }
            }
    }
};
struct EpiResid {
    static constexpr bool PERM = true, AFTER_DRAIN = false;
    const float* xp; const float* xs; const bf16_t* xb; bf16_t* yout; const float* gate; int pm_off; float* P; int helper;
    __device__ __forceinline__ void operator()(const f32x4 (&acc)[2][2][4][2], const Unit& u, int wr, int wc, int fr, int fq) const {
        const int pm = u.pm + pm_off; const int cond = pm < MP / 256 ? 0 : 1 + ((pm - MP / 256) >> 4);
        const int col0 = u.pn * BM + wc * 32 + 8 * fq; const float* g = gate + (size_t)cond * MODW + col0;
        f32x4 gv[2][2];
#pragma unroll
        for (int bj = 0; bj < 2; ++bj)
#pragma unroll
            for (int n = 0; n < 2; ++n) gv[bj][n] = *(const f32x4*)(g + bj * HALF + n * 4);
#pragma unroll
        for (int ai = 0; ai < 2; ++ai)
#pragma unroll
            for (int m = 0; m < 4; ++m) {
                const int row = pm * BM + ai * HALF + wr * 64 + m * 16 + fr;
                if (helper) { float* pp = P + (size_t)(row - pm_off * BM) * DM + col0;
#pragma unroll
                    for (int bj = 0; bj < 2; ++bj)
#pragma unroll
                        for (int n = 0; n < 2; ++n) *(f32x4*)(pp + bj * HALF + n * 4) = gv[bj][n] * acc[ai][bj][m][n];
                } else {
                    bf16_t* op = yout + (size_t)row * DM + col0;
#pragma unroll
                    for (int bj = 0; bj < 2; ++bj) { f32x4 x0, x1;
                        if (xb) { const u32x4 w = *(const u32x4*)(xb + (size_t)row * DM + col0 + bj * HALF);
                            x0 = (f32x4){__uint_as_float(w.x << 16), __uint_as_float(w.x & 0xffff0000u), __uint_as_float(w.y << 16), __uint_as_float(w.y & 0xffff0000u)};
                            x1 = (f32x4){__uint_as_float(w.z << 16), __uint_as_float(w.z & 0xffff0000u), __uint_as_float(w.w << 16), __uint_as_float(w.w & 0xffff0000u)};
                        } else { const float* xin = (row < MP ? xp + (size_t)row * DM : xs + (size_t)(row - MP) * DM) + col0 + bj * HALF; x0 = *(const f32x4*)xin; x1 = *(const f32x4*)(xin + 4); }
                        const f32x4 y0 = x0 * ALPHA_F + gv[bj][0] * acc[ai][bj][m][0], y1 = x1 * ALPHA_F + gv[bj][1] * acc[ai][bj][m][1];
                        u32x4 o; o.x = cvt_pk_bf16(y0[0], y0[1]); o.y = cvt_pk_bf16(y0[2], y0[3]); o.z = cvt_pk_bf16(y1[0], y1[1]); o.w = cvt_pk_bf16(y1[2], y1[3]);
                        *(u32x4*)(op + bj * HALF) = o; }
                }
            }
    }
};
template <int ACT> struct EpiAct {
    static constexpr bool PERM = true, AFTER_DRAIN = false;
    bf16_t* O; int ldc;
    __device__ __forceinline__ void operator()(const f32x4 (&acc)[2][2][4][2], const Unit& u, int wr, int wc, int fr, int fq) const {
        const int row0 = u.pm * BM + wr * 64 + fr; const int col0 = u.pn * BM + wc * 32 + 8 * fq;
#pragma unroll
        for (int ai = 0; ai < 2; ++ai)
#pragma unroll
            for (int m = 0; m < 4; ++m) { bf16_t* rowp = O + (size_t)(row0 + ai * HALF + m * 16) * ldc + col0;
#pragma unroll
                for (int bj = 0; bj < 2; ++bj) { f32x4 v0 = acc[ai][bj][m][0], v1 = acc[ai][bj][m][1];
                    if (ACT == 1) { v0 = __builtin_elementwise_max(v0, (f32x4){0.f, 0.f, 0.f, 0.f}); v1 = __builtin_elementwise_max(v1, (f32x4){0.f, 0.f, 0.f, 0.f}); v0 = v0 * v0; v1 = v1 * v1; }
                    u32x4 w; w.x = cvt_pk_bf16(v0[0], v0[1]); w.y = cvt_pk_bf16(v0[2], v0[3]); w.z = cvt_pk_bf16(v1[0], v1[1]); w.w = cvt_pk_bf16(v1[2], v1[3]);
                    *(u32x4*)(rowp + bj * HALF) = w; } }
    }
};

struct SplitOrder {
    int c;
    __device__ __forceinline__ bool next(int i, Unit& u) const {
        if (c < 192) { if (i > 0) return false; StaticOrder s; s.init(MHALF, DM, 192, c); return s.next(0, u); }
        if (i >= 3) return false; const int t = 3 * (c - 192) + i; u.pm = t >> 2; u.pn = t & 3; return true;
    }
    __device__ __forceinline__ void a_ready(const Unit&) const {}
    __device__ __forceinline__ void done(const Unit&) const {}
};
template <class Epi, class Sched, bool ALIGN_EPI = false, bool SP2 = false>
__device__ __forceinline__ void gemm_phase(PG8_LAS unsigned char* lds, const Gemm g, const Sched& S, const Epi& E) {
    const int tid = opaque_tid(), wid = __builtin_amdgcn_readfirstlane(tid >> 6), lane = tid & 63, wr = wid >> 2, wc = wid & 3, fr = lane & 15, fq = lane >> 4;
    const int K = g.ld, nt = g.K / BK;
    unsigned voffA[2], voffB[2];
#pragma unroll
    for (int i = 0; i < 2; ++i) { int R, C; stage_rc(tid * 16 + i * 8192, R, C); const int Rb = Epi::PERM ? ((R & ~31) + perm32(R & 31)) : R;
        voffA[i] = (unsigned)(R * K + C) * 2u; voffB[i] = (unsigned)(Rb * K + C) * 2u; }
    const size_t kstep = (size_t)(BK * 2);
    const size_t hstep = (size_t)HALF * K * 2;
    const size_t tstep = 2 * hstep;
    const unsigned ldsw = (unsigned)wid * 1024u;
    const int aoff = lds_byte(wr * 64 + fr, fq * 8), boff = lds_byte(wc * 32 + fr, fq * 8);
#define PG8_SA(b, h) (((b) * 2 + (h)) * HTB)
#define PG8_SB(b, h) ((4 + (b) * 2 + (h)) * HTB)
#define PG8_STAGE(bufoff, gbase, voff) do { _Pragma("unroll") for (int _i = 0; _i < 2; ++_i) \
        __builtin_amdgcn_global_load_lds((const unsigned*)((const char*)(gbase) + (voff)[_i]), (PG8_LAS unsigned*)(lds + (bufoff) + ldsw + _i * 8192), 16, 0, 0); } while (0)
#define PG8_LDA(dst, b, h) do { _Pragma("unroll") for (int m = 0; m < 4; ++m) _Pragma("unroll") for (int k = 0; k < 2; ++k) dst[m][k] = *(const PG8_LAS bf16x8*)(lds + PG8_SA(b, h) + aoff + m * 2048 + k * 1024); } while (0)
#define PG8_LDB(dst, b, h) do { _Pragma("unroll") for (int n = 0; n < 2; ++n) _Pragma("unroll") for (int k = 0; k < 2; ++k) dst[n][k] = *(const PG8_LAS bf16x8*)(lds + PG8_SB(b, h) + boff + n * 2048 + k * 1024); } while (0)
#define PG8_MMA(ai, bj, At, Bt) do { __builtin_amdgcn_s_setprio(1); _Pragma("unroll") for (int m = 0; m < 4; ++m) _Pragma("unroll") for (int n = 0; n < 2; ++n) _Pragma("unroll") for (int k = 0; k < 2; ++k) \
        acc[ai][bj][m][n] = __builtin_amdgcn_mfma_f32_16x16x32_bf16(Bt[n][k], At[m][k], acc[ai][bj][m][n], 0, 0, 0); __builtin_amdgcn_s_setprio(0); } while (0)
#define PG8_WAIT_V(n) asm volatile("s_waitcnt vmcnt(" #n ")" ::: "memory")
#define PG8_WAIT_L(n) asm volatile("s_waitcnt lgkmcnt(" #n ")" ::: "memory")
#define PG8_BAR __builtin_amdgcn_s_barrier()
#define PG8_SCHED __builtin_amdgcn_sched_barrier(0)
    Unit cur, nxt; int ui = 0;
    if (!S.next(0, cur)) return;
    f32x4 acc[2][2][4][2];
#pragma unroll
    for (int a = 0; a < 2; ++a)
#pragma unroll
        for (int b = 0; b < 2; ++b)
#pragma unroll
            for (int m = 0; m < 4; ++m)
#pragma unroll
                for (int n = 0; n < 2; ++n) acc[a][b][m][n] = (f32x4){0.f, 0.f, 0.f, 0.f};
    bf16x8 At[4][2], B0[2][2], B1[2][2];
    const char* cA = (const char*)g.A + (size_t)cur.pm * tstep; const char* cB = (const char*)g.Bt + (size_t)cur.pn * tstep;
    S.a_ready(cur);
    if constexpr (SP2) {
        PG8_STAGE(PG8_SB(0, 0), cB, voffB); PG8_STAGE(PG8_SB(0, 1), cB + hstep, voffB); PG8_STAGE(PG8_SA(0, 0), cA, voffA); PG8_STAGE(PG8_SA(0, 1), cA + hstep, voffA);
        if (wr == 1) PG8_BAR;
        PG8_WAIT_V(2); PG8_BAR;
        PG8_STAGE(PG8_SB(1, 0), cB + kstep, voffB); PG8_STAGE(PG8_SA(1, 0), cA + kstep, voffA); PG8_STAGE(PG8_SB(1, 1), cB + hstep + kstep, voffB);
        PG8_WAIT_V(6); PG8_BAR;
    } else {
        PG8_STAGE(PG8_SB(0, 0), cB, voffB); PG8_STAGE(PG8_SA(0, 0), cA, voffA); PG8_STAGE(PG8_SB(0, 1), cB + hstep, voffB); PG8_STAGE(PG8_SA(0, 1), cA + hstep, voffA);
        if (wr == 1) PG8_BAR;
        PG8_WAIT_V(4); PG8_BAR;
        PG8_STAGE(PG8_SB(1, 0), cB + kstep, voffB); PG8_STAGE(PG8_SA(1, 0), cA + kstep, voffA); PG8_STAGE(PG8_SB(1, 1), cB + hstep + kstep, voffB);
        PG8_WAIT_V(6); PG8_BAR;
    }
    for (;;) {
        const bool has_next = S.next(ui + 1, nxt);
        const char* nA = has_next ? (const char*)g.A + (size_t)nxt.pm * tstep : cA; const char* nB = has_next ? (const char*)g.Bt + (size_t)nxt.pn * tstep : cB;
        for (int t = 0; t < nt; t += 2) {
            const bool last = (t == nt - 2);
            const char* a1 = cA + (size_t)(t + 1) * kstep;
            const char* a2 = last ? nA : cA + (size_t)(t + 2) * kstep; const char* b2 = last ? nB : cB + (size_t)(t + 2) * kstep;
            const char* a3 = a2 + kstep; const char* b3 = b2 + kstep;
            if (last && has_next) S.a_ready(nxt);
            if constexpr (SP2) {
            PG8_LDB(B0, 0, 0); PG8_LDB(B1, 0, 1); PG8_SCHED; PG8_LDA(At, 0, 0); PG8_STAGE(PG8_SA(1, 1), a1 + hstep, voffA);
            PG8_WAIT_V(8); PG8_WAIT_L(0); PG8_BAR; PG8_MMA(0, 0, At, B0); PG8_MMA(0, 1, At, B1); PG8_BAR; PG8_SCHED;
            PG8_LDA(At, 0, 1); PG8_STAGE(PG8_SB(0, 0), b2, voffB); PG8_STAGE(PG8_SB(0, 1), b2 + hstep, voffB); PG8_STAGE(PG8_SA(0, 0), a2, voffA);
            PG8_WAIT_V(8); PG8_WAIT_L(0); PG8_BAR; PG8_MMA(1, 0, At, B0); PG8_MMA(1, 1, At, B1); PG8_BAR; PG8_SCHED;
            PG8_LDB(B0, 1, 0); PG8_LDB(B1, 1, 1); PG8_SCHED; PG8_LDA(At, 1, 0); PG8_STAGE(PG8_SA(0, 1), a2 + hstep, voffA);
            PG8_WAIT_V(8); PG8_WAIT_L(0); PG8_BAR; PG8_MMA(0, 0, At, B0); PG8_MMA(0, 1, At, B1); PG8_BAR; PG8_SCHED;
            PG8_LDA(At, 1, 1); PG8_STAGE(PG8_SB(1, 0), b3, voffB); PG8_STAGE(PG8_SB(1, 1), b3 + hstep, voffB); PG8_STAGE(PG8_SA(1, 0), a3, voffA);
            PG8_WAIT_V(8); PG8_WAIT_L(0); PG8_BAR; PG8_MMA(1, 0, At, B0); PG8_MMA(1, 1, At, B1); PG8_BAR; PG8_SCHED;
            } else {
            PG8_LDB(B0, 0, 0); PG8_SCHED; PG8_LDA(At, 0, 0); PG8_STAGE(PG8_SA(1, 1), a1 + hstep, voffA);
            PG8_WAIT_L(8); PG8_BAR; PG8_WAIT_L(0); PG8_MMA(0, 0, At, B0); PG8_BAR; PG8_SCHED;
            PG8_LDB(B1, 0, 1); PG8_STAGE(PG8_SB(0, 0), b2, voffB);
            PG8_BAR; PG8_WAIT_L(0); PG8_MMA(0, 1, At, B1); PG8_BAR;
            PG8_LDA(At, 0, 1); PG8_STAGE(PG8_SA(0, 0), a2, voffA);
            PG8_BAR; PG8_WAIT_L(0); PG8_MMA(1, 0, At, B0); PG8_BAR; PG8_SCHED;
            PG8_STAGE(PG8_SB(0, 1), b2 + hstep, voffB);
            PG8_WAIT_V(6); PG8_BAR; PG8_MMA(1, 1, At, B1); PG8_BAR;
            PG8_LDB(B0, 1, 0); PG8_SCHED; PG8_LDA(At, 1, 0); PG8_STAGE(PG8_SA(0, 1), a2 + hstep, voffA);
            PG8_WAIT_L(8); PG8_BAR; PG8_WAIT_L(0); PG8_MMA(0, 0, At, B0); PG8_BAR; PG8_SCHED;
            PG8_LDB(B1, 1, 1); PG8_STAGE(PG8_SB(1, 0), b3, voffB);
            PG8_BAR; PG8_WAIT_L(0); PG8_MMA(0, 1, At, B1); PG8_BAR;
            PG8_LDA(At, 1, 1); PG8_STAGE(PG8_SA(1, 0), a3, voffA);
            PG8_BAR; PG8_WAIT_L(0); PG8_MMA(1, 0, At, B0); PG8_BAR; PG8_SCHED;
            PG8_STAGE(PG8_SB(1, 1), b3 + hstep, voffB);
            PG8_WAIT_V(6); PG8_BAR; PG8_MMA(1, 1, At, B1); PG8_BAR;
            }
        }
        if constexpr (ALIGN_EPI) { if (wr == 0) PG8_BAR; }
        if constexpr (!Epi::AFTER_DRAIN) { E(acc, cur, wr, wc, fr, fq); S.done(cur); }
        if (!has_next) break;
#pragma unroll
        for (int a = 0; a < 2; ++a)
#pragma unroll
            for (int b = 0; b < 2; ++b)
#pragma unroll
                for (int m = 0; m < 4; ++m)
#pragma unroll
                    for (int n = 0; n < 2; ++n) acc[a][b][m][n] = (f32x4){0.f, 0.f, 0.f, 0.f};
        cur = nxt; cA = nA; cB = nB; ++ui;
        if constexpr (ALIGN_EPI) { if (wr == 1) PG8_BAR; }
    }
    PG8_WAIT_V(0);
    if constexpr (!ALIGN_EPI) { if (wr == 0) PG8_BAR; }
    PG8_BAR;
    if constexpr (Epi::AFTER_DRAIN) { E.fused(acc, cur, wr, wc, fr, fq, lds, wid, lane); S.done(cur); }
#undef PG8_SA
#undef PG8_SB
#undef PG8_STAGE
#undef PG8_LDA
#undef PG8_LDB
#undef PG8_MMA
#undef PG8_WAIT_V
#undef PG8_WAIT_L
#undef PG8_BAR
#undef PG8_SCHED
}
}
namespace att {
using bf16x8 = __attribute__((ext_vector_type(8))) short;
using s16x4  = __attribute__((ext_vector_type(4))) short;
using f32x16 = __attribute__((ext_vector_type(16))) float;
using u32x4  = __attribute__((ext_vector_type(4))) unsigned;
typedef unsigned short bf16_t;
constexpr float SCALE = 0.125f;
constexpr float THR = 8.f;
constexpr int SHM_V = 64 * 128 * 2, SHM_K = 64 * 64 * 2;
constexpr int LDS_ATT = 2 * SHM_V + 2 * SHM_K + 8 * 64 * 4;
#define KSWZ(row, colB) ((row) * 128 + ((colB) ^ ((((row) >> 1) & 7) << 4)))
#define SBAR() __builtin_amdgcn_sched_barrier(0)
__device__ __forceinline__ int crow(int r, int hi) { return (r & 3) + 8 * (r >> 2) + 4 * hi; }
__device__ __forceinline__ unsigned cvtpk(float lo, float hi) { unsigned r; asm volatile("v_cvt_pk_bf16_f32 %0, %1, %2" : "=v"(r) : "v"(lo), "v"(hi)); return r; }

__device__ __forceinline__ void partialSM(f32x16& p0, f32x16& p1, float& m_reg, float& mn, float& alpha) {
  constexpr float C = SCALE * 1.4426950408889634f;
  float pmax = p0[0];
#pragma unroll
  for (int r = 1; r < 16; ++r) pmax = fmaxf(pmax, p0[r]);
#pragma unroll
  for (int r = 0; r < 16; ++r) pmax = fmaxf(pmax, p1[r]);
  { auto rr = __builtin_amdgcn_permlane32_swap(__float_as_uint(pmax), __float_as_uint(pmax), false, false);
    pmax = fmaxf(__uint_as_float(rr[0]), __uint_as_float(rr[1])); }
  if (__builtin_expect(__all(pmax - m_reg <= THR / SCALE), 1)) { mn = m_reg; alpha = 1.f; }
  else { mn = fmaxf(m_reg, pmax); alpha = __builtin_amdgcn_exp2f((m_reg - mn) * C); m_reg = mn; }
  float mnC = -mn * C;
#pragma unroll
  for (int r = 0; r < 16; ++r) p0[r] = fmaf(p0[r], C, mnC);
#pragma unroll
  for (int r = 0; r < 16; ++r) p1[r] = fmaf(p1[r], C, mnC);
#pragma unroll
  for (int r = 0; r < 16; ++r) p0[r] = __builtin_amdgcn_exp2f(p0[r]);
}
__device__ __forceinline__ void finishSM(f32x16& p0, f32x16& p1, float alpha, float& l_reg, bf16x8& pa0, bf16x8& pa1, bf16x8& pa2, bf16x8& pa3) {
#pragma unroll
  for (int r = 0; r < 16; ++r) p1[r] = __builtin_amdgcn_exp2f(p1[r]);
  float ps = 0;
#pragma unroll
  for (int r = 0; r < 16; ++r) ps += p0[r];
#pragma unroll
  for (int r = 0; r < 16; ++r) ps += p1[r];
  { auto rr = __builtin_amdgcn_permlane32_swap(__float_as_uint(ps), __float_as_uint(ps), false, false);
    ps = __uint_as_float(rr[0]) + __uint_as_float(rr[1]); }
  l_reg = l_reg * alpha + ps;
#define PK4(P, BASE, OUT) do { unsigned a0 = cvtpk(P[BASE + 0], P[BASE + 1]), a1 = cvtpk(P[BASE + 2], P[BASE + 3]);   \
    unsigned b0 = cvtpk(P[BASE + 4], P[BASE + 5]), b1 = cvtpk(P[BASE + 6], P[BASE + 7]);                              \
    auto r0 = __builtin_amdgcn_permlane32_swap(a0, b0, false, false); auto r1 = __builtin_amdgcn_permlane32_swap(a1, b1, false, false); \
    u32x4 w = {r0[0], r1[0], r0[1], r1[1]}; OUT = *reinterpret_cast<bf16x8*>(&w); } while (0)
  PK4(p0, 0, pa0); PK4(p0, 8, pa1); PK4(p1, 0, pa2); PK4(p1, 8, pa3);
#undef PK4
}
__device__ __forceinline__ void qkt(f32x16& p0, f32x16& p1, const char* Ks, const bf16x8* qr, int r32, int hi) {
  p0 = f32x16{}; p1 = f32x16{};
#pragma unroll
  for (int d0 = 0; d0 < 4; ++d0) { int cb = (d0 * 16 + hi * 8) * 2;
    bf16x8 b0 = *reinterpret_cast<const bf16x8*>(Ks + KSWZ(r32, cb));
    bf16x8 b1 = *reinterpret_cast<const bf16x8*>(Ks + KSWZ(32 + r32, cb));
    p0 = __builtin_amdgcn_mfma_f32_32x32x16_bf16(b0, qr[d0], p0, 0, 0, 0);
    p1 = __builtin_amdgcn_mfma_f32_32x32x16_bf16(b1, qr[d0], p1, 0, 0, 0); }
}
__device__ __forceinline__ int v_st(int k, int c) { const int kk = (k & ~0xC) | ((k & 4) << 1) | ((k & 8) >> 1); return ((kk >> 3) * 4 + (c >> 5)) * 512 + ((kk & 7) * 32 + (c & 31)) * 2; }
__device__ __forceinline__ int v_rd_base(int lane) { return ((lane & 3) << 3) | (((lane >> 2) & 3) << 6) | (((lane >> 4) & 1) << 5) | (((lane >> 5) & 1) << 8); }
constexpr int v_rd_off(int d0, int ks, int half) { return d0 * 512 + ks * 4096 + half * 2048; }
template <int OFF> __device__ __forceinline__ s16x4 tr_read(int vb) {
  s16x4 r; asm volatile("ds_read_b64_tr_b16 %0, %1 offset:%2" : "=&v"(r) : "v"(vb), "i"(OFF) : "memory"); return r;
}
template <int D0> __device__ __forceinline__ void pv_one(f32x16& od, int vb, bf16x8 pa0, bf16x8 pa1, bf16x8 pa2, bf16x8 pa3) {
  const s16x4 l0 = tr_read<v_rd_off(D0, 0, 0)>(vb), h0 = tr_read<v_rd_off(D0, 0, 1)>(vb), l1 = tr_read<v_rd_off(D0, 1, 0)>(vb), h1 = tr_read<v_rd_off(D0, 1, 1)>(vb);
  const s16x4 l2 = tr_read<v_rd_off(D0, 2, 0)>(vb), h2 = tr_read<v_rd_off(D0, 2, 1)>(vb), l3 = tr_read<v_rd_off(D0, 3, 0)>(vb), h3 = tr_read<v_rd_off(D0, 3, 1)>(vb);
  asm volatile("s_waitcnt lgkmcnt(0)" ::: "memory"); SBAR();
#define PK(L, H) (bf16x8){L[0], L[1], L[2], L[3], H[0], H[1], H[2], H[3]}
  od = __builtin_amdgcn_mfma_f32_32x32x16_bf16(pa0, PK(l0, h0), od, 0, 0, 0);
  od = __builtin_amdgcn_mfma_f32_32x32x16_bf16(pa1, PK(l1, h1), od, 0, 0, 0);
  od = __builtin_amdgcn_mfma_f32_32x32x16_bf16(pa2, PK(l2, h2), od, 0, 0, 0);
  od = __builtin_amdgcn_mfma_f32_32x32x16_bf16(pa3, PK(l3, h3), od, 0, 0, 0);
#undef PK
}
__device__ __forceinline__ void pv_d0(f32x16* o, int vb, bf16x8 pa0, bf16x8 pa1, bf16x8 pa2, bf16x8 pa3) {
  pv_one<0>(o[0], vb, pa0, pa1, pa2, pa3); pv_one<1>(o[1], vb, pa0, pa1, pa2, pa3); pv_one<2>(o[2], vb, pa0, pa1, pa2, pa3); pv_one<3>(o[3], vb, pa0, pa1, pa2, pa3);
}

__device__ __forceinline__ void attn_half(f32x16 (&o)[4], const bf16_t* __restrict__ Qw, const bf16_t* __restrict__ Kc, const bf16_t* __restrict__ Vc,
                                          const bf16_t* __restrict__ Kn, const bf16_t* __restrict__ Vn, int ncache, int NT, char* lds) {
  const int tid = opaque_tid(), wid = tid >> 6, lane = tid & 63, r32 = lane & 31, hi = lane >> 5;
  char* V_lds = lds; char* K_lds = lds + 2 * SHM_V;
  float* wsf = (float*)(lds + 2 * SHM_V + 2 * SHM_K) + wid * 64; float* li_l = wsf; float* al_l = wsf + 32;
  float m_reg = -1e30f, l_reg = 0; bf16x8 qr[4];
#pragma unroll
  for (int d = 0; d < 4; ++d) o[d] = f32x16{};
#pragma unroll
  for (int d0 = 0; d0 < 4; ++d0) qr[d0] = *reinterpret_cast<const bf16x8*>(Qw + d0 * 16);
  const int sr = tid >> 4, sc = (tid & 15) * 8, vst0 = v_st(sr, sc), vst1 = v_st(32 + sr, sc);
  const int kr = tid >> 3, kc = (tid & 7) * 8, kst = KSWZ(kr, kc * 2);
  const int vb0 = (int)(uintptr_t)V_lds + v_rd_base(lane);
  struct { bf16x8 vs0, vs1, ks0; } sr_[2];
#define TPTR(jt, PC, PN) ((jt) < ncache ? (PC) + (size_t)(jt) * (64 * 512) : (PN) + (size_t)((jt) - ncache) * (64 * 512))
#define SLOAD(i, jt) do { const bf16_t* vt_ = TPTR(jt, Vc, Vn); const bf16_t* kt_ = TPTR(jt, Kc, Kn); \
    sr_[i].vs0 = *reinterpret_cast<const bf16x8*>(vt_ + (size_t)sr * 512 + sc); sr_[i].vs1 = *reinterpret_cast<const bf16x8*>(vt_ + (size_t)(32 + sr) * 512 + sc); \
    sr_[i].ks0 = *reinterpret_cast<const bf16x8*>(kt_ + (size_t)kr * 512 + kc); } while (0)
#define SWRITE(b, i) do { *(bf16x8*)(V_lds + (b) * SHM_V + vst0) = sr_[i].vs0; *(bf16x8*)(V_lds + (b) * SHM_V + vst1) = sr_[i].vs1; \
    *(bf16x8*)(K_lds + (b) * SHM_K + kst) = sr_[i].ks0; } while (0)
#define SWAIT() asm volatile("s_waitcnt vmcnt(3)" ::: "memory")
#define RESC(a) do { if (__any((a) < 1.f)) { if (hi == 0) al_l[r32] = (a); asm volatile("s_waitcnt lgkmcnt(0)" ::: "memory"); \
    _Pragma("unroll") for (int d = 0; d < 4; ++d) _Pragma("unroll") for (int r = 0; r < 16; ++r) o[d][r] *= al_l[crow(r, hi)]; } } while (0)
  f32x16 pA0, pA1, pB0, pB1; float mnA, mnB, alA, alB; bf16x8 pa0, pa1, pa2, pa3;
  constexpr int SE = 0, SO = 1;
  __syncthreads();
  SLOAD(SE, 0); asm volatile("s_waitcnt vmcnt(0)" ::: "memory"); SWRITE(0, SE); __syncthreads();
  qkt(pA0, pA1, K_lds, qr, r32, hi); partialSM(pA0, pA1, m_reg, mnA, alA);
  SLOAD(SO, 1); if (2 < NT) SLOAD(SE, 2);
  SWAIT(); SWRITE(1, SO); __syncthreads();
  for (int j = 1; j + 1 < NT; j += 2) {
    SBAR(); qkt(pB0, pB1, K_lds + SHM_K, qr, r32, hi);
    finishSM(pA0, pA1, alA, l_reg, pa0, pa1, pa2, pa3); SBAR();
    SLOAD(SO, j + 2); SBAR();
    pv_d0(o, vb0, pa0, pa1, pa2, pa3); partialSM(pB0, pB1, m_reg, mnB, alB);
    __syncthreads(); SWAIT(); SWRITE(0, SE);
    RESC(alB); __syncthreads();
    SBAR(); qkt(pA0, pA1, K_lds, qr, r32, hi);
    finishSM(pB0, pB1, alB, l_reg, pa0, pa1, pa2, pa3); SBAR();
    if (j + 3 < NT) SLOAD(SE, j + 3); SBAR();
    pv_d0(o, vb0 + SHM_V, pa0, pa1, pa2, pa3); partialSM(pA0, pA1, m_reg, mnA, alA);
    __syncthreads(); SWAIT(); SWRITE(1, SO);
    RESC(alA); __syncthreads();
  }
  SBAR(); qkt(pB0, pB1, K_lds + SHM_K, qr, r32, hi);
  finishSM(pA0, pA1, alA, l_reg, pa0, pa1, pa2, pa3); SBAR();
  pv_d0(o, vb0, pa0, pa1, pa2, pa3); partialSM(pB0, pB1, m_reg, mnB, alB);
  __syncthreads(); RESC(alB);
  finishSM(pB0, pB1, alB, l_reg, pa0, pa1, pa2, pa3); SBAR();
  pv_d0(o, vb0 + SHM_V, pa0, pa1, pa2, pa3);
  if (hi == 0) li_l[r32] = l_reg; asm volatile("s_waitcnt lgkmcnt(0)" ::: "memory");
#pragma unroll
  for (int r = 0; r < 16; ++r) { const float rl = __builtin_amdgcn_rcpf(li_l[crow(r, hi)]);
#pragma unroll
    for (int d = 0; d < 4; ++d) o[d][r] *= rl; }
#undef TPTR
#undef SLOAD
#undef SWRITE
#undef SWAIT
#undef RESC
}
}
typedef unsigned short bf16_t;
typedef float f32x4v __attribute__((ext_vector_type(4)));
typedef float f32x2v __attribute__((ext_vector_type(2)));
typedef unsigned u32x4v __attribute__((ext_vector_type(4)));
typedef unsigned u32x2v __attribute__((ext_vector_type(2)));
typedef short bf16x8v __attribute__((ext_vector_type(8)));
using att::f32x16;
#define LDS_WAIT() asm volatile("s_waitcnt lgkmcnt(0)" ::: "memory")
__device__ __forceinline__ unsigned pk2(float lo, float hi) { return pg8::cvt_pk_bf16(lo, hi); }
__device__ __forceinline__ float bf_lo(unsigned w) { return __uint_as_float(w << 16); }
__device__ __forceinline__ float bf_hi(unsigned w) { return __uint_as_float(w & 0xffff0000u); }
__device__ __forceinline__ float wave_sum(float v) {
#pragma unroll
    for (int o = 1; o < 64; o <<= 1) v += __shfl_xor(v, o);
    return v;
}
#define LAS __attribute__((address_space(3)))
#define XB_TMO      128
#define XB_XCNT(j)  (256  + 64 * (j))
#define XB_XSUB(j)  (1280 + 64 * (j))
#define XB_XGEN(j)  (2304 + 64 * (j))
#define XB_TOP      3328
#define XB_TOPGEN   3392
#define XCD_BAR_WORDS 3456
#define XB_SPIN_CAP (1u << 18)

__device__ __forceinline__ unsigned xb_ld(unsigned* p)              { return __hip_atomic_load(p, __ATOMIC_RELAXED, __HIP_MEMORY_SCOPE_AGENT); }
__device__ __forceinline__ unsigned xb_add(unsigned* p, unsigned v) { return __hip_atomic_fetch_add(p, v, __ATOMIC_RELAXED, __HIP_MEMORY_SCOPE_AGENT); }
__device__ __forceinline__ unsigned xb_xcc_id() { return (unsigned)__builtin_amdgcn_s_getreg((3 << 11) | 20) & 0xFu; }
#define XB_SPIN(cond, bar) do { unsigned _sp = 0; while (cond) { __builtin_amdgcn_s_sleep(1); \
    if ((++_sp & 255u) == 0u) { if (xb_ld(&(bar)[XB_TMO])) break; if (_sp > XB_SPIN_CAP) { atomicAdd(&(bar)[XB_TMO], 1u); break; } } } } while (0)

struct XcdBarrier {
    unsigned* bar; unsigned x;
    volatile LAS unsigned* st;
};

__device__ __forceinline__ XcdBarrier xcd_barrier_post(unsigned* bar, volatile LAS unsigned* st) {
    XcdBarrier b; b.bar = bar; b.x = xb_xcc_id(); b.st = st;
    if (threadIdx.x == 0) (void)xb_add(&bar[XB_XCNT(b.x)], 1u);
    return b;
}
__device__ __forceinline__ void xcd_barrier_complete(unsigned* bar, unsigned x, unsigned& nloc, unsigned& nx) {
    const unsigned G = gridDim.x * gridDim.y * gridDim.z;
    unsigned sum, cnt, mine, sp = 0u;
    for (;;) {
        sum = 0u; cnt = 0u; mine = 0u;
#pragma unroll
        for (unsigned j = 0; j < 16; ++j) { const unsigned c = xb_ld(&bar[XB_XCNT(j)]); sum += c; cnt += (c > 0u) ? 1u : 0u; mine = (j == x) ? c : mine; }
        if (sum == G) break;
        __builtin_amdgcn_s_sleep(1);
        if ((++sp & 255u) == 0u) { if (xb_ld(&bar[XB_TMO])) break; if (sp > XB_SPIN_CAP) { atomicAdd(&bar[XB_TMO], 1u); break; } }
    }
    nloc = mine > 0u ? mine : 1u; nx = cnt > 0u ? cnt : 1u;
}

__device__ __forceinline__ void xcd_barrier(const XcdBarrier& b) {
    asm volatile("s_waitcnt vmcnt(0)" ::: "memory");
    __syncthreads();
    if (threadIdx.x == 0) {
        unsigned* bar = b.bar;
        __builtin_amdgcn_s_waitcnt(0);
        unsigned nloc = b.st[0], nx = b.st[1];
        if (nloc == 0u) { xcd_barrier_complete(bar, b.x, nloc, nx); b.st[0] = nloc; b.st[1] = nx; }
        const unsigned old = xb_add(&bar[XB_XSUB(b.x)], 1u);
        const unsigned gen = old / nloc;
        if (old + 1u == (gen + 1u) * nloc) {
            __builtin_amdgcn_fence(__ATOMIC_RELEASE, "agent");
            asm volatile("s_waitcnt vmcnt(0)" ::: "memory");
            const unsigned og = xb_add(&bar[XB_TOP], 1u);
            const unsigned tg = og / nx;
            if (og + 1u == (tg + 1u) * nx) xb_add(&bar[XB_TOPGEN], 1u);
            else XB_SPIN(xb_ld(&bar[XB_TOPGEN]) == tg, bar);
            __builtin_amdgcn_fence(__ATOMIC_ACQUIRE, "agent");
            xb_add(&bar[XB_XGEN(b.x)], 1u);
            asm volatile("s_waitcnt vmcnt(0)" ::: "memory");
        } else {
            XB_SPIN(xb_ld(&bar[XB_XGEN(b.x)]) == gen, bar);
            __builtin_amdgcn_fence(__ATOMIC_ACQUIRE, "agent");
            asm volatile("s_waitcnt vmcnt(0)" ::: "memory");
        }
    }
    __syncthreads();
}

struct Args { const float* in[34]; float* out; unsigned char* ws; int ph_lo, ph_hi; };

__device__ __forceinline__ void p0_transpose_item(const float* __restrict__ W, int K, int N, bf16_t* __restrict__ WT, float* scr, int item, int lane) {
    const int nblk = N / 32, kb = item / nblk, nb = item % nblk, k0 = 64 * kb, n0 = 32 * nb;
#pragma unroll 8
    for (int i = 0; i < 32; ++i) { const int kk = 2 * i + (lane >> 5); scr[kk * 33 + (lane & 31)] = W[(size_t)(k0 + kk) * N + n0 + (lane & 31)]; }
    LDS_WAIT(); asm volatile("" ::: "memory");
    const int c = lane & 7;
#pragma unroll
    for (int j = 0; j < 4; ++j) { const int n = (lane >> 3) + 8 * j; const float* s = scr + (8 * c) * 33 + n;
        u32x4v o; o.x = pk2(s[0 * 33], s[1 * 33]); o.y = pk2(s[2 * 33], s[3 * 33]); o.z = pk2(s[4 * 33], s[5 * 33]); o.w = pk2(s[6 * 33], s[7 * 33]);
        *(u32x4v*)(WT + (size_t)(n0 + n) * K + k0 + 8 * c) = o; }
    LDS_WAIT(); asm volatile("" ::: "memory");
}
__device__ __forceinline__ void p0_adaln_item(const Args& a, int item, float* silu_tab  , float* part  , int tid) {
    const int wid = tid >> 6, lane = tid & 63;
    const int layer = item / 48, blk = item % 48, j0 = blk * 128 + 2 * lane;
    const float* wm = a.in[layer ? 23 : 6]; const float* bm = a.in[layer ? 24 : 7];
    for (int i = tid; i < NCOND * DM; i += 512) { const int c = i >> 10, k = i & 1023; const float x = c == 0 ? a.in[5][k] : a.in[4][(c - 1) * DM + k]; silu_tab[i] = x / (1.f + __expf(-x)); }
    __syncthreads();
    f32x2v acc[NCOND];
#pragma unroll
    for (int c = 0; c < NCOND; ++c) acc[c] = (f32x2v){0.f, 0.f};
    const int kb = wid * 128;
    for (int k = kb; k < kb + 128; k += 16) {
        f32x2v w[16];
#pragma unroll
        for (int u = 0; u < 16; ++u) w[u] = *(const f32x2v*)(wm + (size_t)(k + u) * MODW + j0);
#pragma unroll
        for (int u = 0; u < 16; ++u)
#pragma unroll
            for (int c = 0; c < NCOND; ++c) acc[c] += w[u] * silu_tab[c * DM + k + u];
    }
#pragma unroll
    for (int c = 0; c < NCOND; ++c) *(f32x2v*)(part + (wid * NCOND + c) * 128 + 2 * lane) = acc[c];
    __syncthreads();
    float* mod = (float*)(a.ws + WS_MOD) + (size_t)layer * NCOND * MODW;
    for (int o = tid; o < NCOND * 128; o += 512) { const int c = o >> 7, j = o & 127; float s = bm[blk * 128 + j];
#pragma unroll
        for (int w8 = 0; w8 < 8; ++w8) s += part[(w8 * NCOND + c) * 128 + j];
        mod[(size_t)c * MODW + blk * 128 + j] = s; }
    __syncthreads();
}
__device__ __forceinline__ int row_cond(int row) { return row < MP ? 0 : 1 + ((row - MP) >> 12); }
__device__ __forceinline__ const float* x_in_row(const Args& a, int row) { return row < MP ? a.in[0] + (size_t)row * DM : a.in[1] + (size_t)(row - MP) * DM; }

__device__ __forceinline__ void p0_prologue(const Args& a, char* lds) {
    const int tid = opaque_tid(), wid = tid >> 6, lane = tid & 63, G = gridDim.x;
    float* scr = (float*)(lds + wid * 8704);
    if (blockIdx.x < 96) p0_adaln_item(a, blockIdx.x, (float*)(lds + 73728), (float*)(lds + 73728 + 20480), tid);
    const int gw = blockIdx.x * 8 + wid, NGW = G * 8;
    constexpr int I_IN0 = 16 * (IN0 / 32), I_OUT = 16 * 32, I_FF1 = 16 * (DFF / 32), I_FF2 = 64 * 32, I_IN1 = 16 * (IN1 / 32);
    constexpr int NITEMS = I_IN0 + I_OUT + I_FF1 + I_FF2 + I_IN1 + I_OUT + I_FF1 + I_FF2;
    constexpr int PASS1_PER_WAVE = 5;
    const int n_late = (G > 96) ? (G - 96) * 8 : 0, pass1 = n_late * PASS1_PER_WAVE < NITEMS ? n_late * PASS1_PER_WAVE : NITEMS;
#pragma unroll 1
    for (int pass = 0; pass < 2; ++pass) {
        int it0, it1, stride, first;
        if (pass == 0) { it0 = 0; it1 = pass1; stride = n_late; first = (int)blockIdx.x >= 96 ? (gw - 96 * 8) : it1; }
        else { it0 = pass1; it1 = NITEMS; stride = NGW; first = gw; }
        if (stride <= 0) continue;
#pragma unroll 1
        for (int it = it0 + first; it < it1; it += stride) {
        int r = it;
        if (r < I_IN0) { p0_transpose_item(a.in[8], DM, IN0, (bf16_t*)(a.ws + WS_WIN0), scr, r, lane); continue; } r -= I_IN0;
        if (r < I_OUT) { p0_transpose_item(a.in[16], DM, DM, (bf16_t*)(a.ws + WS_WOUT0), scr, r, lane); continue; } r -= I_OUT;
        if (r < I_FF1) { p0_transpose_item(a.in[19], DM, DFF, (bf16_t*)(a.ws + WS_WFF1_0), scr, r, lane); continue; } r -= I_FF1;
        if (r < I_FF2) { p0_transpose_item(a.in[20], DFF, DM, (bf16_t*)(a.ws + WS_WFF2_0), scr, r, lane); continue; } r -= I_FF2;
        if (r < I_IN1) { p0_transpose_item(a.in[25], DM, IN1, (bf16_t*)(a.ws + WS_WIN1), scr, r, lane); continue; } r -= I_IN1;
        if (r < I_OUT) { p0_transpose_item(a.in[27], DM, DM, (bf16_t*)(a.ws + WS_WOUT1), scr, r, lane); continue; } r -= I_OUT;
        if (r < I_FF1) { p0_transpose_item(a.in[30], DM, DFF, (bf16_t*)(a.ws + WS_WFF1_1), scr, r, lane); continue; } r -= I_FF1;
        p0_transpose_item(a.in[31], DFF, DM, (bf16_t*)(a.ws + WS_WFF2_1), scr, r, lane);
            }
    }
    for (int i = blockIdx.x * 512 + tid; i < 2 * 131072 / 2; i += G * 512) {
        const bool isk = i < 65536; const int j = isk ? i : i - 65536;
        const float* src = (isk ? a.in[2] : a.in[3]) + (size_t)j * 8;
        const f32x4v x0 = *(const f32x4v*)src, x1 = *(const f32x4v*)(src + 4);
        u32x4v o; o.x = pk2(x0[0], x0[1]); o.y = pk2(x0[2], x0[3]); o.z = pk2(x1[0], x1[1]); o.w = pk2(x1[2], x1[3]);
        *(u32x4v*)((bf16_t*)(a.ws + (isk ? WS_CK : WS_CV)) + (size_t)j * 8) = o;
    }
    if (blockIdx.x == G - 1 && wid == 7) {
        const float s1 = wave_sum(a.in[9][lane] * a.in[10][lane]), s2 = wave_sum(a.in[11][lane] * a.in[12][lane]);
        if (lane == 0) ((float*)(a.ws + WS_MOD))[2 * NCOND * MODW] = __expf(s1) - __expf(s2) + LAMBDA_INIT;
    }
}
__device__ __forceinline__ void p_modulate0(const Args& a) {
    const int tid = opaque_tid(), wid = tid >> 6, lane = tid & 63;
    const float* mod = (const float*)(a.ws + WS_MOD); bf16_t* HB = (bf16_t*)(a.ws + WS_HB);
    for (int row = blockIdx.x * 8 + wid; row < MT; row += gridDim.x * 8) {
        const float* xr = x_in_row(a, row) + 4 * lane; const float* mc = mod + (size_t)row_cond(row) * MODW + 4 * lane;
        unsigned long long* o8 = (unsigned long long*)(HB + (size_t)row * DM) + lane;
#pragma unroll
        for (int j = 0; j < 4; ++j) { const f32x4v x = *(const f32x4v*)(xr + 256 * j), sh = *(const f32x4v*)(mc + 256 * j), sc = *(const f32x4v*)(mc + DM + 256 * j);
            const f32x4v h = x * (sc + 1.f) + sh; o8[64 * j] = (unsigned long long)pk2(h[0], h[1]) | ((unsigned long long)pk2(h[2], h[3]) << 32); }
    }
}
template <bool WRITE_H>
__device__ __forceinline__ void p_layernorm(const bf16_t* __restrict__ Y, const float* __restrict__ g, const float* __restrict__ b, const float* __restrict__ modn, bf16_t* HB, bf16_t* XB, float* OUT,
                                            int row0, int nrows, const float* __restrict__ P) {
    const int tid = opaque_tid(), wid = tid >> 6, lane = tid & 63;
    for (int row = row0 + blockIdx.x * 8 + wid; row < row0 + nrows; row += gridDim.x * 8) {
        const bf16_t* yr = Y + (size_t)row * DM + 8 * lane; const float* pr = P ? P + (size_t)(row - row0) * DM + 8 * lane : nullptr;
        f32x4v v[4]; float s = 0.f;
#pragma unroll
        for (int j = 0; j < 2; ++j) { const u32x4v w = *(const u32x4v*)(yr + 512 * j);
            v[2 * j] = (f32x4v){bf_lo(w.x), bf_hi(w.x), bf_lo(w.y), bf_hi(w.y)}; v[2 * j + 1] = (f32x4v){bf_lo(w.z), bf_hi(w.z), bf_lo(w.w), bf_hi(w.w)};
            if (pr) { v[2 * j] += *(const f32x4v*)(pr + 512 * j); v[2 * j + 1] += *(const f32x4v*)(pr + 512 * j + 4); } }
#pragma unroll
        for (int j = 0; j < 4; ++j) s += (v[j][0] + v[j][1]) + (v[j][2] + v[j][3]);
        const float mean = wave_sum(s) * (1.f / DM); float s2 = 0.f;
#pragma unroll
        for (int j = 0; j < 4; ++j) { v[j] = v[j] - mean; s2 += (v[j][0] * v[j][0] + v[j][1] * v[j][1]) + (v[j][2] * v[j][2] + v[j][3] * v[j][3]); }
        const float rstd = 1.f / sqrtf(wave_sum(s2) * (1.f / DM) + LN_EPS_F);
        const float* mc = WRITE_H ? modn + (size_t)row_cond(row) * MODW + 8 * lane : nullptr;
#pragma unroll
        for (int j = 0; j < 2; ++j) { const int c = 8 * lane + 512 * j;
            const f32x4v y0 = v[2 * j] * rstd * *(const f32x4v*)(g + c) + *(const f32x4v*)(b + c), y1 = v[2 * j + 1] * rstd * *(const f32x4v*)(g + c + 4) + *(const f32x4v*)(b + c + 4);
            if (XB) { u32x4v o; o.x = pk2(y0[0], y0[1]); o.y = pk2(y0[2], y0[3]); o.z = pk2(y1[0], y1[1]); o.w = pk2(y1[2], y1[3]); *(u32x4v*)(XB + (size_t)row * DM + c) = o; }
            if (OUT) { *(f32x4v*)(OUT + (size_t)row * DM + c) = y0; *(f32x4v*)(OUT + (size_t)row * DM + c + 4) = y1; }
            if (WRITE_H) { const f32x4v h0 = y0 * (*(const f32x4v*)(mc + DM + 512 * j) + 1.f) + *(const f32x4v*)(mc + 512 * j), h1 = y1 * (*(const f32x4v*)(mc + DM + 512 * j + 4) + 1.f) + *(const f32x4v*)(mc + 512 * j + 4);
                u32x4v o; o.x = pk2(h0[0], h0[1]); o.y = pk2(h0[2], h0[3]); o.z = pk2(h1[0], h1[1]); o.w = pk2(h1[2], h1[3]); *(u32x4v*)(HB + (size_t)row * DM + c) = o; } }
    }
}
__device__ __forceinline__ void p_conv(const Args& a) {
    const int tid = opaque_tid(), wid = tid >> 6, lane = tid & 63;
    const bf16_t* R = (const bf16_t*)(a.ws + WS_R1); bf16_t* MIX = (bf16_t*)(a.ws + WS_HB); const float* cw = a.in[26];
    for (int row = blockIdx.x * 8 + wid; row < MT; row += gridDim.x * 8) {
        const int pos = row < MP ? (row & 255) : ((row - MP) & 4095), len = row < MP ? 256 : 4096;
        const bool hasl = pos > 0, hasr = pos < len - 1;
#pragma unroll
        for (int j = 0; j < 2; ++j) {
            const int c8 = (lane + 64 * j) * 8; const bf16_t* p = R + (size_t)row * IN1 + c8;
            const u32x4v bg = *(const u32x4v*)p, c1 = *(const u32x4v*)(p + 1024), x1 = *(const u32x4v*)(p + 2048);
            u32x4v c0 = {0, 0, 0, 0}, x0 = c0, c2 = c0, x2 = c0;
            if (hasl) { c0 = *(const u32x4v*)(p - IN1 + 1024); x0 = *(const u32x4v*)(p - IN1 + 2048); }
            if (hasr) { c2 = *(const u32x4v*)(p + IN1 + 1024); x2 = *(const u32x4v*)(p + IN1 + 2048); }
            const f32x4v w0a = *(const f32x4v*)(cw + c8), w0b = *(const f32x4v*)(cw + c8 + 4), w1a = *(const f32x4v*)(cw + DM + c8), w1b = *(const f32x4v*)(cw + DM + c8 + 4),
                         w2a = *(const f32x4v*)(cw + 2 * DM + c8), w2b = *(const f32x4v*)(cw + 2 * DM + c8 + 4);
            u32x4v o;
#pragma unroll
            for (int e = 0; e < 4; ++e) {
                const float w0l = e < 2 ? w0a[2 * e] : w0b[2 * e - 4], w0h = e < 2 ? w0a[2 * e + 1] : w0b[2 * e - 3];
                const float w1l = e < 2 ? w1a[2 * e] : w1b[2 * e - 4], w1h = e < 2 ? w1a[2 * e + 1] : w1b[2 * e - 3];
                const float w2l = e < 2 ? w2a[2 * e] : w2b[2 * e - 4], w2h = e < 2 ? w2a[2 * e + 1] : w2b[2 * e - 3];
                const float yl = bf_lo(c0[e]) * bf_lo(x0[e]) * w0l + bf_lo(c1[e]) * bf_lo(x1[e]) * w1l + bf_lo(c2[e]) * bf_lo(x2[e]) * w2l;
                const float yh = bf_hi(c0[e]) * bf_hi(x0[e]) * w0h + bf_hi(c1[e]) * bf_hi(x1[e]) * w1h + bf_hi(c2[e]) * bf_hi(x2[e]) * w2h;
                o[e] = pk2(bf_lo(bg[e]) * yl, bf_hi(bg[e]) * yh);
            }
            *(u32x4v*)(MIX + (size_t)row * DM + c8) = o;
        }
    }
}
__device__ __forceinline__ void p_attention(const Args& a, char* lds) {
    const int tid = opaque_tid(), wid = tid >> 6, lane = tid & 63, r32 = lane & 31, hi = lane >> 5;
    const bf16_t* QB = (const bf16_t*)(a.ws + WS_R1); const bf16_t* KB = QB + (size_t)MT * 512; const bf16_t* VB = KB + (size_t)MT * 512;
    const bf16_t* CK = (const bf16_t*)(a.ws + WS_CK); const bf16_t* CV = (const bf16_t*)(a.ws + WS_CV);
    bf16_t* MIX = (bf16_t*)(a.ws + WS_HB);
    const float lam = ((const float*)(a.ws + WS_MOD))[2 * NCOND * MODW];
    float* o0s = a.out + (((size_t)blockIdx.x * 8 + wid) * 64 + lane) * 64;
    const float* subg = a.in[13];
    for (int ui = blockIdx.x; ui < 256 + 128; ui += gridDim.x) {
        int qrow0, h, ncache, NT; const bf16_t *Kc, *Vc, *Kn, *Vn;
        if (ui < 256) {
            const int xcd = ui & 7, slot = ui >> 3, bh = xcd * 2 + (slot >> 4), qb = slot & 15, b = bh >> 2; h = bh & 3;
            qrow0 = MP + b * 4096 + qb * 256; ncache = 4; NT = 68;
            Kc = CK + (size_t)(b * 256) * 512; Vc = CV + (size_t)(b * 256) * 512; Kn = KB + (size_t)(MP + b * 4096) * 512; Vn = VB + (size_t)(MP + b * 4096) * 512;
        } else { const int p = ui - 256, b = p >> 2; h = p & 3; qrow0 = b * 256; ncache = 0; NT = 4;
            Kn = KB + (size_t)(b * 256) * 512; Vn = VB + (size_t)(b * 256) * 512; Kc = Kn; Vc = Vn; }
        const bf16_t* Qw = QB + (size_t)(qrow0 + wid * 32 + r32) * 512 + h * 128 + hi * 8;
        f32x16 o[4];
        att::attn_half(o, Qw, Kc + h * 128, Vc + h * 128, Kn + h * 128, Vn + h * 128, ncache, NT, lds);
        { float* op = o0s; asm volatile("" : "+v"(op));
#pragma unroll
        for (int d = 0; d < 4; ++d)
#pragma unroll
            for (int r4 = 0; r4 < 4; ++r4) *(f32x4v*)(op + d * 16 + r4 * 4) = (f32x4v){o[d][4 * r4], o[d][4 * r4 + 1], o[d][4 * r4 + 2], o[d][4 * r4 + 3]}; }
        att::attn_half(o, Qw + 64, Kc + h * 128 + 64, Vc + h * 128, Kn + h * 128 + 64, Vn + h * 128, ncache, NT, lds);
        float ss[16];
#pragma unroll
        for (int r = 0; r < 16; ++r) ss[r] = 0.f;
        int hi_ = hi; const float* op = o0s; asm volatile("" : "+v"(op), "+v"(hi_));
#pragma unroll
        for (int d = 0; d < 4; ++d)
#pragma unroll
            for (int r4 = 0; r4 < 4; ++r4) { const f32x4v o0 = *(const f32x4v*)(op + d * 16 + r4 * 4);
#pragma unroll
                for (int e = 0; e < 4; ++e) { const int r = 4 * r4 + e; const float v = o0[e] - lam * o[d][r]; o[d][r] = v; ss[r] += v * v; } }
#pragma unroll
        for (int r = 0; r < 16; ++r) { float s = ss[r]; s += __shfl_xor(s, 1); s += __shfl_xor(s, 2); s += __shfl_xor(s, 4); s += __shfl_xor(s, 8); s += __shfl_xor(s, 16);
            ss[r] = (1.f - LAMBDA_INIT) / sqrtf(s * (1.f / 128.f) + LN_EPS_F); }
        bf16_t* mo = MIX + (size_t)(qrow0 + wid * 32) * DM + h * 128 + r32;
#pragma unroll
        for (int d = 0; d < 4; ++d) { const float gd = subg[d * 32 + r32];
#pragma unroll
            for (int r = 0; r < 16; ++r) { const float v = o[d][r] * ss[r] * gd; mo[(size_t)att::crow(r, hi_) * DM + d * 32] = (bf16_t)(pk2(v, v) & 0xffffu); } }
    }
}
__device__ __forceinline__ void p_sgu(const Args& a, char* lds) {
    const int tid = opaque_tid(), wid = tid >> 6, lane = tid & 63, r32 = lane & 31, hi = lane >> 5, G = gridDim.x;
    const bf16_t* UB = (const bf16_t*)(a.ws + WS_R1) + (size_t)3 * MT * 512; const bf16_t* GB = UB + (size_t)MT * 512;
    bf16_t* MIX = (bf16_t*)(a.ws + WS_HB);
    const float* sw = a.in[14]; const float* sb = a.in[15];
    bf16_t* Wl = (bf16_t*)lds; bf16_t* VT = (bf16_t*)(lds + 34816);
    int u0, nu; if (G == 256) { if ((int)blockIdx.x < 128) { u0 = blockIdx.x * 2; nu = 2; } else { u0 = 256 + (blockIdx.x - 128) * 4; nu = 4; } } else { u0 = 0; nu = 0; }
    for (int k = 0; (G == 256) ? (k < nu) : ((int)blockIdx.x + k * G < 768); ++k) {
        const int su = (G == 256) ? u0 + k : (int)blockIdx.x + k * G;
        const int chunk = su >> 2, g = su & 3, row0 = chunk * 128;
        __syncthreads();
        for (int it = 0; it < 8; ++it) { const int idx = (it * 512 + tid) * 4, p = idx >> 7, q = idx & 127;
            const f32x4v w = *(const f32x4v*)(sw + (size_t)g * 16384 + idx);
            u32x2v o; o.x = pk2(w[0], w[1]); o.y = pk2(w[2], w[3]); *(u32x2v*)(Wl + p * 136 + q) = o; }
#pragma unroll
        for (int it = 0; it < 4; ++it) { const int tok = wid * 16 + it * 4 + (lane >> 4), d0 = (lane & 15) * 8;
            const u32x4v x = *(const u32x4v*)(GB + (size_t)(row0 + tok) * 512 + g * 128 + d0);
            float f[8];
#pragma unroll
            for (int e = 0; e < 4; ++e) { f[2 * e] = bf_lo(x[e]); f[2 * e + 1] = bf_hi(x[e]); }
            float s = 0.f;
#pragma unroll
            for (int e = 0; e < 8; ++e) s += f[e];
            s += __shfl_xor(s, 1); s += __shfl_xor(s, 2); s += __shfl_xor(s, 4); s += __shfl_xor(s, 8);
            const float mean = s * (1.f / 128.f); float q2 = 0.f;
#pragma unroll
            for (int e = 0; e < 8; ++e) { f[e] -= mean; q2 += f[e] * f[e]; }
            q2 += __shfl_xor(q2, 1); q2 += __shfl_xor(q2, 2); q2 += __shfl_xor(q2, 4); q2 += __shfl_xor(q2, 8);
            const float rstd = 1.f / sqrtf(q2 * (1.f / 128.f) + LN_EPS_F);
#pragma unroll
            for (int e = 0; e < 8; ++e) VT[(d0 + e) * 136 + tok] = (bf16_t)(pk2(f[e] * rstd, 0.f) & 0xffffu);
        }
        __syncthreads();
        const int pbase = (wid & 3) * 32, dbase = (wid >> 2) * 64;
        f32x16 acc[2] = {f32x16{}, f32x16{}};
#pragma unroll
        for (int ks = 0; ks < 8; ++ks) {
            const bf16x8v bw = *(const bf16x8v*)(Wl + (pbase + r32) * 136 + ks * 16 + hi * 8);
#pragma unroll
            for (int ds = 0; ds < 2; ++ds) { const bf16x8v av = *(const bf16x8v*)(VT + (dbase + ds * 32 + r32) * 136 + ks * 16 + hi * 8);
                acc[ds] = __builtin_amdgcn_mfma_f32_32x32x16_bf16(av, bw, acc[ds], 0, 0, 0); }
        }
        const int p = pbase + r32; const float bias = sb[g * 128 + p];
        const bf16_t* up = UB + (size_t)(row0 + p) * 512 + g * 128; bf16_t* mo = MIX + (size_t)(row0 + p) * DM + 512 + g * 128;
#pragma unroll
        for (int ds = 0; ds < 2; ++ds)
#pragma unroll
            for (int rq = 0; rq < 4; ++rq) { const int d = dbase + ds * 32 + 8 * rq + 4 * hi;
                const u32x2v uu = *(const u32x2v*)(up + d);
                u32x2v o; o.x = pk2(bf_lo(uu.x) * (acc[ds][4 * rq] + bias), bf_hi(uu.x) * (acc[ds][4 * rq + 1] + bias));
                o.y = pk2(bf_lo(uu.y) * (acc[ds][4 * rq + 2] + bias), bf_hi(uu.y) * (acc[ds][4 * rq + 3] + bias));
                *(u32x2v*)(mo + d) = o; }
    }
}
constexpr int NPHASE = 20;
#ifndef PHMASK
#define PHMASK 0xfffff
#endif
#define PM(i) ((PHMASK >> (i)) & 1)
#ifndef PROBE_REP
#define PROBE_REP 0
#endif
#define NREP(i) (1 + ((PROBE_REP >> (i)) & 1))
__global__ void __launch_bounds__(512, 2) mega_fwd(Args a) {
    extern __shared__ __attribute__((aligned(16))) unsigned char lds_raw[];
    char* lds = (char*)lds_raw;
    PG8_LAS unsigned char* glds = (PG8_LAS unsigned char*)lds_raw;
    cg::grid_group grid = cg::this_grid();
    volatile LAS unsigned* MISC = (volatile LAS unsigned*)(glds + 131072);
    if (threadIdx.x < 16) MISC[threadIdx.x] = 0u;
    __syncthreads();
    unsigned* const barw = (unsigned*)(a.ws + WS_CTL);
    XcdBarrier xbar; xbar.bar = barw; xbar.x = 0; xbar.st = nullptr;
    const int lo = a.ph_lo, hi = a.ph_hi, G = gridDim.x, bx = blockIdx.x;
    float* const mod = (float*)(a.ws + WS_MOD);
    bf16_t* const YB = (bf16_t*)a.out;
    bf16_t* const XB = YB + (size_t)MT * DM;
    bf16_t* const HB = (bf16_t*)(a.ws + WS_HB);
    bf16_t* const R1 = (bf16_t*)(a.ws + WS_R1);
#define IN(k) (lo <= (k) && (k) < hi)
#define SEAM(k) do { if (IN(k) && IN((k) + 1)) { xcd_barrier(xbar); if ((PROBE_REP >> 20) & 1) xcd_barrier(xbar); } } while (0)
    int ph = 0;
    for (int rep = 0; rep < NREP(0); ++rep) { if (PM(0) && IN(ph)) p0_prologue(a, lds); __syncthreads(); }
    if (IN(ph) && bx == 0) for (int i = threadIdx.x; i < XCD_BAR_WORDS; i += 512) __hip_atomic_store(barw + i, 0u, __ATOMIC_RELAXED, __HIP_MEMORY_SCOPE_AGENT);
    if (IN(ph) && IN(ph + 1)) { grid.sync();
        xbar = xcd_barrier_post(barw, MISC + 8); }
    ++ph;
    for (int rep = 0; rep < NREP(1); ++rep) if (PM(1) && IN(ph)) p_modulate0(a);
    SEAM(ph); ++ph;
#pragma unroll 1
    for (int layer = 0; layer < 2; ++layer) {
        const float* lmod = mod + (size_t)layer * NCOND * MODW;
        const bf16_t* w_in = (const bf16_t*)(a.ws + (layer ? WS_WIN1 : WS_WIN0)); const bf16_t* w_out = (const bf16_t*)(a.ws + (layer ? WS_WOUT1 : WS_WOUT0));
        const bf16_t* w_ff1 = (const bf16_t*)(a.ws + (layer ? WS_WFF1_1 : WS_WFF1_0)); const bf16_t* w_ff2 = (const bf16_t*)(a.ws + (layer ? WS_WFF2_1 : WS_WFF2_0));
        const float* g_mix = a.in[layer ? 28 : 17]; const float* b_mix = a.in[layer ? 29 : 18]; const float* g_ff = a.in[layer ? 32 : 21]; const float* b_ff = a.in[layer ? 33 : 22];
        for (int rep = 0; rep < NREP(2); ++rep) if (IN(ph)) {
            if (PM(2) && layer == 0) { pg8::Gemm g{HB, w_in, MT, IN0, DM, DM}; pg8::StaticOrder S; S.init(MT, IN0, G, bx);
                pg8::EpiInProj0 E{R1, a.out + (size_t)MT * DM, a.out + (size_t)MT * DM + (size_t)MP * 512};
                pg8::gemm_phase<pg8::EpiInProj0, pg8::StaticOrder, true, true>(glds, g, S, E);
            } else if (PM(3) && layer == 1) { pg8::Gemm g{HB, w_in, MT, IN1, DM, DM}; pg8::StaticOrder S; S.init(MT, IN1, G, bx);
                pg8::EpiAct<0> E{R1, IN1};
                pg8::gemm_phase<pg8::EpiAct<0>, pg8::StaticOrder, true, true>(glds, g, S, E); }
        }
        SEAM(ph); ++ph;
        if (IN(ph)) { if (layer == 0) { for (int rep = 0; rep < NREP(4); ++rep) { if (PM(4)) p_attention(a, lds); } for (int rep = 0; rep < NREP(5); ++rep) { if (PM(5)) p_sgu(a, lds); } } else for (int rep = 0; rep < NREP(6); ++rep) { if (PM(6)) p_conv(a); } }
        SEAM(ph); ++ph;
        if (PM(7) && IN(ph)) { pg8::Gemm g{HB, w_out, MT, DM, DM, DM}; pg8::StaticOrder S; S.init(MT, DM, G, bx);
            pg8::EpiResid E{a.in[0], a.in[1], layer == 0 ? nullptr : XB, YB, lmod + 2 * DM, 0, nullptr, 0};
            pg8::gemm_phase<pg8::EpiResid, pg8::StaticOrder, true, true>(glds, g, S, E); }
        SEAM(ph); ++ph;
        if (PM(8) && IN(ph)) p_layernorm<true>(YB, g_mix, b_mix, lmod + 3 * DM, HB, XB, nullptr, 0, MT, nullptr);
        SEAM(ph); ++ph;
        float* const Pbuf = (float*)(a.ws + WS_R1 + (size_t)MHALF * DFF * 2);
        const float* const modnext = layer == 0 ? mod + (size_t)NCOND * MODW : nullptr;
        bf16_t* const Y2 = layer == 0 ? YB : HB;
#pragma unroll 1
        for (int half = 0; half < 2; ++half) {
            if (IN(ph)) {
                if (half == 1 && PM(11)) {
                    if (layer == 0) p_layernorm<true>(Y2, g_ff, b_ff, modnext, HB, XB, nullptr, 0, MHALF, Pbuf); else p_layernorm<false>(Y2, g_ff, b_ff, nullptr, nullptr, nullptr, a.out, 0, MHALF, Pbuf); }
                for (int rep = 0; rep < NREP(9); ++rep) if (PM(9)) { pg8::Gemm g{HB + (size_t)half * MHALF * DM, w_ff1, MHALF, DFF, DM, DM}; pg8::StaticOrder S; S.init(MHALF, DFF, G, bx);
                    pg8::EpiAct<1> E{R1, DFF};
                    pg8::gemm_phase<pg8::EpiAct<1>, pg8::StaticOrder, true, true>(glds, g, S, E); }
            }
            SEAM(ph); ++ph;
            if (PM(10) && IN(ph)) { const int helper = bx >= 192; const int koff = helper ? 3072 : 0;
                pg8::Gemm g{R1 + koff, w_ff2 + koff, MHALF, DM, helper ? 1024 : 3072, DFF}; pg8::SplitOrder S{bx};
                pg8::EpiResid E{nullptr, nullptr, XB, Y2, lmod + 5 * DM, half * (MHALF / 256), Pbuf, helper};
                pg8::gemm_phase<pg8::EpiResid, pg8::SplitOrder, true, true>(glds, g, S, E); }
            SEAM(ph); ++ph;
        }
        if (PM(11) && IN(ph)) { if (layer == 0) p_layernorm<true>(Y2, g_ff, b_ff, modnext, HB, XB, nullptr, MHALF, MHALF, Pbuf); else p_layernorm<false>(Y2, g_ff, b_ff, nullptr, nullptr, nullptr, a.out, MHALF, MHALF, Pbuf); }
        if (layer == 0) SEAM(ph);
        ++ph;
    }
#undef IN
#undef SEAM
}

extern "C" void kernel_launch(void* const* d_in, const int* in_sizes, int n_in, void* d_out, int out_size, void* d_ws, size_t ws_size, hipStream_t stream) {
    static int ready = 0;
    if (ready == 0) {
        if (n_in != 34 || ws_size < WS_END) { fprintf(stderr, "kernel_launch: built for 34 inputs and >= %zu bytes of workspace; got n_in %d ws %zu\n", (size_t)WS_END, n_in, ws_size); ready = -1; return; }
        if (hipFuncSetAttribute((const void*)mega_fwd, hipFuncAttributeMaxDynamicSharedMemorySize, LDS_BYTES) != hipSuccess) { fprintf(stderr, "kernel_launch: hipFuncSetAttribute failed\n"); ready = -1; return; }
        int dev = 0, cus = 0, per_cu = 0;
        hipGetDevice(&dev); hipDeviceGetAttribute(&cus, hipDeviceAttributeMultiprocessorCount, dev);
        hipOccupancyMaxActiveBlocksPerMultiprocessor(&per_cu, (const void*)mega_fwd, 512, LDS_BYTES);
        if (cus * per_cu < 256) { fprintf(stderr, "kernel_launch: resident capacity %d x %d < 256 workgroups\n", cus, per_cu); ready = -1; return; }
        ready = 1;
    }
    if (ready < 0) return;
    Args a{};
    for (int i = 0; i < 34; ++i) a.in[i] = (const float*)d_in[i];
    a.out = (float*)d_out; a.ws = (unsigned char*)d_ws;
#if MK_PER_PHASE
    for (int p = 0; p < NPHASE; ++p) { a.ph_lo = p; a.ph_hi = p + 1; hipLaunchKernelGGL(mega_fwd, dim3(256), dim3(512), LDS_BYTES, stream, a); }
#else
    a.ph_lo = 0; a.ph_hi = NPHASE;
    void* args[] = {&a};
    hipError_t e = hipLaunchCooperativeKernel((const void*)mega_fwd, dim3(256), dim3(512), args, LDS_BYTES, stream);
    if (e != hipSuccess) fprintf(stderr, "cooperative launch failed: %s\n", hipGetErrorString(e));
#endif
}
```

```cpp
#include <hip/hip_runtime.h>
#include <hip/hip_cooperative_groups.h>
#include <hip/hip_bf16.h>
#include <cstdio>
#include <cstdint>
namespace cg = cooperative_groups;

#ifndef MK_PER_PHASE
#define MK_PER_PHASE 0
#endif

constexpr int DM = 1024, MP = 8192, MS = 16384, MT = MP + MS;
constexpr int NCOND = 5, MODW = 6 * DM;
constexpr int IN0 = 2560, IN1 = 3072, DFF = 4096;
constexpr float ALPHA_F = 1.4142135623730951f;
constexpr float LN_EPS_F = 1e-5f;
constexpr float LAMBDA_INIT = 0.2f;
constexpr int MHALF = MT / 2;

constexpr size_t WS_MOD  = 0;
constexpr size_t WS_CTL  = 246272;
constexpr size_t WS_CK   = 262144;
constexpr size_t WS_CV   = WS_CK + 1048576;
constexpr size_t WS_WIN0 = WS_CV + 1048576;
constexpr size_t WS_WOUT0 = WS_WIN0 + (size_t)IN0 * DM * 2;
constexpr size_t WS_WFF1_0 = WS_WOUT0 + (size_t)DM * DM * 2;
constexpr size_t WS_WFF2_0 = WS_WFF1_0 + (size_t)DFF * DM * 2;
constexpr size_t WS_WIN1 = WS_WFF2_0 + (size_t)DFF * DM * 2;
constexpr size_t WS_WOUT1 = WS_WIN1 + (size_t)IN1 * DM * 2;
constexpr size_t WS_WFF1_1 = WS_WOUT1 + (size_t)DM * DM * 2;
constexpr size_t WS_WFF2_1 = WS_WFF1_1 + (size_t)DFF * DM * 2;
constexpr size_t WS_HB   = WS_WFF2_1 + (size_t)DFF * DM * 2;
constexpr size_t WS_R1   = WS_HB + (size_t)MT * DM * 2;
constexpr size_t WS_END  = WS_R1 + (size_t)MT * IN1 * 2;
static_assert(WS_END <= 268435456ull, "workspace budget (256 MiB)");
static_assert((size_t)MHALF * DFF * 2 <= (size_t)MT * IN1 * 2, "hidden half fits R1");
constexpr int LDS_BYTES = 131072 + 4096;

__device__ __forceinline__ int opaque_tid() { int t = threadIdx.x; asm volatile("" : "+v"(t)); return t; }
namespace pg8 {
#define PG8_LAS __attribute__((address_space(3)))
typedef unsigned short bf16_t;
typedef short bf16x8 __attribute__((ext_vector_type(8)));
typedef float f32x4 __attribute__((ext_vector_type(4)));
typedef unsigned u32x4 __attribute__((ext_vector_type(4)));
constexpr int BM = 256, BK = 64, HALF = 128, HTB = HALF * BK * 2  , STAGE_BYTES = 8 * HTB, NXCD = 8, WGM = 8;

__host__ __device__ __forceinline__ int lds_byte(int r, int c) { const int st = (r >> 4) * 2 + (c >> 5), rr = r & 15, cc = c & 31, ob = rr * 64 + cc * 2; return st * 1024 + (ob ^ (((ob >> 9) & 1) << 5)); }
__host__ __device__ __forceinline__ void stage_rc(int b, int& R, int& C) { const int st = b / 1024, sb = b % 1024, swz = sb ^ (((sb >> 9) & 1) << 5); R = (st >> 1) * 16 + swz / 64; C = (st & 1) * 32 + (swz % 64) / 2; }
__host__ __device__ __forceinline__ int perm32(int rho) { const int n = rho >> 4, i = rho & 15; return 8 * (i >> 2) + 4 * n + (i & 3); }

struct Unit { int pm, pn; };
struct Gemm { const bf16_t* A; const bf16_t* Bt; int M, N, K, ld; };

struct StaticOrder {
    int nM, nN, nwg, G, c;
    __host__ __device__ void init(int M, int N, int G_, int c_) { nM = M / BM; nN = N / BM; nwg = nM * nN; G = G_; c = c_; }
    __host__ __device__ bool next(int i, Unit& u) const {
        const long L = (long)i * G + c; if (L >= nwg) return false;
        int wgid = (int)L; { const int q = nwg / NXCD, r = nwg % NXCD, xcd = wgid % NXCD, off = wgid / NXCD; wgid = (xcd < r ? xcd * (q + 1) : r * (q + 1) + (xcd - r) * q) + off; }
        const int nig = WGM * nN, gid = wgid / nig, fm = gid * WGM, gsz = (nM - fm) < WGM ? (nM - fm) : WGM;
        u.pm = fm + ((wgid % nig) % gsz); u.pn = (wgid % nig) / gsz; return true;
    }
    __device__ __forceinline__ void a_ready(const Unit&) const {}
    __device__ __forceinline__ void done(const Unit&) const {}
};
__device__ __forceinline__ unsigned cvt_pk_bf16(float lo, float hi) { unsigned r; asm volatile("v_cvt_pk_bf16_f32 %0, %1, %2" : "=v"(r) : "v"(lo), "v"(hi)); return r; }
typedef float f32x2 __attribute__((ext_vector_type(2)));
typedef unsigned u32x2 __attribute__((ext_vector_type(2)));
struct EpiInProj0 {
    static constexpr bool PERM = false, AFTER_DRAIN = false;
    bf16_t* O; float* newk; float* newv;
    __device__ __forceinline__ void operator()(const f32x4 (&acc)[2][2][4][2], const Unit& u, int wr, int wc, int fr, int fq) const {
        const int t = u.pn >> 1;
        bf16_t* base = O + (size_t)t * ((size_t)MT * 512);
        const int colt = (u.pn & 1) * 256 + wc * 32 + 4 * fq;
        const bool rope = (t <= 1) && (u.pm >= MP / 256);
        float* f32o = (u.pm < MP / 256) ? (t == 1 ? newk : (t == 2 ? newv : nullptr)) : nullptr;
        float inv[4];
#pragma unroll
        for (int e = 0; e < 4; ++e) inv[e] = __builtin_amdgcn_exp2f(-(float)(4 * fq + e) * (13.287712379549449f / 16.0f));
#pragma unroll
        for (int ai = 0; ai < 2; ++ai)
#pragma unroll
            for (int m = 0; m < 4; ++m) {
                const int row = u.pm * BM + ai * HALF + wr * 64 + m * 16 + fr;
                f32x4 v[2][2];
#pragma unroll
                for (int bj = 0; bj < 2; ++bj) { v[bj][0] = acc[ai][bj][m][0]; v[bj][1] = acc[ai][bj][m][1]; }
                if (rope) {
                    const int tok = (row - MP) & 4095; const float pos = (float)((wc & 1) ? (tok & 63) : (tok >> 6));
                    f32x4 cs, sn;
#pragma unroll
                    for (int e = 0; e < 4; ++e) { const float a = pos * inv[e]; cs[e] = __cosf(a); sn[e] = __sinf(a); }
#pragma unroll
                    for (int bj = 0; bj < 2; ++bj) { const f32x4 x1 = v[bj][0], x2 = v[bj][1]; v[bj][0] = x1 * cs - x2 * sn; v[bj][1] = x1 * sn + x2 * cs; }
                }
                bf16_t* rowp = base + (size_t)row * 512 + colt;
#pragma unroll
                for (int bj = 0; bj < 2; ++bj)
#pragma unroll
                    for (int n = 0; n < 2; ++n) { u32x2 w; w.x = cvt_pk_bf16(v[bj][n][0], v[bj][n][1]); w.y = cvt_pk_bf16(v[bj][n][2], v[bj][n][3]); *(u32x2*)(rowp + bj * HALF + n * 16) = w; }
                if (f32o) { float* fp = f32o + (size_t)row * 512 + colt;
#pragma unroll
                    for (int bj = 0; bj < 2; ++bj)
#pragma unroll
                        for (int n = 0; n < 2; ++n) *(f32x4*)(fp + bj * HALF + n * 16) = v[bj][n]; }
            }
    }
};
struct EpiResid {
    static constexpr bool PERM = true, AFTER_DRAIN = false;
    const float* xp; const float* xs; const bf16_t* xb; bf16_t* yout; const float* gate; int pm_off; bf16_t* P; int helper;
    __device__ __forceinline__ void operator()(const f32x4 (&acc)[2][2][4][2], const Unit& u, int wr, int wc, int fr, int fq) const {
        const int pm = u.pm + pm_off; const int cond = pm < MP / 256 ? 0 : 1 + ((pm - MP / 256) >> 4);
        const int col0 = u.pn * BM + wc * 32 + 8 * fq; const float* g = gate + (size_t)cond * MODW + col0;
        f32x4 gv[2][2];
#pragma unroll
        for (int bj = 0; bj < 2; ++bj)
#pragma unroll
            for (int n = 0; n < 2; ++n) gv[bj][n] = *(const f32x4*)(g + bj * HALF + n * 4);
#pragma unroll
        for (int ai = 0; ai < 2; ++ai)
#pragma unroll
            for (int m = 0; m < 4; ++m) {
                const int row = pm * BM + ai * HALF + wr * 64 + m * 16 + fr;
                if (helper) { bf16_t* pp = P + (size_t)(row - pm_off * BM) * DM + col0;
#pragma unroll
                    for (int bj = 0; bj < 2; ++bj) { const f32x4 p0 = gv[bj][0] * acc[ai][bj][m][0], p1 = gv[bj][1] * acc[ai][bj][m][1];
                        u32x4 o; o.x = cvt_pk_bf16(p0[0], p0[1]); o.y = cvt_pk_bf16(p0[2], p0[3]); o.z = cvt_pk_bf16(p1[0], p1[1]); o.w = cvt_pk_bf16(p1[2], p1[3]);
                        *(u32x4*)(pp + bj * HALF) = o; }
                } else {
                    bf16_t* op = yout + (size_t)row * DM + col0;
#pragma unroll
                    for (int bj = 0; bj < 2; ++bj) { f32x4 x0, x1;
                        if (xb) { const u32x4 w = *(const u32x4*)(xb + (size_t)row * DM + col0 + bj * HALF);
                            x0 = (f32x4){__uint_as_float(w.x << 16), __uint_as_float(w.x & 0xffff0000u), __uint_as_float(w.y << 16), __uint_as_float(w.y & 0xffff0000u)};
                            x1 = (f32x4){__uint_as_float(w.z << 16), __uint_as_float(w.z & 0xffff0000u), __uint_as_float(w.w << 16), __uint_as_float(w.w & 0xffff0000u)};
                        } else { const float* xin = (row < MP ? xp + (size_t)row * DM : xs + (size_t)(row - MP) * DM) + col0 + bj * HALF; x0 = *(const f32x4*)xin; x1 = *(const f32x4*)(xin + 4); }
                        const f32x4 y0 = x0 * ALPHA_F + gv[bj][0] * acc[ai][bj][m][0], y1 = x1 * ALPHA_F + gv[bj][1] * acc[ai][bj][m][1];
                        u32x4 o; o.x = cvt_pk_bf16(y0[0], y0[1]); o.y = cvt_pk_bf16(y0[2], y0[3]); o.z = cvt_pk_bf16(y1[0], y1[1]); o.w = cvt_pk_bf16(y1[2], y1[3]);
                        *(u32x4*)(op + bj * HALF) = o; }
                }
            }
    }
};
template <int ACT> struct EpiAct {
    static constexpr bool PERM = true, AFTER_DRAIN = false;
    bf16_t* O; int ldc;
    __device__ __forceinline__ void operator()(const f32x4 (&acc)[2][2][4][2], const Unit& u, int wr, int wc, int fr, int fq) const {
        const int row0 = u.pm * BM + wr * 64 + fr; const int col0 = u.pn * BM + wc * 32 + 8 * fq;
#pragma unroll
        for (int ai = 0; ai < 2; ++ai)
#pragma unroll
            for (int m = 0; m < 4; ++m) { bf16_t* rowp = O + (size_t)(row0 + ai * HALF + m * 16) * ldc + col0;
#pragma unroll
                for (int bj = 0; bj < 2; ++bj) { f32x4 v0 = acc[ai][bj][m][0], v1 = acc[ai][bj][m][1];
                    if (ACT == 1) { v0 = __builtin_elementwise_max(v0, (f32x4){0.f, 0.f, 0.f, 0.f}); v1 = __builtin_elementwise_max(v1, (f32x4){0.f, 0.f, 0.f, 0.f}); v0 = v0 * v0; v1 = v1 * v1; }
                    u32x4 w; w.x = cvt_pk_bf16(v0[0], v0[1]); w.y = cvt_pk_bf16(v0[2], v0[3]); w.z = cvt_pk_bf16(v1[0], v1[1]); w.w = cvt_pk_bf16(v1[2], v1[3]);
                    *(u32x4*)(rowp + bj * HALF) = w; } }
    }
};

struct SplitOrder {
    int c;
    __device__ __forceinline__ bool next(int i, Unit& u) const {
        if (c < 192) { if (i > 0) return false; StaticOrder s; s.init(MHALF, DM, 192, c); return s.next(0, u); }
        if (i >= 3) return false; const int t = 3 * (c - 192) + i; u.pm = t >> 2; u.pn = t & 3; return true;
    }
    __device__ __forceinline__ void a_ready(const Unit&) const {}
    __device__ __forceinline__ void done(const Unit&) const {}
};

struct EpiInProj1 {
    static constexpr bool PERM = true, AFTER_DRAIN = false;
    bf16_t* BG; bf16_t* Z;
    __device__ __forceinline__ void operator()(const f32x4 (&acc)[2][2][4][2], const Unit& u, int wr, int wc, int fr, int fq) const {
        const int row0 = u.pm * BM + wr * 64 + fr;
        if (u.pn < 4) { const int col0 = u.pn * BM + wc * 32 + 8 * fq;
#pragma unroll
            for (int ai = 0; ai < 2; ++ai)
#pragma unroll
                for (int m = 0; m < 4; ++m) { bf16_t* rowp = BG + (size_t)(row0 + ai * HALF + m * 16) * DM + col0;
#pragma unroll
                    for (int bj = 0; bj < 2; ++bj) { const f32x4 v0 = acc[ai][bj][m][0], v1 = acc[ai][bj][m][1];
                        u32x4 w; w.x = cvt_pk_bf16(v0[0], v0[1]); w.y = cvt_pk_bf16(v0[2], v0[3]); w.z = cvt_pk_bf16(v1[0], v1[1]); w.w = cvt_pk_bf16(v1[2], v1[3]);
                        *(u32x4*)(rowp + bj * HALF) = w; } }
        } else { const int col0 = (u.pn - 4) * HALF + wc * 32 + 8 * fq;
#pragma unroll
            for (int ai = 0; ai < 2; ++ai)
#pragma unroll
                for (int m = 0; m < 4; ++m) { const f32x4 v0 = acc[ai][0][m][0] * acc[ai][1][m][0], v1 = acc[ai][0][m][1] * acc[ai][1][m][1];
                    u32x4 w; w.x = cvt_pk_bf16(v0[0], v0[1]); w.y = cvt_pk_bf16(v0[2], v0[3]); w.z = cvt_pk_bf16(v1[0], v1[1]); w.w = cvt_pk_bf16(v1[2], v1[3]);
                    *(u32x4*)(Z + (size_t)(row0 + ai * HALF + m * 16) * DM + col0) = w; }
        }
    }
};
template <class Epi, class Sched, bool ALIGN_EPI = false, bool SP2 = false>
__device__ __forceinline__ void gemm_phase(PG8_LAS unsigned char* lds, const Gemm g, const Sched& S, const Epi& E) {
    const int tid = opaque_tid(), wid = __builtin_amdgcn_readfirstlane(tid >> 6), lane = tid & 63, wr = wid >> 2, wc = wid & 3, fr = lane & 15, fq = lane >> 4;
    const int K = g.ld, nt = g.K / BK;
    unsigned voffA[2], voffB[2];
#pragma unroll
    for (int i = 0; i < 2; ++i) { int R, C; stage_rc(tid * 16 + i * 8192, R, C); const int Rb = Epi::PERM ? ((R & ~31) + perm32(R & 31)) : R;
        voffA[i] = (unsigned)(R * K + C) * 2u; voffB[i] = (unsigned)(Rb * K + C) * 2u; }
    const size_t kstep = (size_t)(BK * 2);
    const size_t hstep = (size_t)HALF * K * 2;
    const size_t tstep = 2 * hstep;
    const unsigned ldsw = (unsigned)wid * 1024u;
    const int aoff = lds_byte(wr * 64 + fr, fq * 8), boff = lds_byte(wc * 32 + fr, fq * 8);
#define PG8_SA(b, h) (((b) * 2 + (h)) * HTB)
#define PG8_SB(b, h) ((4 + (b) * 2 + (h)) * HTB)
#define PG8_STAGE(bufoff, gbase, voff) do { _Pragma("unroll") for (int _i = 0; _i < 2; ++_i) \
        __builtin_amdgcn_global_load_lds((const unsigned*)((const char*)(gbase) + (voff)[_i]), (PG8_LAS unsigned*)(lds + (bufoff) + ldsw + _i * 8192), 16, 0, 0); } while (0)
#define PG8_LDA(dst, b, h) do { _Pragma("unroll") for (int m = 0; m < 4; ++m) _Pragma("unroll") for (int k = 0; k < 2; ++k) dst[m][k] = *(const PG8_LAS bf16x8*)(lds + PG8_SA(b, h) + aoff + m * 2048 + k * 1024); } while (0)
#define PG8_LDB(dst, b, h) do { _Pragma("unroll") for (int n = 0; n < 2; ++n) _Pragma("unroll") for (int k = 0; k < 2; ++k) dst[n][k] = *(const PG8_LAS bf16x8*)(lds + PG8_SB(b, h) + boff + n * 2048 + k * 1024); } while (0)
#define PG8_MMA(ai, bj, At, Bt) do { __builtin_amdgcn_s_setprio(1); _Pragma("unroll") for (int m = 0; m < 4; ++m) _Pragma("unroll") for (int n = 0; n < 2; ++n) _Pragma("unroll") for (int k = 0; k < 2; ++k) \
        acc[ai][bj][m][n] = __builtin_amdgcn_mfma_f32_16x16x32_bf16(Bt[n][k], At[m][k], acc[ai][bj][m][n], 0, 0, 0); __builtin_amdgcn_s_setprio(0); } while (0)
#define PG8_WAIT_V(n) asm volatile("s_waitcnt vmcnt(" #n ")" ::: "memory")
#define PG8_WAIT_L(n) asm volatile("s_waitcnt lgkmcnt(" #n ")" ::: "memory")
#define PG8_BAR __builtin_amdgcn_s_barrier()
#define PG8_SCHED __builtin_amdgcn_sched_barrier(0)
    Unit cur, nxt; int ui = 0;
    if (!S.next(0, cur)) return;
    f32x4 acc[2][2][4][2];
#pragma unroll
    for (int a = 0; a < 2; ++a)
#pragma unroll
        for (int b = 0; b < 2; ++b)
#pragma unroll
            for (int m = 0; m < 4; ++m)
#pragma unroll
                for (int n = 0; n < 2; ++n) acc[a][b][m][n] = (f32x4){0.f, 0.f, 0.f, 0.f};
    bf16x8 At[4][2], B0[2][2], B1[2][2];
    const char* cA = (const char*)g.A + (size_t)cur.pm * tstep; const char* cB = (const char*)g.Bt + (size_t)cur.pn * tstep;
    S.a_ready(cur);
    if constexpr (SP2) {
        PG8_STAGE(PG8_SB(0, 0), cB, voffB); PG8_STAGE(PG8_SB(0, 1), cB + hstep, voffB); PG8_STAGE(PG8_SA(0, 0), cA, voffA); PG8_STAGE(PG8_SA(0, 1), cA + hstep, voffA);
        if (wr == 1) PG8_BAR;
        PG8_WAIT_V(2); PG8_BAR;
        PG8_STAGE(PG8_SB(1, 0), cB + kstep, voffB); PG8_STAGE(PG8_SA(1, 0), cA + kstep, voffA); PG8_STAGE(PG8_SB(1, 1), cB + hstep + kstep, voffB);
        PG8_WAIT_V(6); PG8_BAR;
    } else {
        PG8_STAGE(PG8_SB(0, 0), cB, voffB); PG8_STAGE(PG8_SA(0, 0), cA, voffA); PG8_STAGE(PG8_SB(0, 1), cB + hstep, voffB); PG8_STAGE(PG8_SA(0, 1), cA + hstep, voffA);
        if (wr == 1) PG8_BAR;
        PG8_WAIT_V(4); PG8_BAR;
        PG8_STAGE(PG8_SB(1, 0), cB + kstep, voffB); PG8_STAGE(PG8_SA(1, 0), cA + kstep, voffA); PG8_STAGE(PG8_SB(1, 1), cB + hstep + kstep, voffB);
        PG8_WAIT_V(6); PG8_BAR;
    }
    for (;;) {
        const bool has_next = S.next(ui + 1, nxt);
        const char* nA = has_next ? (const char*)g.A + (size_t)nxt.pm * tstep : cA; const char* nB = has_next ? (const char*)g.Bt + (size_t)nxt.pn * tstep : cB;
        for (int t = 0; t < nt; t += 2) {
            const bool last = (t == nt - 2);
            const char* a1 = cA + (size_t)(t + 1) * kstep;
            const char* a2 = last ? nA : cA + (size_t)(t + 2) * kstep; const char* b2 = last ? nB : cB + (size_t)(t + 2) * kstep;
            const char* a3 = a2 + kstep; const char* b3 = b2 + kstep;
            if (last && has_next) S.a_ready(nxt);
            if constexpr (SP2) {
            PG8_LDB(B0, 0, 0); PG8_LDB(B1, 0, 1); PG8_SCHED; PG8_LDA(At, 0, 0); PG8_STAGE(PG8_SA(1, 1), a1 + hstep, voffA);
            PG8_WAIT_V(8); PG8_WAIT_L(0); PG8_BAR; PG8_MMA(0, 0, At, B0); PG8_MMA(0, 1, At, B1); PG8_BAR; PG8_SCHED;
            PG8_LDA(At, 0, 1); PG8_STAGE(PG8_SB(0, 0), b2, voffB); PG8_STAGE(PG8_SB(0, 1), b2 + hstep, voffB); PG8_STAGE(PG8_SA(0, 0), a2, voffA);
            PG8_WAIT_V(8); PG8_WAIT_L(0); PG8_BAR; PG8_MMA(1, 0, At, B0); PG8_MMA(1, 1, At, B1); PG8_BAR; PG8_SCHED;
            PG8_LDB(B0, 1, 0); PG8_LDB(B1, 1, 1); PG8_SCHED; PG8_LDA(At, 1, 0); PG8_STAGE(PG8_SA(0, 1), a2 + hstep, voffA);
            PG8_WAIT_V(8); PG8_WAIT_L(0); PG8_BAR; PG8_MMA(0, 0, At, B0); PG8_MMA(0, 1, At, B1); PG8_BAR; PG8_SCHED;
            PG8_LDA(At, 1, 1); PG8_STAGE(PG8_SB(1, 0), b3, voffB); PG8_STAGE(PG8_SB(1, 1), b3 + hstep, voffB); PG8_STAGE(PG8_SA(1, 0), a3, voffA);
            PG8_WAIT_V(8); PG8_WAIT_L(0); PG8_BAR; PG8_MMA(1, 0, At, B0); PG8_MMA(1, 1, At, B1); PG8_BAR; PG8_SCHED;
            } else {
            PG8_LDB(B0, 0, 0); PG8_SCHED; PG8_LDA(At, 0, 0); PG8_STAGE(PG8_SA(1, 1), a1 + hstep, voffA);
            PG8_WAIT_L(8); PG8_BAR; PG8_WAIT_L(0); PG8_MMA(0, 0, At, B0); PG8_BAR; PG8_SCHED;
            PG8_LDB(B1, 0, 1); PG8_STAGE(PG8_SB(0, 0), b2, voffB);
            PG8_BAR; PG8_WAIT_L(0); PG8_MMA(0, 1, At, B1); PG8_BAR;
            PG8_LDA(At, 0, 1); PG8_STAGE(PG8_SA(0, 0), a2, voffA);
            PG8_BAR; PG8_WAIT_L(0); PG8_MMA(1, 0, At, B0); PG8_BAR; PG8_SCHED;
            PG8_STAGE(PG8_SB(0, 1), b2 + hstep, voffB);
            PG8_WAIT_V(6); PG8_BAR; PG8_MMA(1, 1, At, B1); PG8_BAR;
            PG8_LDB(B0, 1, 0); PG8_SCHED; PG8_LDA(At, 1, 0); PG8_STAGE(PG8_SA(0, 1), a2 + hstep, voffA);
            PG8_WAIT_L(8); PG8_BAR; PG8_WAIT_L(0); PG8_MMA(0, 0, At, B0); PG8_BAR; PG8_SCHED;
            PG8_LDB(B1, 1, 1); PG8_STAGE(PG8_SB(1, 0), b3, voffB);
            PG8_BAR; PG8_WAIT_L(0); PG8_MMA(0, 1, At, B1); PG8_BAR;
            PG8_LDA(At, 1, 1); PG8_STAGE(PG8_SA(1, 0), a3, voffA);
            PG8_BAR; PG8_WAIT_L(0); PG8_MMA(1, 0, At, B0); PG8_BAR; PG8_SCHED;
            PG8_STAGE(PG8_SB(1, 1), b3 + hstep, voffB);
            PG8_WAIT_V(6); PG8_BAR; PG8_MMA(1, 1, At, B1); PG8_BAR;
            }
        }
        if constexpr (ALIGN_EPI) { if (wr == 0) PG8_BAR; }
        if constexpr (!Epi::AFTER_DRAIN) { E(acc, cur, wr, wc, fr, fq); S.done(cur); }
        if (!has_next) break;
#pragma unroll
        for (int a = 0; a < 2; ++a)
#pragma unroll
            for (int b = 0; b < 2; ++b)
#pragma unroll
                for (int m = 0; m < 4; ++m)
#pragma unroll
                    for (int n = 0; n < 2; ++n) acc[a][b][m][n] = (f32x4){0.f, 0.f, 0.f, 0.f};
        cur = nxt; cA = nA; cB = nB; ++ui;
        if constexpr (ALIGN_EPI) { if (wr == 1) PG8_BAR; }
    }
    PG8_WAIT_V(0);
    if constexpr (!ALIGN_EPI) { if (wr == 0) PG8_BAR; }
    PG8_BAR;
    if constexpr (Epi::AFTER_DRAIN) { E.fused(acc, cur, wr, wc, fr, fq, lds, wid, lane); S.done(cur); }
#undef PG8_SA
#undef PG8_SB
#undef PG8_STAGE
#undef PG8_LDA
#undef PG8_LDB
#undef PG8_MMA
#undef PG8_WAIT_V
#undef PG8_WAIT_L
#undef PG8_BAR
#undef PG8_SCHED
}
}
namespace att {
using bf16x8 = __attribute__((ext_vector_type(8))) short;
using s16x4  = __attribute__((ext_vector_type(4))) short;
using f32x16 = __attribute__((ext_vector_type(16))) float;
using u32x4  = __attribute__((ext_vector_type(4))) unsigned;
typedef unsigned short bf16_t;
constexpr float SCALE = 0.125f;
constexpr float THR = 8.f;
constexpr int SHM_V = 64 * 128 * 2, SHM_K = 64 * 64 * 2;
constexpr int LDS_ATT = 2 * SHM_V + 2 * SHM_K + 8 * 64 * 4;
#define KSWZ(row, colB) ((row) * 128 + ((colB) ^ ((((row) >> 1) & 7) << 4)))
#define SBAR() __builtin_amdgcn_sched_barrier(0)
__device__ __forceinline__ int crow(int r, int hi) { return (r & 3) + 8 * (r >> 2) + 4 * hi; }
__device__ __forceinline__ unsigned cvtpk(float lo, float hi) { unsigned r; asm volatile("v_cvt_pk_bf16_f32 %0, %1, %2" : "=v"(r) : "v"(lo), "v"(hi)); return r; }

__device__ __forceinline__ void partialSM(f32x16& p0, f32x16& p1, float& m_reg, float& mn, float& alpha) {
  constexpr float C = SCALE * 1.4426950408889634f;
  float pmax = p0[0];
#pragma unroll
  for (int r = 1; r < 16; ++r) pmax = fmaxf(pmax, p0[r]);
#pragma unroll
  for (int r = 0; r < 16; ++r) pmax = fmaxf(pmax, p1[r]);
  { auto rr = __builtin_amdgcn_permlane32_swap(__float_as_uint(pmax), __float_as_uint(pmax), false, false);
    pmax = fmaxf(__uint_as_float(rr[0]), __uint_as_float(rr[1])); }
  if (__builtin_expect(__all(pmax - m_reg <= THR / SCALE), 1)) { mn = m_reg; alpha = 1.f; }
  else { mn = fmaxf(m_reg, pmax); alpha = __builtin_amdgcn_exp2f((m_reg - mn) * C); m_reg = mn; }
  float mnC = -mn * C;
#pragma unroll
  for (int r = 0; r < 16; ++r) p0[r] = fmaf(p0[r], C, mnC);
#pragma unroll
  for (int r = 0; r < 16; ++r) p1[r] = fmaf(p1[r], C, mnC);
#pragma unroll
  for (int r = 0; r < 16; ++r) p0[r] = __builtin_amdgcn_exp2f(p0[r]);
}
__device__ __forceinline__ void finishSM(f32x16& p0, f32x16& p1, float alpha, float& l_reg, bf16x8& pa0, bf16x8& pa1, bf16x8& pa2, bf16x8& pa3) {
#pragma unroll
  for (int r = 0; r < 16; ++r) p1[r] = __builtin_amdgcn_exp2f(p1[r]);
  float ps = 0;
#pragma unroll
  for (int r = 0; r < 16; ++r) ps += p0[r];
#pragma unroll
  for (int r = 0; r < 16; ++r) ps += p1[r];
  { auto rr = __builtin_amdgcn_permlane32_swap(__float_as_uint(ps), __float_as_uint(ps), false, false);
    ps = __uint_as_float(rr[0]) + __uint_as_float(rr[1]); }
  l_reg = l_reg * alpha + ps;
#define PK4(P, BASE, OUT) do { unsigned a0 = cvtpk(P[BASE + 0], P[BASE + 1]), a1 = cvtpk(P[BASE + 2], P[BASE + 3]);   \
    unsigned b0 = cvtpk(P[BASE + 4], P[BASE + 5]), b1 = cvtpk(P[BASE + 6], P[BASE + 7]);                              \
    auto r0 = __builtin_amdgcn_permlane32_swap(a0, b0, false, false); auto r1 = __builtin_amdgcn_permlane32_swap(a1, b1, false, false); \
    u32x4 w = {r0[0], r1[0], r0[1], r1[1]}; OUT = *reinterpret_cast<bf16x8*>(&w); } while (0)
  PK4(p0, 0, pa0); PK4(p0, 8, pa1); PK4(p1, 0, pa2); PK4(p1, 8, pa3);
#undef PK4
}
__device__ __forceinline__ void qkt(f32x16& p0, f32x16& p1, const char* Ks, const bf16x8* qr, int r32, int hi) {
  p0 = f32x16{}; p1 = f32x16{};
#pragma unroll
  for (int d0 = 0; d0 < 4; ++d0) { int cb = (d0 * 16 + hi * 8) * 2;
    bf16x8 b0 = *reinterpret_cast<const bf16x8*>(Ks + KSWZ(r32, cb));
    bf16x8 b1 = *reinterpret_cast<const bf16x8*>(Ks + KSWZ(32 + r32, cb));
    p0 = __builtin_amdgcn_mfma_f32_32x32x16_bf16(b0, qr[d0], p0, 0, 0, 0);
    p1 = __builtin_amdgcn_mfma_f32_32x32x16_bf16(b1, qr[d0], p1, 0, 0, 0); }
}
__device__ __forceinline__ int v_st(int k, int c) { const int kk = (k & ~0xC) | ((k & 4) << 1) | ((k & 8) >> 1); return ((kk >> 3) * 4 + (c >> 5)) * 512 + ((kk & 7) * 32 + (c & 31)) * 2; }
__device__ __forceinline__ int v_rd_base(int lane) { return ((lane & 3) << 3) | (((lane >> 2) & 3) << 6) | (((lane >> 4) & 1) << 5) | (((lane >> 5) & 1) << 8); }
constexpr int v_rd_off(int d0, int ks, int half) { return d0 * 512 + ks * 4096 + half * 2048; }
template <int OFF> __device__ __forceinline__ s16x4 tr_read(int vb) {
  s16x4 r; asm volatile("ds_read_b64_tr_b16 %0, %1 offset:%2" : "=&v"(r) : "v"(vb), "i"(OFF) : "memory"); return r;
}
template <int D0> __device__ __forceinline__ void pv_one(f32x16& od, int vb, bf16x8 pa0, bf16x8 pa1, bf16x8 pa2, bf16x8 pa3) {
  const s16x4 l0 = tr_read<v_rd_off(D0, 0, 0)>(vb), h0 = tr_read<v_rd_off(D0, 0, 1)>(vb), l1 = tr_read<v_rd_off(D0, 1, 0)>(vb), h1 = tr_read<v_rd_off(D0, 1, 1)>(vb);
  const s16x4 l2 = tr_read<v_rd_off(D0, 2, 0)>(vb), h2 = tr_read<v_rd_off(D0, 2, 1)>(vb), l3 = tr_read<v_rd_off(D0, 3, 0)>(vb), h3 = tr_read<v_rd_off(D0, 3, 1)>(vb);
  asm volatile("s_waitcnt lgkmcnt(0)" ::: "memory"); SBAR();
#define PK(L, H) (bf16x8){L[0], L[1], L[2], L[3], H[0], H[1], H[2], H[3]}
  od = __builtin_amdgcn_mfma_f32_32x32x16_bf16(pa0, PK(l0, h0), od, 0, 0, 0);
  od = __builtin_amdgcn_mfma_f32_32x32x16_bf16(pa1, PK(l1, h1), od, 0, 0, 0);
  od = __builtin_amdgcn_mfma_f32_32x32x16_bf16(pa2, PK(l2, h2), od, 0, 0, 0);
  od = __builtin_amdgcn_mfma_f32_32x32x16_bf16(pa3, PK(l3, h3), od, 0, 0, 0);
#undef PK
}
__device__ __forceinline__ void pv_d0(f32x16* o, int vb, bf16x8 pa0, bf16x8 pa1, bf16x8 pa2, bf16x8 pa3) {
  pv_one<0>(o[0], vb, pa0, pa1, pa2, pa3); pv_one<1>(o[1], vb, pa0, pa1, pa2, pa3); pv_one<2>(o[2], vb, pa0, pa1, pa2, pa3); pv_one<3>(o[3], vb, pa0, pa1, pa2, pa3);
}

__device__ __forceinline__ void attn_half(f32x16 (&o)[4], const bf16_t* __restrict__ Qw, const bf16_t* __restrict__ Kc, const bf16_t* __restrict__ Vc,
                                          const bf16_t* __restrict__ Kn, const bf16_t* __restrict__ Vn, int ncache, int NT, char* lds) {
  const int tid = opaque_tid(), wid = tid >> 6, lane = tid & 63, r32 = lane & 31, hi = lane >> 5;
  char* V_lds = lds; char* K_lds = lds + 2 * SHM_V;
  float* wsf = (float*)(lds + 2 * SHM_V + 2 * SHM_K) + wid * 64; float* li_l = wsf; float* al_l = wsf + 32;
  float m_reg = -1e30f, l_reg = 0; bf16x8 qr[4];
#pragma unroll
  for (int d = 0; d < 4; ++d) o[d] = f32x16{};
#pragma unroll
  for (int d0 = 0; d0 < 4; ++d0) qr[d0] = *reinterpret_cast<const bf16x8*>(Qw + d0 * 16);
  const int sr = tid >> 4, sc = (tid & 15) * 8, vst0 = v_st(sr, sc), vst1 = v_st(32 + sr, sc);
  const int kr = tid >> 3, kc = (tid & 7) * 8, kst = KSWZ(kr, kc * 2);
  const int vb0 = (int)(uintptr_t)V_lds + v_rd_base(lane);
  struct { bf16x8 vs0, vs1, ks0; } sr_[2];
#define TPTR(jt, PC, PN) ((jt) < ncache ? (PC) + (size_t)(jt) * (64 * 512) : (PN) + (size_t)((jt) - ncache) * (64 * 512))
#define SLOAD(i, jt) do { const bf16_t* vt_ = TPTR(jt, Vc, Vn); const bf16_t* kt_ = TPTR(jt, Kc, Kn); \
    sr_[i].vs0 = *reinterpret_cast<const bf16x8*>(vt_ + (size_t)sr * 512 + sc); sr_[i].vs1 = *reinterpret_cast<const bf16x8*>(vt_ + (size_t)(32 + sr) * 512 + sc); \
    sr_[i].ks0 = *reinterpret_cast<const bf16x8*>(kt_ + (size_t)kr * 512 + kc); } while (0)
#define SWRITE(b, i) do { *(bf16x8*)(V_lds + (b) * SHM_V + vst0) = sr_[i].vs0; *(bf16x8*)(V_lds + (b) * SHM_V + vst1) = sr_[i].vs1; \
    *(bf16x8*)(K_lds + (b) * SHM_K + kst) = sr_[i].ks0; } while (0)
#define SWAIT() asm volatile("s_waitcnt vmcnt(3)" ::: "memory")
#define RESC(a) do { if (__any((a) < 1.f)) { if (hi == 0) al_l[r32] = (a); asm volatile("s_waitcnt lgkmcnt(0)" ::: "memory"); \
    _Pragma("unroll") for (int d = 0; d < 4; ++d) _Pragma("unroll") for (int r = 0; r < 16; ++r) o[d][r] *= al_l[crow(r, hi)]; } } while (0)
  f32x16 pA0, pA1, pB0, pB1; float mnA, mnB, alA, alB; bf16x8 pa0, pa1, pa2, pa3;
  constexpr int SE = 0, SO = 1;
  __syncthreads();
  SLOAD(SE, 0); asm volatile("s_waitcnt vmcnt(0)" ::: "memory"); SWRITE(0, SE); __syncthreads();
  qkt(pA0, pA1, K_lds, qr, r32, hi); partialSM(pA0, pA1, m_reg, mnA, alA);
  SLOAD(SO, 1); if (2 < NT) SLOAD(SE, 2);
  SWAIT(); SWRITE(1, SO); __syncthreads();
  for (int j = 1; j + 1 < NT; j += 2) {
    SBAR(); qkt(pB0, pB1, K_lds + SHM_K, qr, r32, hi);
    finishSM(pA0, pA1, alA, l_reg, pa0, pa1, pa2, pa3); SBAR();
    SLOAD(SO, j + 2); SBAR();
    pv_d0(o, vb0, pa0, pa1, pa2, pa3); partialSM(pB0, pB1, m_reg, mnB, alB);
    __syncthreads(); SWAIT(); SWRITE(0, SE);
    RESC(alB); __syncthreads();
    SBAR(); qkt(pA0, pA1, K_lds, qr, r32, hi);
    finishSM(pB0, pB1, alB, l_reg, pa0, pa1, pa2, pa3); SBAR();
    if (j + 3 < NT) SLOAD(SE, j + 3); SBAR();
    pv_d0(o, vb0 + SHM_V, pa0, pa1, pa2, pa3); partialSM(pA0, pA1, m_reg, mnA, alA);
    __syncthreads(); SWAIT(); SWRITE(1, SO);
    RESC(alA); __syncthreads();
  }
  SBAR(); qkt(pB0, pB1, K_lds + SHM_K, qr, r32, hi);
  finishSM(pA0, pA1, alA, l_reg, pa0, pa1, pa2, pa3); SBAR();
  pv_d0(o, vb0, pa0, pa1, pa2, pa3); partialSM(pB0, pB1, m_reg, mnB, alB);
  __syncthreads(); RESC(alB);
  finishSM(pB0, pB1, alB, l_reg, pa0, pa1, pa2, pa3); SBAR();
  pv_d0(o, vb0 + SHM_V, pa0, pa1, pa2, pa3);
  if (hi == 0) li_l[r32] = l_reg; asm volatile("s_waitcnt lgkmcnt(0)" ::: "memory");
#pragma unroll
  for (int r = 0; r < 16; ++r) { const float rl = __builtin_amdgcn_rcpf(li_l[crow(r, hi)]);
#pragma unroll
    for (int d = 0; d < 4; ++d) o[d][r] *= rl; }
#undef TPTR
#undef SLOAD
#undef SWRITE
#undef SWAIT
#undef RESC
}
}
typedef unsigned short bf16_t;
typedef float f32x4v __attribute__((ext_vector_type(4)));
typedef float f32x2v __attribute__((ext_vector_type(2)));
typedef unsigned u32x4v __attribute__((ext_vector_type(4)));
typedef unsigned u32x2v __attribute__((ext_vector_type(2)));
typedef short bf16x8v __attribute__((ext_vector_type(8)));
using att::f32x16;
#define LDS_WAIT() asm volatile("s_waitcnt lgkmcnt(0)" ::: "memory")
__device__ __forceinline__ unsigned pk2(float lo, float hi) { return pg8::cvt_pk_bf16(lo, hi); }
__device__ __forceinline__ float bf_lo(unsigned w) { return __uint_as_float(w << 16); }
__device__ __forceinline__ float bf_hi(unsigned w) { return __uint_as_float(w & 0xffff0000u); }
__device__ __forceinline__ float wave_sum(float v) {
#pragma unroll
    for (int o = 1; o < 64; o <<= 1) v += __shfl_xor(v, o);
    return v;
}
#define LAS __attribute__((address_space(3)))
#define XB_TMO      128
#define XB_XCNT(j)  (256  + 64 * (j))
#define XB_XSUB(j)  (1280 + 64 * (j))
#define XB_XGEN(j)  (2304 + 64 * (j))
#define XB_TOP      3328
#define XB_TOPGEN   3392
#define XCD_BAR_WORDS 3456
#define XB_SPIN_CAP (1u << 18)

__device__ __forceinline__ unsigned xb_ld(unsigned* p)              { return __hip_atomic_load(p, __ATOMIC_RELAXED, __HIP_MEMORY_SCOPE_AGENT); }
__device__ __forceinline__ unsigned xb_add(unsigned* p, unsigned v) { return __hip_atomic_fetch_add(p, v, __ATOMIC_RELAXED, __HIP_MEMORY_SCOPE_AGENT); }
__device__ __forceinline__ unsigned xb_xcc_id() { return (unsigned)__builtin_amdgcn_s_getreg((3 << 11) | 20) & 0xFu; }
#define XB_SPIN(cond, bar) do { unsigned _sp = 0; while (cond) { __builtin_amdgcn_s_sleep(1); \
    if ((++_sp & 255u) == 0u) { if (xb_ld(&(bar)[XB_TMO])) break; if (_sp > XB_SPIN_CAP) { atomicAdd(&(bar)[XB_TMO], 1u); break; } } } } while (0)

struct XcdBarrier {
    unsigned* bar; unsigned x;
    volatile LAS unsigned* st;
};

__device__ __forceinline__ XcdBarrier xcd_barrier_post(unsigned* bar, volatile LAS unsigned* st) {
    XcdBarrier b; b.bar = bar; b.x = xb_xcc_id(); b.st = st;
    if (threadIdx.x == 0) (void)xb_add(&bar[XB_XCNT(b.x)], 1u);
    return b;
}
__device__ __forceinline__ void xcd_barrier_complete(unsigned* bar, unsigned x, unsigned& nloc, unsigned& nx) {
    const unsigned G = gridDim.x * gridDim.y * gridDim.z;
    unsigned sum, cnt, mine, sp = 0u;
    for (;;) {
        sum = 0u; cnt = 0u; mine = 0u;
#pragma unroll
        for (unsigned j = 0; j < 16; ++j) { const unsigned c = xb_ld(&bar[XB_XCNT(j)]); sum += c; cnt += (c > 0u) ? 1u : 0u; mine = (j == x) ? c : mine; }
        if (sum == G) break;
        __builtin_amdgcn_s_sleep(1);
        if ((++sp & 255u) == 0u) { if (xb_ld(&bar[XB_TMO])) break; if (sp > XB_SPIN_CAP) { atomicAdd(&bar[XB_TMO], 1u); break; } }
    }
    nloc = mine > 0u ? mine : 1u; nx = cnt > 0u ? cnt : 1u;
}

__device__ __forceinline__ void xcd_barrier(const XcdBarrier& b) {
    asm volatile("s_waitcnt vmcnt(0)" ::: "memory");
    __syncthreads();
    if (threadIdx.x == 0) {
        unsigned* bar = b.bar;
        __builtin_amdgcn_s_waitcnt(0);
        unsigned nloc = b.st[0], nx = b.st[1];
        if (nloc == 0u) { xcd_barrier_complete(bar, b.x, nloc, nx); b.st[0] = nloc; b.st[1] = nx; }
        const unsigned old = xb_add(&bar[XB_XSUB(b.x)], 1u);
        const unsigned gen = old / nloc;
        if (old + 1u == (gen + 1u) * nloc) {
            __builtin_amdgcn_fence(__ATOMIC_RELEASE, "agent");
            asm volatile("s_waitcnt vmcnt(0)" ::: "memory");
            const unsigned og = xb_add(&bar[XB_TOP], 1u);
            const unsigned tg = og / nx;
            if (og + 1u == (tg + 1u) * nx) xb_add(&bar[XB_TOPGEN], 1u);
            else XB_SPIN(xb_ld(&bar[XB_TOPGEN]) == tg, bar);
            __builtin_amdgcn_fence(__ATOMIC_ACQUIRE, "agent");
            xb_add(&bar[XB_XGEN(b.x)], 1u);
            asm volatile("s_waitcnt vmcnt(0)" ::: "memory");
        } else {
            XB_SPIN(xb_ld(&bar[XB_XGEN(b.x)]) == gen, bar);
            __builtin_amdgcn_fence(__ATOMIC_ACQUIRE, "agent");
            asm volatile("s_waitcnt vmcnt(0)" ::: "memory");
        }
    }
    __syncthreads();
}

struct Args { const float* in[34]; float* out; unsigned char* ws; int ph_lo, ph_hi; };

__device__ __forceinline__ int in1_row(int n) { if (n < 1024) return n; const int j = (n - 1024) & 1023, t = j >> 7, i = j & 127; return 1024 + 256 * t + (n >= 2048 ? 128 : 0) + i; }
template <bool MAP1 = false>
__device__ __forceinline__ void p0_transpose_item(const float* __restrict__ W, int K, int N, bf16_t* __restrict__ WT, float* scr, int item, int lane) {
    const int nblk = N / 32, kb = item / nblk, nb = item % nblk, k0 = 64 * kb, n0 = 32 * nb;
#pragma unroll 8
    for (int i = 0; i < 32; ++i) { const int kk = 2 * i + (lane >> 5); scr[kk * 33 + (lane & 31)] = W[(size_t)(k0 + kk) * N + n0 + (lane & 31)]; }
    LDS_WAIT(); asm volatile("" ::: "memory");
    const int c = lane & 7;
#pragma unroll
    for (int j = 0; j < 4; ++j) { const int n = (lane >> 3) + 8 * j; const float* s = scr + (8 * c) * 33 + n;
        u32x4v o; o.x = pk2(s[0 * 33], s[1 * 33]); o.y = pk2(s[2 * 33], s[3 * 33]); o.z = pk2(s[4 * 33], s[5 * 33]); o.w = pk2(s[6 * 33], s[7 * 33]);
        *(u32x4v*)(WT + (size_t)(MAP1 ? in1_row(n0 + n) : n0 + n) * K + k0 + 8 * c) = o; }
    LDS_WAIT(); asm volatile("" ::: "memory");
}
__device__ __forceinline__ void p0_adaln_item(const Args& a, int item, float* silu_tab  , float* part  , int tid) {
    const int wid = tid >> 6, lane = tid & 63;
    const int layer = item / 48, blk = item % 48, j0 = blk * 128 + 2 * lane;
    const float* wm = a.in[layer ? 23 : 6]; const float* bm = a.in[layer ? 24 : 7];
    for (int i = tid; i < NCOND * DM; i += 512) { const int c = i >> 10, k = i & 1023; const float x = c == 0 ? a.in[5][k] : a.in[4][(c - 1) * DM + k]; silu_tab[i] = x / (1.f + __expf(-x)); }
    __syncthreads();
    f32x2v acc[NCOND];
#pragma unroll
    for (int c = 0; c < NCOND; ++c) acc[c] = (f32x2v){0.f, 0.f};
    const int kb = wid * 128;
    for (int k = kb; k < kb + 128; k += 16) {
        f32x2v w[16];
#pragma unroll
        for (int u = 0; u < 16; ++u) w[u] = *(const f32x2v*)(wm + (size_t)(k + u) * MODW + j0);
#pragma unroll
        for (int u = 0; u < 16; ++u)
#pragma unroll
            for (int c = 0; c < NCOND; ++c) acc[c] += w[u] * silu_tab[c * DM + k + u];
    }
#pragma unroll
    for (int c = 0; c < NCOND; ++c) *(f32x2v*)(part + (wid * NCOND + c) * 128 + 2 * lane) = acc[c];
    __syncthreads();
    float* mod = (float*)(a.ws + WS_MOD) + (size_t)layer * NCOND * MODW;
    for (int o = tid; o < NCOND * 128; o += 512) { const int c = o >> 7, j = o & 127; float s = bm[blk * 128 + j];
#pragma unroll
        for (int w8 = 0; w8 < 8; ++w8) s += part[(w8 * NCOND + c) * 128 + j];
        mod[(size_t)c * MODW + blk * 128 + j] = s; }
    __syncthreads();
}
__device__ __forceinline__ int row_cond(int row) { return row < MP ? 0 : 1 + ((row - MP) >> 12); }
__device__ __forceinline__ const float* x_in_row(const Args& a, int row) { return row < MP ? a.in[0] + (size_t)row * DM : a.in[1] + (size_t)(row - MP) * DM; }

__device__ __forceinline__ void p0_prologue(const Args& a, char* lds) {
    const int tid = opaque_tid(), wid = tid >> 6, lane = tid & 63, G = gridDim.x;
    float* scr = (float*)(lds + wid * 8704);
    if (blockIdx.x < 96) p0_adaln_item(a, blockIdx.x, (float*)(lds + 73728), (float*)(lds + 73728 + 20480), tid);
    const int gw = blockIdx.x * 8 + wid, NGW = G * 8;
    constexpr int I_IN0 = 16 * (IN0 / 32), I_OUT = 16 * 32, I_FF1 = 16 * (DFF / 32), I_FF2 = 64 * 32, I_IN1 = 16 * (IN1 / 32);
    constexpr int NITEMS = I_IN0 + I_OUT + I_FF1 + I_FF2 + I_IN1 + I_OUT + I_FF1 + I_FF2;
    constexpr int PASS1_PER_WAVE = 5;
    const int n_late = (G > 96) ? (G - 96) * 8 : 0, pass1 = n_late * PASS1_PER_WAVE < NITEMS ? n_late * PASS1_PER_WAVE : NITEMS;
#pragma unroll 1
    for (int pass = 0; pass < 2; ++pass) {
        int it0, it1, stride, first;
        if (pass == 0) { it0 = 0; it1 = pass1; stride = n_late; first = (int)blockIdx.x >= 96 ? (gw - 96 * 8) : it1; }
        else { it0 = pass1; it1 = NITEMS; stride = NGW; first = gw; }
        if (stride <= 0) continue;
#pragma unroll 1
        for (int it = it0 + first; it < it1; it += stride) {
        int r = it;
        if (r < I_IN0) { p0_transpose_item(a.in[8], DM, IN0, (bf16_t*)(a.ws + WS_WIN0), scr, r, lane); continue; } r -= I_IN0;
        if (r < I_OUT) { p0_transpose_item(a.in[16], DM, DM, (bf16_t*)(a.ws + WS_WOUT0), scr, r, lane); continue; } r -= I_OUT;
        if (r < I_FF1) { p0_transpose_item(a.in[19], DM, DFF, (bf16_t*)(a.ws + WS_WFF1_0), scr, r, lane); continue; } r -= I_FF1;
        if (r < I_FF2) { p0_transpose_item(a.in[20], DFF, DM, (bf16_t*)(a.ws + WS_WFF2_0), scr, r, lane); continue; } r -= I_FF2;
        if (r < I_IN1) { p0_transpose_item<true>(a.in[25], DM, IN1, (bf16_t*)(a.ws + WS_WIN1), scr, r, lane); continue; } r -= I_IN1;
        if (r < I_OUT) { p0_transpose_item(a.in[27], DM, DM, (bf16_t*)(a.ws + WS_WOUT1), scr, r, lane); continue; } r -= I_OUT;
        if (r < I_FF1) { p0_transpose_item(a.in[30], DM, DFF, (bf16_t*)(a.ws + WS_WFF1_1), scr, r, lane); continue; } r -= I_FF1;
        p0_transpose_item(a.in[31], DFF, DM, (bf16_t*)(a.ws + WS_WFF2_1), scr, r, lane);
            }
    }
    for (int i = blockIdx.x * 512 + tid; i < 2 * 131072 / 2; i += G * 512) {
        const bool isk = i < 65536; const int j = isk ? i : i - 65536;
        const float* src = (isk ? a.in[2] : a.in[3]) + (size_t)j * 8;
        const f32x4v x0 = *(const f32x4v*)src, x1 = *(const f32x4v*)(src + 4);
        u32x4v o; o.x = pk2(x0[0], x0[1]); o.y = pk2(x0[2], x0[3]); o.z = pk2(x1[0], x1[1]); o.w = pk2(x1[2], x1[3]);
        *(u32x4v*)((bf16_t*)(a.ws + (isk ? WS_CK : WS_CV)) + (size_t)j * 8) = o;
    }
    if (blockIdx.x == G - 1 && wid == 7) {
        const float s1 = wave_sum(a.in[9][lane] * a.in[10][lane]), s2 = wave_sum(a.in[11][lane] * a.in[12][lane]);
        if (lane == 0) ((float*)(a.ws + WS_MOD))[2 * NCOND * MODW] = __expf(s1) - __expf(s2) + LAMBDA_INIT;
    }
}
__device__ __forceinline__ void p_modulate0(const Args& a) {
    const int tid = opaque_tid(), wid = tid >> 6, lane = tid & 63;
    const float* mod = (const float*)(a.ws + WS_MOD); bf16_t* HB = (bf16_t*)(a.ws + WS_HB);
    for (int row = blockIdx.x * 8 + wid; row < MT; row += gridDim.x * 8) {
        const float* xr = x_in_row(a, row) + 4 * lane; const float* mc = mod + (size_t)row_cond(row) * MODW + 4 * lane;
        unsigned long long* o8 = (unsigned long long*)(HB + (size_t)row * DM) + lane;
#pragma unroll
        for (int j = 0; j < 4; ++j) { const f32x4v x = *(const f32x4v*)(xr + 256 * j), sh = *(const f32x4v*)(mc + 256 * j), sc = *(const f32x4v*)(mc + DM + 256 * j);
            const f32x4v h = x * (sc + 1.f) + sh; o8[64 * j] = (unsigned long long)pk2(h[0], h[1]) | ((unsigned long long)pk2(h[2], h[3]) << 32); }
    }
}
template <bool WRITE_H>
__device__ __forceinline__ void p_layernorm(const bf16_t* __restrict__ Y, const float* __restrict__ g, const float* __restrict__ b, const float* __restrict__ modn, bf16_t* HB, bf16_t* XB, float* OUT,
                                            int row0, int nrows, const bf16_t* __restrict__ P) {
    const int tid = opaque_tid(), wid = tid >> 6, lane = tid & 63;
    for (int row = row0 + blockIdx.x * 8 + wid; row < row0 + nrows; row += gridDim.x * 8) {
        const bf16_t* yr = Y + (size_t)row * DM + 8 * lane; const bf16_t* pr = P ? P + (size_t)(row - row0) * DM + 8 * lane : nullptr;
        f32x4v v[4]; float s = 0.f;
#pragma unroll
        for (int j = 0; j < 2; ++j) { const u32x4v w = *(const u32x4v*)(yr + 512 * j);
            v[2 * j] = (f32x4v){bf_lo(w.x), bf_hi(w.x), bf_lo(w.y), bf_hi(w.y)}; v[2 * j + 1] = (f32x4v){bf_lo(w.z), bf_hi(w.z), bf_lo(w.w), bf_hi(w.w)};
            if (pr) { const u32x4v q = *(const u32x4v*)(pr + 512 * j); v[2 * j] += (f32x4v){bf_lo(q.x), bf_hi(q.x), bf_lo(q.y), bf_hi(q.y)}; v[2 * j + 1] += (f32x4v){bf_lo(q.z), bf_hi(q.z), bf_lo(q.w), bf_hi(q.w)}; } }
#pragma unroll
        for (int j = 0; j < 4; ++j) s += (v[j][0] + v[j][1]) + (v[j][2] + v[j][3]);
        const float mean = wave_sum(s) * (1.f / DM); float s2 = 0.f;
#pragma unroll
        for (int j = 0; j < 4; ++j) { v[j] = v[j] - mean; s2 += (v[j][0] * v[j][0] + v[j][1] * v[j][1]) + (v[j][2] * v[j][2] + v[j][3] * v[j][3]); }
        const float rstd = 1.f / sqrtf(wave_sum(s2) * (1.f / DM) + LN_EPS_F);
        const float* mc = WRITE_H ? modn + (size_t)row_cond(row) * MODW + 8 * lane : nullptr;
#pragma unroll
        for (int j = 0; j < 2; ++j) { const int c = 8 * lane + 512 * j;
            const f32x4v y0 = v[2 * j] * rstd * *(const f32x4v*)(g + c) + *(const f32x4v*)(b + c), y1 = v[2 * j + 1] * rstd * *(const f32x4v*)(g + c + 4) + *(const f32x4v*)(b + c + 4);
            if (XB) { u32x4v o; o.x = pk2(y0[0], y0[1]); o.y = pk2(y0[2], y0[3]); o.z = pk2(y1[0], y1[1]); o.w = pk2(y1[2], y1[3]); *(u32x4v*)(XB + (size_t)row * DM + c) = o; }
            if (OUT) { *(f32x4v*)(OUT + (size_t)row * DM + c) = y0; *(f32x4v*)(OUT + (size_t)row * DM + c + 4) = y1; }
            if (WRITE_H) { const f32x4v h0 = y0 * (*(const f32x4v*)(mc + DM + 512 * j) + 1.f) + *(const f32x4v*)(mc + 512 * j), h1 = y1 * (*(const f32x4v*)(mc + DM + 512 * j + 4) + 1.f) + *(const f32x4v*)(mc + 512 * j + 4);
                u32x4v o; o.x = pk2(h0[0], h0[1]); o.y = pk2(h0[2], h0[3]); o.z = pk2(h1[0], h1[1]); o.w = pk2(h1[2], h1[3]); *(u32x4v*)(HB + (size_t)row * DM + c) = o; } }
    }
}
__device__ __forceinline__ void p_conv(const Args& a) {
    const int tid = opaque_tid(), wid = tid >> 6, lane = tid & 63;
    const bf16_t* BG = (const bf16_t*)(a.ws + WS_R1); const bf16_t* Z = BG + (size_t)MT * DM; bf16_t* MIX = (bf16_t*)(a.ws + WS_HB); const float* cw = a.in[26];
    for (int row = blockIdx.x * 8 + wid; row < MT; row += gridDim.x * 8) {
        const int pos = row < MP ? (row & 255) : ((row - MP) & 4095), len = row < MP ? 256 : 4096;
        const bool hasl = pos > 0, hasr = pos < len - 1;
#pragma unroll
        for (int j = 0; j < 2; ++j) {
            const int c8 = (lane + 64 * j) * 8; const bf16_t* p = Z + (size_t)row * DM + c8;
            const u32x4v bg = *(const u32x4v*)(BG + (size_t)row * DM + c8), z1 = *(const u32x4v*)p;
            u32x4v z0 = {0, 0, 0, 0}, z2 = z0;
            if (hasl) z0 = *(const u32x4v*)(p - DM);
            if (hasr) z2 = *(const u32x4v*)(p + DM);
            const f32x4v w0a = *(const f32x4v*)(cw + c8), w0b = *(const f32x4v*)(cw + c8 + 4), w1a = *(const f32x4v*)(cw + DM + c8), w1b = *(const f32x4v*)(cw + DM + c8 + 4),
                         w2a = *(const f32x4v*)(cw + 2 * DM + c8), w2b = *(const f32x4v*)(cw + 2 * DM + c8 + 4);
            u32x4v o;
#pragma unroll
            for (int e = 0; e < 4; ++e) {
                const float w0l = e < 2 ? w0a[2 * e] : w0b[2 * e - 4], w0h = e < 2 ? w0a[2 * e + 1] : w0b[2 * e - 3];
                const float w1l = e < 2 ? w1a[2 * e] : w1b[2 * e - 4], w1h = e < 2 ? w1a[2 * e + 1] : w1b[2 * e - 3];
                const float w2l = e < 2 ? w2a[2 * e] : w2b[2 * e - 4], w2h = e < 2 ? w2a[2 * e + 1] : w2b[2 * e - 3];
                const float yl = bf_lo(z0[e]) * w0l + bf_lo(z1[e]) * w1l + bf_lo(z2[e]) * w2l;
                const float yh = bf_hi(z0[e]) * w0h + bf_hi(z1[e]) * w1h + bf_hi(z2[e]) * w2h;
                o[e] = pk2(bf_lo(bg[e]) * yl, bf_hi(bg[e]) * yh);
            }
            *(u32x4v*)(MIX + (size_t)row * DM + c8) = o;
        }
    }
}
__device__ __forceinline__ void p_attention(const Args& a, char* lds) {
    const int tid = opaque_tid(), wid = tid >> 6, lane = tid & 63, r32 = lane & 31, hi = lane >> 5;
    const bf16_t* QB = (const bf16_t*)(a.ws + WS_R1); const bf16_t* KB = QB + (size_t)MT * 512; const bf16_t* VB = KB + (size_t)MT * 512;
    const bf16_t* CK = (const bf16_t*)(a.ws + WS_CK); const bf16_t* CV = (const bf16_t*)(a.ws + WS_CV);
    bf16_t* MIX = (bf16_t*)(a.ws + WS_HB);
    const float lam = ((const float*)(a.ws + WS_MOD))[2 * NCOND * MODW];
    float* o0s = a.out + (((size_t)blockIdx.x * 8 + wid) * 64 + lane) * 64;
    const float* subg = a.in[13];
    for (int ui = blockIdx.x; ui < 256 + 128; ui += gridDim.x) {
        int qrow0, h, ncache, NT; const bf16_t *Kc, *Vc, *Kn, *Vn;
        if (ui < 256) {
            const int xcd = ui & 7, slot = ui >> 3, bh = xcd * 2 + (slot >> 4), qb = slot & 15, b = bh >> 2; h = bh & 3;
            qrow0 = MP + b * 4096 + qb * 256; ncache = 4; NT = 68;
            Kc = CK + (size_t)(b * 256) * 512; Vc = CV + (size_t)(b * 256) * 512; Kn = KB + (size_t)(MP + b * 4096) * 512; Vn = VB + (size_t)(MP + b * 4096) * 512;
        } else { const int p = ui - 256, b = p >> 2; h = p & 3; qrow0 = b * 256; ncache = 0; NT = 4;
            Kn = KB + (size_t)(b * 256) * 512; Vn = VB + (size_t)(b * 256) * 512; Kc = Kn; Vc = Vn; }
        const bf16_t* Qw = QB + (size_t)(qrow0 + wid * 32 + r32) * 512 + h * 128 + hi * 8;
        f32x16 o[4];
        att::attn_half(o, Qw, Kc + h * 128, Vc + h * 128, Kn + h * 128, Vn + h * 128, ncache, NT, lds);
        { float* op = o0s; asm volatile("" : "+v"(op));
#pragma unroll
        for (int d = 0; d < 4; ++d)
#pragma unroll
            for (int r4 = 0; r4 < 4; ++r4) *(f32x4v*)(op + d * 16 + r4 * 4) = (f32x4v){o[d][4 * r4], o[d][4 * r4 + 1], o[d][4 * r4 + 2], o[d][4 * r4 + 3]}; }
        att::attn_half(o, Qw + 64, Kc + h * 128 + 64, Vc + h * 128, Kn + h * 128 + 64, Vn + h * 128, ncache, NT, lds);
        float ss[16];
#pragma unroll
        for (int r = 0; r < 16; ++r) ss[r] = 0.f;
        int hi_ = hi; const float* op = o0s; asm volatile("" : "+v"(op), "+v"(hi_));
#pragma unroll
        for (int d = 0; d < 4; ++d)
#pragma unroll
            for (int r4 = 0; r4 < 4; ++r4) { const f32x4v o0 = *(const f32x4v*)(op + d * 16 + r4 * 4);
#pragma unroll
                for (int e = 0; e < 4; ++e) { const int r = 4 * r4 + e; const float v = o0[e] - lam * o[d][r]; o[d][r] = v; ss[r] += v * v; } }
#pragma unroll
        for (int r = 0; r < 16; ++r) { float s = ss[r]; s += __shfl_xor(s, 1); s += __shfl_xor(s, 2); s += __shfl_xor(s, 4); s += __shfl_xor(s, 8); s += __shfl_xor(s, 16);
            ss[r] = (1.f - LAMBDA_INIT) / sqrtf(s * (1.f / 128.f) + LN_EPS_F); }
        bf16_t* mo = MIX + (size_t)(qrow0 + wid * 32) * DM + h * 128 + r32;
#pragma unroll
        for (int d = 0; d < 4; ++d) { const float gd = subg[d * 32 + r32];
#pragma unroll
            for (int r = 0; r < 16; ++r) { const float v = o[d][r] * ss[r] * gd; mo[(size_t)att::crow(r, hi_) * DM + d * 32] = (bf16_t)(pk2(v, v) & 0xffffu); } }
    }
}
__device__ __forceinline__ void p_sgu(const Args& a, char* lds) {
    const int tid = opaque_tid(), wid = tid >> 6, lane = tid & 63, r32 = lane & 31, hi = lane >> 5, G = gridDim.x;
    const bf16_t* UB = (const bf16_t*)(a.ws + WS_R1) + (size_t)3 * MT * 512; const bf16_t* GB = UB + (size_t)MT * 512;
    bf16_t* MIX = (bf16_t*)(a.ws + WS_HB);
    const float* sw = a.in[14]; const float* sb = a.in[15];
    bf16_t* Wl = (bf16_t*)lds; bf16_t* VT = (bf16_t*)(lds + 34816);
    int u0, nu; if (G == 256) { if ((int)blockIdx.x < 128) { u0 = blockIdx.x * 2; nu = 2; } else { u0 = 256 + (blockIdx.x - 128) * 4; nu = 4; } } else { u0 = 0; nu = 0; }
    for (int k = 0; (G == 256) ? (k < nu) : ((int)blockIdx.x + k * G < 768); ++k) {
        const int su = (G == 256) ? u0 + k : (int)blockIdx.x + k * G;
        const int chunk = su >> 2, g = su & 3, row0 = chunk * 128;
        __syncthreads();
        for (int it = 0; it < 8; ++it) { const int idx = (it * 512 + tid) * 4, p = idx >> 7, q = idx & 127;
            const f32x4v w = *(const f32x4v*)(sw + (size_t)g * 16384 + idx);
            u32x2v o; o.x = pk2(w[0], w[1]); o.y = pk2(w[2], w[3]); *(u32x2v*)(Wl + p * 136 + q) = o; }
#pragma unroll
        for (int it = 0; it < 4; ++it) { const int tok = wid * 16 + it * 4 + (lane >> 4), d0 = (lane & 15) * 8;
            const u32x4v x = *(const u32x4v*)(GB + (size_t)(row0 + tok) * 512 + g * 128 + d0);
            float f[8];
#pragma unroll
            for (int e = 0; e < 4; ++e) { f[2 * e] = bf_lo(x[e]); f[2 * e + 1] = bf_hi(x[e]); }
            float s = 0.f;
#pragma unroll
            for (int e = 0; e < 8; ++e) s += f[e];
            s += __shfl_xor(s, 1); s += __shfl_xor(s, 2); s += __shfl_xor(s, 4); s += __shfl_xor(s, 8);
            const float mean = s * (1.f / 128.f); float q2 = 0.f;
#pragma unroll
            for (int e = 0; e < 8; ++e) { f[e] -= mean; q2 += f[e] * f[e]; }
            q2 += __shfl_xor(q2, 1); q2 += __shfl_xor(q2, 2); q2 += __shfl_xor(q2, 4); q2 += __shfl_xor(q2, 8);
            const float rstd = 1.f / sqrtf(q2 * (1.f / 128.f) + LN_EPS_F);
#pragma unroll
            for (int e = 0; e < 8; ++e) VT[(d0 + e) * 136 + tok] = (bf16_t)(pk2(f[e] * rstd, 0.f) & 0xffffu);
        }
        __syncthreads();
        const int pbase = (wid & 3) * 32, dbase = (wid >> 2) * 64;
        f32x16 acc[2] = {f32x16{}, f32x16{}};
#pragma unroll
        for (int ks = 0; ks < 8; ++ks) {
            const bf16x8v bw = *(const bf16x8v*)(Wl + (pbase + r32) * 136 + ks * 16 + hi * 8);
#pragma unroll
            for (int ds = 0; ds < 2; ++ds) { const bf16x8v av = *(const bf16x8v*)(VT + (dbase + ds * 32 + r32) * 136 + ks * 16 + hi * 8);
                acc[ds] = __builtin_amdgcn_mfma_f32_32x32x16_bf16(av, bw, acc[ds], 0, 0, 0); }
        }
        const int p = pbase + r32; const float bias = sb[g * 128 + p];
        const bf16_t* up = UB + (size_t)(row0 + p) * 512 + g * 128; bf16_t* mo = MIX + (size_t)(row0 + p) * DM + 512 + g * 128;
#pragma unroll
        for (int ds = 0; ds < 2; ++ds)
#pragma unroll
            for (int rq = 0; rq < 4; ++rq) { const int d = dbase + ds * 32 + 8 * rq + 4 * hi;
                const u32x2v uu = *(const u32x2v*)(up + d);
                u32x2v o; o.x = pk2(bf_lo(uu.x) * (acc[ds][4 * rq] + bias), bf_hi(uu.x) * (acc[ds][4 * rq + 1] + bias));
                o.y = pk2(bf_lo(uu.y) * (acc[ds][4 * rq + 2] + bias), bf_hi(uu.y) * (acc[ds][4 * rq + 3] + bias));
                *(u32x2v*)(mo + d) = o; }
    }
}
constexpr int NPHASE = 20;
#ifndef PHMASK
#define PHMASK 0xfffff
#endif
#define PM(i) ((PHMASK >> (i)) & 1)
#ifndef PROBE_REP
#define PROBE_REP 0
#endif
#define NREP(i) (1 + ((PROBE_REP >> (i)) & 1))
__global__ void __launch_bounds__(512, 2) mega_fwd(Args a) {
    extern __shared__ __attribute__((aligned(16))) unsigned char lds_raw[];
    char* lds = (char*)lds_raw;
    PG8_LAS unsigned char* glds = (PG8_LAS unsigned char*)lds_raw;
    cg::grid_group grid = cg::this_grid();
    volatile LAS unsigned* MISC = (volatile LAS unsigned*)(glds + 131072);
    if (threadIdx.x < 16) MISC[threadIdx.x] = 0u;
    __syncthreads();
    unsigned* const barw = (unsigned*)(a.ws + WS_CTL);
    XcdBarrier xbar; xbar.bar = barw; xbar.x = 0; xbar.st = nullptr;
    const int lo = a.ph_lo, hi = a.ph_hi, G = gridDim.x, bx = blockIdx.x;
    float* const mod = (float*)(a.ws + WS_MOD);
    bf16_t* const YB = (bf16_t*)a.out;
    bf16_t* const XB = YB + (size_t)MT * DM;
    bf16_t* const HB = (bf16_t*)(a.ws + WS_HB);
    bf16_t* const R1 = (bf16_t*)(a.ws + WS_R1);
#define IN(k) (lo <= (k) && (k) < hi)
#define SEAM(k) do { if (IN(k) && IN((k) + 1)) { xcd_barrier(xbar); if ((PROBE_REP >> 20) & 1) xcd_barrier(xbar); } } while (0)
    int ph = 0;
    for (int rep = 0; rep < NREP(0); ++rep) { if (PM(0) && IN(ph)) p0_prologue(a, lds); __syncthreads(); }
    if (IN(ph) && bx == 0) for (int i = threadIdx.x; i < XCD_BAR_WORDS; i += 512) __hip_atomic_store(barw + i, 0u, __ATOMIC_RELAXED, __HIP_MEMORY_SCOPE_AGENT);
    if (IN(ph) && IN(ph + 1)) { grid.sync();
        xbar = xcd_barrier_post(barw, MISC + 8); }
    ++ph;
    for (int rep = 0; rep < NREP(1); ++rep) if (PM(1) && IN(ph)) p_modulate0(a);
    SEAM(ph); ++ph;
#pragma unroll 1
    for (int layer = 0; layer < 2; ++layer) {
        const float* lmod = mod + (size_t)layer * NCOND * MODW;
        const bf16_t* w_in = (const bf16_t*)(a.ws + (layer ? WS_WIN1 : WS_WIN0)); const bf16_t* w_out = (const bf16_t*)(a.ws + (layer ? WS_WOUT1 : WS_WOUT0));
        const bf16_t* w_ff1 = (const bf16_t*)(a.ws + (layer ? WS_WFF1_1 : WS_WFF1_0)); const bf16_t* w_ff2 = (const bf16_t*)(a.ws + (layer ? WS_WFF2_1 : WS_WFF2_0));
        const float* g_mix = a.in[layer ? 28 : 17]; const float* b_mix = a.in[layer ? 29 : 18]; const float* g_ff = a.in[layer ? 32 : 21]; const float* b_ff = a.in[layer ? 33 : 22];
        for (int rep = 0; rep < NREP(2); ++rep) if (IN(ph)) {
            if (PM(2) && layer == 0) { pg8::Gemm g{HB, w_in, MT, IN0, DM, DM}; pg8::StaticOrder S; S.init(MT, IN0, G, bx);
                pg8::EpiInProj0 E{R1, a.out + (size_t)MT * DM, a.out + (size_t)MT * DM + (size_t)MP * 512};
                pg8::gemm_phase<pg8::EpiInProj0, pg8::StaticOrder, true, true>(glds, g, S, E);
            } else if (PM(3) && layer == 1) { pg8::Gemm g{HB, w_in, MT, IN1, DM, DM}; pg8::StaticOrder S; S.init(MT, IN1, G, bx);
                pg8::EpiInProj1 E{R1, R1 + (size_t)MT * DM};
                pg8::gemm_phase<pg8::EpiInProj1, pg8::StaticOrder, true, true>(glds, g, S, E); }
        }
        SEAM(ph); ++ph;
        if (IN(ph)) { if (layer == 0) { for (int rep = 0; rep < NREP(4); ++rep) { if (PM(4)) p_attention(a, lds); } for (int rep = 0; rep < NREP(5); ++rep) { if (PM(5)) p_sgu(a, lds); } } else for (int rep = 0; rep < NREP(6); ++rep) { if (PM(6)) p_conv(a); } }
        SEAM(ph); ++ph;
        if (PM(7) && IN(ph)) { pg8::Gemm g{HB, w_out, MT, DM, DM, DM}; pg8::StaticOrder S; S.init(MT, DM, G, bx);
            pg8::EpiResid E{a.in[0], a.in[1], layer == 0 ? nullptr : XB, YB, lmod + 2 * DM, 0, nullptr, 0};
            pg8::gemm_phase<pg8::EpiResid, pg8::StaticOrder, true, true>(glds, g, S, E); }
        SEAM(ph); ++ph;
        if (PM(8) && IN(ph)) p_layernorm<true>(YB, g_mix, b_mix, lmod + 3 * DM, HB, XB, nullptr, 0, MT, nullptr);
        SEAM(ph); ++ph;
        bf16_t* const Pbuf = (bf16_t*)(a.ws + WS_R1 + (size_t)MHALF * DFF * 2);
        const float* const modnext = layer == 0 ? mod + (size_t)NCOND * MODW : nullptr;
        bf16_t* const Y2 = layer == 0 ? YB : HB;
#pragma unroll 1
        for (int half = 0; half < 2; ++half) {
            if (IN(ph)) {
                if (half == 1 && PM(11)) {
                    if (layer == 0) p_layernorm<true>(Y2, g_ff, b_ff, modnext, HB, XB, nullptr, 0, MHALF, Pbuf); else p_layernorm<false>(Y2, g_ff, b_ff, nullptr, nullptr, nullptr, a.out, 0, MHALF, Pbuf); }
                for (int rep = 0; rep < NREP(9); ++rep) if (PM(9)) { pg8::Gemm g{HB + (size_t)half * MHALF * DM, w_ff1, MHALF, DFF, DM, DM}; pg8::StaticOrder S; S.init(MHALF, DFF, G, bx);
                    pg8::EpiAct<1> E{R1, DFF};
                    pg8::gemm_phase<pg8::EpiAct<1>, pg8::StaticOrder, true, true>(glds, g, S, E); }
            }
            SEAM(ph); ++ph;
            if (PM(10) && IN(ph)) { const int helper = bx >= 192; const int koff = helper ? 3072 : 0;
                pg8::Gemm g{R1 + koff, w_ff2 + koff, MHALF, DM, helper ? 1024 : 3072, DFF}; pg8::SplitOrder S{bx};
                pg8::EpiResid E{nullptr, nullptr, XB, Y2, lmod + 5 * DM, half * (MHALF / 256), Pbuf, helper};
                pg8::gemm_phase<pg8::EpiResid, pg8::SplitOrder, true, true>(glds, g, S, E); }
            SEAM(ph); ++ph;
        }
        if (PM(11) && IN(ph)) { if (layer == 0) p_layernorm<true>(Y2, g_ff, b_ff, modnext, HB, XB, nullptr, MHALF, MHALF, Pbuf); else p_layernorm<false>(Y2, g_ff, b_ff, nullptr, nullptr, nullptr, a.out, MHALF, MHALF, Pbuf); }
        if (layer == 0) SEAM(ph);
        ++ph;
    }
#undef IN
#undef SEAM
}

extern "C" void kernel_launch(void* const* d_in, const int* in_sizes, int n_in, void* d_out, int out_size, void* d_ws, size_t ws_size, hipStream_t stream) {
    static int ready = 0;
    if (ready == 0) {
        if (n_in != 34 || ws_size < WS_END) { fprintf(stderr, "kernel_launch: built for 34 inputs and >= %zu bytes of workspace; got n_in %d ws %zu\n", (size_t)WS_END, n_in, ws_size); ready = -1; return; }
        if (hipFuncSetAttribute((const void*)mega_fwd, hipFuncAttributeMaxDynamicSharedMemorySize, LDS_BYTES) != hipSuccess) { fprintf(stderr, "kernel_launch: hipFuncSetAttribute failed\n"); ready = -1; return; }
        int dev = 0, cus = 0, per_cu = 0;
        hipGetDevice(&dev); hipDeviceGetAttribute(&cus, hipDeviceAttributeMultiprocessorCount, dev);
        hipOccupancyMaxActiveBlocksPerMultiprocessor(&per_cu, (const void*)mega_fwd, 512, LDS_BYTES);
        if (cus * per_cu < 256) { fprintf(stderr, "kernel_launch: resident capacity %d x %d < 256 workgroups\n", cus, per_cu); ready = -1; return; }
        ready = 1;
    }
    if (ready < 0) return;
    Args a{};
    for (int i = 0; i < 34; ++i) a.in[i] = (const float*)d_in[i];
    a.out = (float*)d_out; a.ws = (unsigned char*)d_ws;
#if MK_PER_PHASE
    for (int p = 0; p < NPHASE; ++p) { a.ph_lo = p; a.ph_hi = p + 1; hipLaunchKernelGGL(mega_fwd, dim3(256), dim3(512), LDS_BYTES, stream, a); }
#else
    a.ph_lo = 0; a.ph_hi = NPHASE;
    void* args[] = {&a};
    hipError_t e = hipLaunchCooperativeKernel((const void*)mega_fwd, dim3(256), dim3(512), args, LDS_BYTES, stream);
    if (e != hipSuccess) fprintf(stderr, "cooperative launch failed: %s\n", hipGetErrorString(e));
#endif
}
```

```cpp
#include <hip/hip_runtime.h>
#include <hip/hip_cooperative_groups.h>
#include <hip/hip_bf16.h>
#include <cstdio>
#include <cstdint>
namespace cg = cooperative_groups;

#ifndef MK_PER_PHASE
#define MK_PER_PHASE 0
#endif

constexpr int DM = 1024, MP = 8192, MS = 16384, MT = MP + MS;
constexpr int NCOND = 5, MODW = 6 * DM;
constexpr int IN0 = 2560, IN1 = 3072, DFF = 4096;
constexpr float ALPHA_F = 1.4142135623730951f;
constexpr float LN_EPS_F = 1e-5f;
constexpr float LAMBDA_INIT = 0.2f;
constexpr int MHALF = MT / 2;

constexpr size_t WS_MOD  = 0;
constexpr size_t WS_CTL  = 246272;
constexpr size_t WS_CK   = 262144;
constexpr size_t WS_CV   = WS_CK + 1048576;
constexpr size_t WS_WIN0 = WS_CV + 1048576;
constexpr size_t WS_WOUT0 = WS_WIN0 + (size_t)IN0 * DM * 2;
constexpr size_t WS_WFF1_0 = WS_WOUT0 + (size_t)DM * DM * 2;
constexpr size_t WS_WFF2_0 = WS_WFF1_0 + (size_t)DFF * DM * 2;
constexpr size_t WS_WIN1 = WS_WFF2_0 + (size_t)DFF * DM * 2;
constexpr size_t WS_WOUT1 = WS_WIN1 + (size_t)IN1 * DM * 2;
constexpr size_t WS_WFF1_1 = WS_WOUT1 + (size_t)DM * DM * 2;
constexpr size_t WS_WFF2_1 = WS_WFF1_1 + (size_t)DFF * DM * 2;
constexpr size_t WS_HB   = WS_WFF2_1 + (size_t)DFF * DM * 2;
constexpr size_t WS_R1   = WS_HB + (size_t)MT * DM * 2;
constexpr size_t WS_END  = WS_R1 + (size_t)MT * IN1 * 2;
static_assert(WS_END <= 268435456ull, "workspace budget (256 MiB)");
static_assert((size_t)MHALF * DFF * 2 <= (size_t)MT * IN1 * 2, "hidden half fits R1");
constexpr int LDS_BYTES = 131072 + 4096;

__device__ __forceinline__ int opaque_tid() { int t = threadIdx.x; asm volatile("" : "+v"(t)); return t; }
namespace pg8 {
#define PG8_LAS __attribute__((address_space(3)))
typedef unsigned short bf16_t;
typedef short bf16x8 __attribute__((ext_vector_type(8)));
typedef float f32x4 __attribute__((ext_vector_type(4)));
typedef unsigned u32x4 __attribute__((ext_vector_type(4)));
constexpr int BM = 256, BK = 64, HALF = 128, HTB = HALF * BK * 2  , STAGE_BYTES = 8 * HTB, NXCD = 8, WGM = 8;

__host__ __device__ __forceinline__ int lds_byte(int r, int c) { const int st = (r >> 4) * 2 + (c >> 5), rr = r & 15, cc = c & 31, ob = rr * 64 + cc * 2; return st * 1024 + (ob ^ (((ob >> 9) & 1) << 5)); }
__host__ __device__ __forceinline__ void stage_rc(int b, int& R, int& C) { const int st = b / 1024, sb = b % 1024, swz = sb ^ (((sb >> 9) & 1) << 5); R = (st >> 1) * 16 + swz / 64; C = (st & 1) * 32 + (swz % 64) / 2; }
__host__ __device__ __forceinline__ int perm32(int rho) { const int n = rho >> 4, i = rho & 15; return 8 * (i >> 2) + 4 * n + (i & 3); }

struct Unit { int pm, pn; };
struct Gemm { const bf16_t* A; const bf16_t* Bt; int M, N, K, ld; };

struct StaticOrder {
    int nM, nN, nwg, G, c;
    __host__ __device__ void init(int M, int N, int G_, int c_) { nM = M / BM; nN = N / BM; nwg = nM * nN; G = G_; c = c_; }
    __host__ __device__ bool next(int i, Unit& u) const {
        const long L = (long)i * G + c; if (L >= nwg) return false;
        int wgid = (int)L; { const int q = nwg / NXCD, r = nwg % NXCD, xcd = wgid % NXCD, off = wgid / NXCD; wgid = (xcd < r ? xcd * (q + 1) : r * (q + 1) + (xcd - r) * q) + off; }
        const int nig = WGM * nN, gid = wgid / nig, fm = gid * WGM, gsz = (nM - fm) < WGM ? (nM - fm) : WGM;
        u.pm = fm + ((wgid % nig) % gsz); u.pn = (wgid % nig) / gsz; return true;
    }
    __device__ __forceinline__ void a_ready(const Unit&) const {}
    __device__ __forceinline__ void done(const Unit&) const {}
};
__device__ __forceinline__ unsigned cvt_pk_bf16(float lo, float hi) { unsigned r; asm volatile("v_cvt_pk_bf16_f32 %0, %1, %2" : "=v"(r) : "v"(lo), "v"(hi)); return r; }
typedef float f32x2 __attribute__((ext_vector_type(2)));
typedef unsigned u32x2 __attribute__((ext_vector_type(2)));
struct EpiInProj0 {
    static constexpr bool PERM = false, AFTER_DRAIN = false;
    bf16_t* O; float* newk; float* newv;
    __device__ __forceinline__ void operator()(const f32x4 (&acc)[2][2][4][2], const Unit& u, int wr, int wc, int fr, int fq) const {
        const int t = u.pn >> 1;
        bf16_t* base = O + (size_t)t * ((size_t)MT * 512);
        const int colt = (u.pn & 1) * 256 + wc * 32 + 4 * fq;
        const bool rope = (t <= 1) && (u.pm >= MP / 256);
        float* f32o = (u.pm < MP / 256) ? (t == 1 ? newk : (t == 2 ? newv : nullptr)) : nullptr;
        float inv[4];
#pragma unroll
        for (int e = 0; e < 4; ++e) inv[e] = __builtin_amdgcn_exp2f(-(float)(4 * fq + e) * (13.287712379549449f / 16.0f));
#pragma unroll
        for (int ai = 0; ai < 2; ++ai)
#pragma unroll
            for (int m = 0; m < 4; ++m) {
                const int row = u.pm * BM + ai * HALF + wr * 64 + m * 16 + fr;
                f32x4 v[2][2];
#pragma unroll
                for (int bj = 0; bj < 2; ++bj) { v[bj][0] = acc[ai][bj][m][0]; v[bj][1] = acc[ai][bj][m][1]; }
                if (rope) {
                    const int tok = (row - MP) & 4095; const float pos = (float)((wc & 1) ? (tok & 63) : (tok >> 6));
                    f32x4 cs, sn;
#pragma unroll
                    for (int e = 0; e < 4; ++e) { const float a = pos * inv[e]; cs[e] = __cosf(a); sn[e] = __sinf(a); }
#pragma unroll
                    for (int bj = 0; bj < 2; ++bj) { const f32x4 x1 = v[bj][0], x2 = v[bj][1]; v[bj][0] = x1 * cs - x2 * sn; v[bj][1] = x1 * sn + x2 * cs; }
                }
                bf16_t* rowp = base + (size_t)row * 512 + colt;
#pragma unroll
                for (int bj = 0; bj < 2; ++bj)
#pragma unroll
                    for (int n = 0; n < 2; ++n) { u32x2 w; w.x = cvt_pk_bf16(v[bj][n][0], v[bj][n][1]); w.y = cvt_pk_bf16(v[bj][n][2], v[bj][n][3]); *(u32x2*)(rowp + bj * HALF + n * 16) = w; }
                if (f32o) { float* fp = f32o + (size_t)row * 512 + colt;
#pragma unroll
                    for (int bj = 0; bj < 2; ++bj)
#pragma unroll
                        for (int n = 0; n < 2; ++n) *(f32x4*)(fp + bj * HALF + n * 16) = v[bj][n]; }
            }
    }
};
struct EpiResid {
    static constexpr bool PERM = true, AFTER_DRAIN = false;
    const float* xp; const float* xs; const bf16_t* xb; bf16_t* yout; const float* gate; int pm_off; bf16_t* P; int helper;
    __device__ __forceinline__ void operator()(const f32x4 (&acc)[2][2][4][2], const Unit& u, int wr, int wc, int fr, int fq) const {
        const int pm = u.pm + pm_off; const int cond = pm < MP / 256 ? 0 : 1 + ((pm - MP / 256) >> 4);
        const int col0 = u.pn * BM + wc * 32 + 8 * fq; const float* g = gate + (size_t)cond * MODW + col0;
        f32x4 gv[2][2];
#pragma unroll
        for (int bj = 0; bj < 2; ++bj)
#pragma unroll
            for (int n = 0; n < 2; ++n) gv[bj][n] = *(const f32x4*)(g + bj * HALF + n * 4);
#pragma unroll
        for (int ai = 0; ai < 2; ++ai)
#pragma unroll
            for (int m = 0; m < 4; ++m) {
                const int row = pm * BM + ai * HALF + wr * 64 + m * 16 + fr;
                if (helper) { bf16_t* pp = P + (size_t)(row - pm_off * BM) * DM + col0;
#pragma unroll
                    for (int bj = 0; bj < 2; ++bj) { const f32x4 p0 = gv[bj][0] * acc[ai][bj][m][0], p1 = gv[bj][1] * acc[ai][bj][m][1];
                        u32x4 o; o.x = cvt_pk_bf16(p0[0], p0[1]); o.y = cvt_pk_bf16(p0[2], p0[3]); o.z = cvt_pk_bf16(p1[0], p1[1]); o.w = cvt_pk_bf16(p1[2], p1[3]);
                        *(u32x4*)(pp + bj * HALF) = o; }
                } else {
                    bf16_t* op = yout + (size_t)row * DM + col0;
#pragma unroll
                    for (int bj = 0; bj < 2; ++bj) { f32x4 x0, x1;
                        if (xb) { const u32x4 w = *(const u32x4*)(xb + (size_t)row * DM + col0 + bj * HALF);
                            x0 = (f32x4){__uint_as_float(w.x << 16), __uint_as_float(w.x & 0xffff0000u), __uint_as_float(w.y << 16), __uint_as_float(w.y & 0xffff0000u)};
                            x1 = (f32x4){__uint_as_float(w.z << 16), __uint_as_float(w.z & 0xffff0000u), __uint_as_float(w.w << 16), __uint_as_float(w.w & 0xffff0000u)};
                        } else { const float* xin = (row < MP ? xp + (size_t)row * DM : xs + (size_t)(row - MP) * DM) + col0 + bj * HALF; x0 = *(const f32x4*)xin; x1 = *(const f32x4*)(xin + 4); }
                        const f32x4 y0 = x0 * ALPHA_F + gv[bj][0] * acc[ai][bj][m][0], y1 = x1 * ALPHA_F + gv[bj][1] * acc[ai][bj][m][1];
                        u32x4 o; o.x = cvt_pk_bf16(y0[0], y0[1]); o.y = cvt_pk_bf16(y0[2], y0[3]); o.z = cvt_pk_bf16(y1[0], y1[1]); o.w = cvt_pk_bf16(y1[2], y1[3]);
                        *(u32x4*)(op + bj * HALF) = o; }
                }
            }
    }
};
template <int ACT> struct EpiAct {
    static constexpr bool PERM = true, AFTER_DRAIN = false;
    bf16_t* O; int ldc;
    __device__ __forceinline__ void operator()(const f32x4 (&acc)[2][2][4][2], const Unit& u, int wr, int wc, int fr, int fq) const {
        const int row0 = u.pm * BM + wr * 64 + fr; const int col0 = u.pn * BM + wc * 32 + 8 * fq;
#pragma unroll
        for (int ai = 0; ai < 2; ++ai)
#pragma unroll
            for (int m = 0; m < 4; ++m) { bf16_t* rowp = O + (size_t)(row0 + ai * HALF + m * 16) * ldc + col0;
#pragma unroll
                for (int bj = 0; bj < 2; ++bj) { f32x4 v0 = acc[ai][bj][m][0], v1 = acc[ai][bj][m][1];
                    if (ACT == 1) { v0 = __builtin_elementwise_max(v0, (f32x4){0.f, 0.f, 0.f, 0.f}); v1 = __builtin_elementwise_max(v1, (f32x4){0.f, 0.f, 0.f, 0.f}); v0 = v0 * v0; v1 = v1 * v1; }
                    u32x4 w; w.x = cvt_pk_bf16(v0[0], v0[1]); w.y = cvt_pk_bf16(v0[2], v0[3]); w.z = cvt_pk_bf16(v1[0], v1[1]); w.w = cvt_pk_bf16(v1[2], v1[3]);
                    *(u32x4*)(rowp + bj * HALF) = w; } }
    }
};

struct SplitOrder {
    int c;
    __device__ __forceinline__ bool next(int i, Unit& u) const {
        if (c < 192) { if (i > 0) return false; StaticOrder s; s.init(MHALF, DM, 192, c); return s.next(0, u); }
        if (i >= 3) return false; const int t = 3 * (c - 192) + i; u.pm = t >> 2; u.pn = t & 3; return true;
    }
    __device__ __forceinline__ void a_ready(const Unit&) const {}
    __device__ __forceinline__ void done(const Unit&) const {}
};

struct EpiInProj1 {
    static constexpr bool PERM = true, AFTER_DRAIN = false;
    bf16_t* BG; bf16_t* Z;
    __device__ __forceinline__ void operator()(const f32x4 (&acc)[2][2][4][2], const Unit& u, int wr, int wc, int fr, int fq) const {
        const int row0 = u.pm * BM + wr * 64 + fr;
        if (u.pn < 4) { const int col0 = u.pn * BM + wc * 32 + 8 * fq;
#pragma unroll
            for (int ai = 0; ai < 2; ++ai)
#pragma unroll
                for (int m = 0; m < 4; ++m) { bf16_t* rowp = BG + (size_t)(row0 + ai * HALF + m * 16) * DM + col0;
#pragma unroll
                    for (int bj = 0; bj < 2; ++bj) { const f32x4 v0 = acc[ai][bj][m][0], v1 = acc[ai][bj][m][1];
                        u32x4 w; w.x = cvt_pk_bf16(v0[0], v0[1]); w.y = cvt_pk_bf16(v0[2], v0[3]); w.z = cvt_pk_bf16(v1[0], v1[1]); w.w = cvt_pk_bf16(v1[2], v1[3]);
                        *(u32x4*)(rowp + bj * HALF) = w; } }
        } else { const int col0 = (u.pn - 4) * HALF + wc * 32 + 8 * fq;
#pragma unroll
            for (int ai = 0; ai < 2; ++ai)
#pragma unroll
                for (int m = 0; m < 4; ++m) { const f32x4 v0 = acc[ai][0][m][0] * acc[ai][1][m][0], v1 = acc[ai][0][m][1] * acc[ai][1][m][1];
                    u32x4 w; w.x = cvt_pk_bf16(v0[0], v0[1]); w.y = cvt_pk_bf16(v0[2], v0[3]); w.z = cvt_pk_bf16(v1[0], v1[1]); w.w = cvt_pk_bf16(v1[2], v1[3]);
                    *(u32x4*)(Z + (size_t)(row0 + ai * HALF + m * 16) * DM + col0) = w; }
        }
    }
};
template <class Epi, class Sched, bool ALIGN_EPI = false, bool SP2 = false>
__device__ __forceinline__ void gemm_phase(PG8_LAS unsigned char* lds, const Gemm g, const Sched& S, const Epi& E) {
    const int tid = opaque_tid(), wid = __builtin_amdgcn_readfirstlane(tid >> 6), lane = tid & 63, wr = wid >> 2, wc = wid & 3, fr = lane & 15, fq = lane >> 4;
    const int K = g.ld, nt = g.K / BK;
    unsigned voffA[2], voffB[2];
#pragma unroll
    for (int i = 0; i < 2; ++i) { int R, C; stage_rc(tid * 16 + i * 8192, R, C); const int Rb = Epi::PERM ? ((R & ~31) + perm32(R & 31)) : R;
        voffA[i] = (unsigned)(R * K + C) * 2u; voffB[i] = (unsigned)(Rb * K + C) * 2u; }
    const size_t kstep = (size_t)(BK * 2);
    const size_t hstep = (size_t)HALF * K * 2;
    const size_t tstep = 2 * hstep;
    const unsigned ldsw = (unsigned)wid * 1024u;
    const int aoff = lds_byte(wr * 64 + fr, fq * 8), boff = lds_byte(wc * 32 + fr, fq * 8);
#define PG8_SA(b, h) (((b) * 2 + (h)) * HTB)
#define PG8_SB(b, h) ((4 + (b) * 2 + (h)) * HTB)
#define PG8_STAGE(bufoff, gbase, voff) do { _Pragma("unroll") for (int _i = 0; _i < 2; ++_i) \
        __builtin_amdgcn_global_load_lds((const unsigned*)((const char*)(gbase) + (voff)[_i]), (PG8_LAS unsigned*)(lds + (bufoff) + ldsw + _i * 8192), 16, 0, 0); } while (0)
#define PG8_LDA(dst, b, h) do { _Pragma("unroll") for (int m = 0; m < 4; ++m) _Pragma("unroll") for (int k = 0; k < 2; ++k) dst[m][k] = *(const PG8_LAS bf16x8*)(lds + PG8_SA(b, h) + aoff + m * 2048 + k * 1024); } while (0)
#define PG8_LDB(dst, b, h) do { _Pragma("unroll") for (int n = 0; n < 2; ++n) _Pragma("unroll") for (int k = 0; k < 2; ++k) dst[n][k] = *(const PG8_LAS bf16x8*)(lds + PG8_SB(b, h) + boff + n * 2048 + k * 1024); } while (0)
#define PG8_MMA(ai, bj, At, Bt) do { __builtin_amdgcn_s_setprio(1); _Pragma("unroll") for (int m = 0; m < 4; ++m) _Pragma("unroll") for (int n = 0; n < 2; ++n) _Pragma("unroll") for (int k = 0; k < 2; ++k) \
        acc[ai][bj][m][n] = __builtin_amdgcn_mfma_f32_16x16x32_bf16(Bt[n][k], At[m][k], acc[ai][bj][m][n], 0, 0, 0); __builtin_amdgcn_s_setprio(0); } while (0)
#define PG8_WAIT_V(n) asm volatile("s_waitcnt vmcnt(" #n ")" ::: "memory")
#define PG8_WAIT_L(n) asm volatile("s_waitcnt lgkmcnt(" #n ")" ::: "memory")
#define PG8_BAR __builtin_amdgcn_s_barrier()
#define PG8_SCHED __builtin_amdgcn_sched_barrier(0)
    Unit cur, nxt; int ui = 0;
    if (!S.next(0, cur)) return;
    f32x4 acc[2][2][4][2];
#pragma unroll
    for (int a = 0; a < 2; ++a)
#pragma unroll
        for (int b = 0; b < 2; ++b)
#pragma unroll
            for (int m = 0; m < 4; ++m)
#pragma unroll
                for (int n = 0; n < 2; ++n) acc[a][b][m][n] = (f32x4){0.f, 0.f, 0.f, 0.f};
    bf16x8 At[4][2], B0[2][2], B1[2][2];
    const char* cA = (const char*)g.A + (size_t)cur.pm * tstep; const char* cB = (const char*)g.Bt + (size_t)cur.pn * tstep;
    S.a_ready(cur);
    if constexpr (SP2) {
        PG8_STAGE(PG8_SB(0, 0), cB, voffB); PG8_STAGE(PG8_SB(0, 1), cB + hstep, voffB); PG8_STAGE(PG8_SA(0, 0), cA, voffA); PG8_STAGE(PG8_SA(0, 1), cA + hstep, voffA);
        if (wr == 1) PG8_BAR;
        PG8_WAIT_V(2); PG8_BAR;
        PG8_STAGE(PG8_SB(1, 0), cB + kstep, voffB); PG8_STAGE(PG8_SA(1, 0), cA + kstep, voffA); PG8_STAGE(PG8_SB(1, 1), cB + hstep + kstep, voffB);
        PG8_WAIT_V(6); PG8_BAR;
    } else {
        PG8_STAGE(PG8_SB(0, 0), cB, voffB); PG8_STAGE(PG8_SA(0, 0), cA, voffA); PG8_STAGE(PG8_SB(0, 1), cB + hstep, voffB); PG8_STAGE(PG8_SA(0, 1), cA + hstep, voffA);
        if (wr == 1) PG8_BAR;
        PG8_WAIT_V(4); PG8_BAR;
        PG8_STAGE(PG8_SB(1, 0), cB + kstep, voffB); PG8_STAGE(PG8_SA(1, 0), cA + kstep, voffA); PG8_STAGE(PG8_SB(1, 1), cB + hstep + kstep, voffB);
        PG8_WAIT_V(6); PG8_BAR;
    }
    for (;;) {
        const bool has_next = S.next(ui + 1, nxt);
        const char* nA = has_next ? (const char*)g.A + (size_t)nxt.pm * tstep : cA; const char* nB = has_next ? (const char*)g.Bt + (size_t)nxt.pn * tstep : cB;
        for (int t = 0; t < nt; t += 2) {
            const bool last = (t == nt - 2);
            const char* a1 = cA + (size_t)(t + 1) * kstep;
            const char* a2 = last ? nA : cA + (size_t)(t + 2) * kstep; const char* b2 = last ? nB : cB + (size_t)(t + 2) * kstep;
            const char* a3 = a2 + kstep; const char* b3 = b2 + kstep;
            if (last && has_next) S.a_ready(nxt);
            if constexpr (SP2) {
            PG8_LDB(B0, 0, 0); PG8_LDB(B1, 0, 1); PG8_SCHED; PG8_LDA(At, 0, 0); PG8_STAGE(PG8_SA(1, 1), a1 + hstep, voffA);
            PG8_WAIT_V(8); PG8_WAIT_L(0); PG8_BAR; PG8_MMA(0, 0, At, B0); PG8_MMA(0, 1, At, B1); PG8_BAR; PG8_SCHED;
            PG8_LDA(At, 0, 1); PG8_STAGE(PG8_SB(0, 0), b2, voffB); PG8_STAGE(PG8_SB(0, 1), b2 + hstep, voffB); PG8_STAGE(PG8_SA(0, 0), a2, voffA);
            PG8_WAIT_V(8); PG8_WAIT_L(0); PG8_BAR; PG8_MMA(1, 0, At, B0); PG8_MMA(1, 1, At, B1); PG8_BAR; PG8_SCHED;
            PG8_LDB(B0, 1, 0); PG8_LDB(B1, 1, 1); PG8_SCHED; PG8_LDA(At, 1, 0); PG8_STAGE(PG8_SA(0, 1), a2 + hstep, voffA);
            PG8_WAIT_V(8); PG8_WAIT_L(0); PG8_BAR; PG8_MMA(0, 0, At, B0); PG8_MMA(0, 1, At, B1); PG8_BAR; PG8_SCHED;
            PG8_LDA(At, 1, 1); PG8_STAGE(PG8_SB(1, 0), b3, voffB); PG8_STAGE(PG8_SB(1, 1), b3 + hstep, voffB); PG8_STAGE(PG8_SA(1, 0), a3, voffA);
            PG8_WAIT_V(8); PG8_WAIT_L(0); PG8_BAR; PG8_MMA(1, 0, At, B0); PG8_MMA(1, 1, At, B1); PG8_BAR; PG8_SCHED;
            } else {
            PG8_LDB(B0, 0, 0); PG8_SCHED; PG8_LDA(At, 0, 0); PG8_STAGE(PG8_SA(1, 1), a1 + hstep, voffA);
            PG8_WAIT_L(8); PG8_BAR; PG8_WAIT_L(0); PG8_MMA(0, 0, At, B0); PG8_BAR; PG8_SCHED;
            PG8_LDB(B1, 0, 1); PG8_STAGE(PG8_SB(0, 0), b2, voffB);
            PG8_BAR; PG8_WAIT_L(0); PG8_MMA(0, 1, At, B1); PG8_BAR;
            PG8_LDA(At, 0, 1); PG8_STAGE(PG8_SA(0, 0), a2, voffA);
            PG8_BAR; PG8_WAIT_L(0); PG8_MMA(1, 0, At, B0); PG8_BAR; PG8_SCHED;
            PG8_STAGE(PG8_SB(0, 1), b2 + hstep, voffB);
            PG8_WAIT_V(6); PG8_BAR; PG8_MMA(1, 1, At, B1); PG8_BAR;
            PG8_LDB(B0, 1, 0); PG8_SCHED; PG8_LDA(At, 1, 0); PG8_STAGE(PG8_SA(0, 1), a2 + hstep, voffA);
            PG8_WAIT_L(8); PG8_BAR; PG8_WAIT_L(0); PG8_MMA(0, 0, At, B0); PG8_BAR; PG8_SCHED;
            PG8_LDB(B1, 1, 1); PG8_STAGE(PG8_SB(1, 0), b3, voffB);
            PG8_BAR; PG8_WAIT_L(0); PG8_MMA(0, 1, At, B1); PG8_BAR;
            PG8_LDA(At, 1, 1); PG8_STAGE(PG8_SA(1, 0), a3, voffA);
            PG8_BAR; PG8_WAIT_L(0); PG8_MMA(1, 0, At, B0); PG8_BAR; PG8_SCHED;
            PG8_STAGE(PG8_SB(1, 1), b3 + hstep, voffB);
            PG8_WAIT_V(6); PG8_BAR; PG8_MMA(1, 1, At, B1); PG8_BAR;
            }
        }
        if constexpr (ALIGN_EPI) { if (wr == 0) PG8_BAR; }
        if constexpr (!Epi::AFTER_DRAIN) { E(acc, cur, wr, wc, fr, fq); S.done(cur); }
        if (!has_next) break;
#pragma unroll
        for (int a = 0; a < 2; ++a)
#pragma unroll
            for (int b = 0; b < 2; ++b)
#pragma unroll
                for (int m = 0; m < 4; ++m)
#pragma unroll
                    for (int n = 0; n < 2; ++n) acc[a][b][m][n] = (f32x4){0.f, 0.f, 0.f, 0.f};
        cur = nxt; cA = nA; cB = nB; ++ui;
        if constexpr (ALIGN_EPI) { if (wr == 1) PG8_BAR; }
    }
    PG8_WAIT_V(0);
    if constexpr (!ALIGN_EPI) { if (wr == 0) PG8_BAR; }
    PG8_BAR;
    if constexpr (Epi::AFTER_DRAIN) { E.fused(acc, cur, wr, wc, fr, fq, lds, wid, lane); S.done(cur); }
#undef PG8_SA
#undef PG8_SB
#undef PG8_STAGE
#undef PG8_LDA
#undef PG8_LDB
#undef PG8_MMA
#undef PG8_WAIT_V
#undef PG8_WAIT_L
#undef PG8_BAR
#undef PG8_SCHED
}
}
namespace att {
using bf16x8 = __attribute__((ext_vector_type(8))) short;
using s16x4  = __attribute__((ext_vector_type(4))) short;
using f32x16 = __attribute__((ext_vector_type(16))) float;
using u32x4  = __attribute__((ext_vector_type(4))) unsigned;
typedef unsigned short bf16_t;
constexpr float SCALE = 0.125f;
constexpr float THR = 8.f;
constexpr int SHM_V = 64 * 128 * 2, SHM_K = 64 * 64 * 2;
constexpr int LDS_ATT = 2 * SHM_V + 2 * SHM_K + 8 * 64 * 4;
#define KSWZ(row, colB) ((row) * 128 + ((colB) ^ ((((row) >> 1) & 7) << 4)))
#define SBAR() __builtin_amdgcn_sched_barrier(0)
__device__ __forceinline__ int crow(int r, int hi) { return (r & 3) + 8 * (r >> 2) + 4 * hi; }
__device__ __forceinline__ unsigned cvtpk(float lo, float hi) { unsigned r; asm volatile("v_cvt_pk_bf16_f32 %0, %1, %2" : "=v"(r) : "v"(lo), "v"(hi)); return r; }

__device__ __forceinline__ void partialSM(f32x16& p0, f32x16& p1, float& m_reg, float& mn, float& alpha) {
  constexpr float C = SCALE * 1.4426950408889634f;
  float pmax = p0[0];
#pragma unroll
  for (int r = 1; r < 16; ++r) pmax = fmaxf(pmax, p0[r]);
#pragma unroll
  for (int r = 0; r < 16; ++r) pmax = fmaxf(pmax, p1[r]);
  { auto rr = __builtin_amdgcn_permlane32_swap(__float_as_uint(pmax), __float_as_uint(pmax), false, false);
    pmax = fmaxf(__uint_as_float(rr[0]), __uint_as_float(rr[1])); }
  if (__builtin_expect(__all(pmax - m_reg <= THR / SCALE), 1)) { mn = m_reg; alpha = 1.f; }
  else { mn = fmaxf(m_reg, pmax); alpha = __builtin_amdgcn_exp2f((m_reg - mn) * C); m_reg = mn; }
  float mnC = -mn * C;
#pragma unroll
  for (int r = 0; r < 16; ++r) p0[r] = fmaf(p0[r], C, mnC);
#pragma unroll
  for (int r = 0; r < 16; ++r) p1[r] = fmaf(p1[r], C, mnC);
#pragma unroll
  for (int r = 0; r < 16; ++r) p0[r] = __builtin_amdgcn_exp2f(p0[r]);
}
__device__ __forceinline__ void finishSM(f32x16& p0, f32x16& p1, float alpha, float& l_reg, bf16x8& pa0, bf16x8& pa1, bf16x8& pa2, bf16x8& pa3) {
#pragma unroll
  for (int r = 0; r < 16; ++r) p1[r] = __builtin_amdgcn_exp2f(p1[r]);
  float ps = 0;
#pragma unroll
  for (int r = 0; r < 16; ++r) ps += p0[r];
#pragma unroll
  for (int r = 0; r < 16; ++r) ps += p1[r];
  { auto rr = __builtin_amdgcn_permlane32_swap(__float_as_uint(ps), __float_as_uint(ps), false, false);
    ps = __uint_as_float(rr[0]) + __uint_as_float(rr[1]); }
  l_reg = l_reg * alpha + ps;
#define PK4(P, BASE, OUT) do { unsigned a0 = cvtpk(P[BASE + 0], P[BASE + 1]), a1 = cvtpk(P[BASE + 2], P[BASE + 3]);   \
    unsigned b0 = cvtpk(P[BASE + 4], P[BASE + 5]), b1 = cvtpk(P[BASE + 6], P[BASE + 7]);                              \
    auto r0 = __builtin_amdgcn_permlane32_swap(a0, b0, false, false); auto r1 = __builtin_amdgcn_permlane32_swap(a1, b1, false, false); \
    u32x4 w = {r0[0], r1[0], r0[1], r1[1]}; OUT = *reinterpret_cast<bf16x8*>(&w); } while (0)
  PK4(p0, 0, pa0); PK4(p0, 8, pa1); PK4(p1, 0, pa2); PK4(p1, 8, pa3);
#undef PK4
}
__device__ __forceinline__ void qkt(f32x16& p0, f32x16& p1, const char* Ks, const bf16x8* qr, int r32, int hi) {
  p0 = f32x16{}; p1 = f32x16{};
#pragma unroll
  for (int d0 = 0; d0 < 4; ++d0) { int cb = (d0 * 16 + hi * 8) * 2;
    bf16x8 b0 = *reinterpret_cast<const bf16x8*>(Ks + KSWZ(r32, cb));
    bf16x8 b1 = *reinterpret_cast<const bf16x8*>(Ks + KSWZ(32 + r32, cb));
    p0 = __builtin_amdgcn_mfma_f32_32x32x16_bf16(b0, qr[d0], p0, 0, 0, 0);
    p1 = __builtin_amdgcn_mfma_f32_32x32x16_bf16(b1, qr[d0], p1, 0, 0, 0); }
}
__device__ __forceinline__ int v_st(int k, int c) { const int kk = (k & ~0xC) | ((k & 4) << 1) | ((k & 8) >> 1); return ((kk >> 3) * 4 + (c >> 5)) * 512 + ((kk & 7) * 32 + (c & 31)) * 2; }
__device__ __forceinline__ int v_rd_base(int lane) { return ((lane & 3) << 3) | (((lane >> 2) & 3) << 6) | (((lane >> 4) & 1) << 5) | (((lane >> 5) & 1) << 8); }
constexpr int v_rd_off(int d0, int ks, int half) { return d0 * 512 + ks * 4096 + half * 2048; }
template <int OFF> __device__ __forceinline__ s16x4 tr_read(int vb) {
  s16x4 r; asm volatile("ds_read_b64_tr_b16 %0, %1 offset:%2" : "=&v"(r) : "v"(vb), "i"(OFF) : "memory"); return r;
}
template <int D0> __device__ __forceinline__ void pv_one(f32x16& od, int vb, bf16x8 pa0, bf16x8 pa1, bf16x8 pa2, bf16x8 pa3) {
  const s16x4 l0 = tr_read<v_rd_off(D0, 0, 0)>(vb), h0 = tr_read<v_rd_off(D0, 0, 1)>(vb), l1 = tr_read<v_rd_off(D0, 1, 0)>(vb), h1 = tr_read<v_rd_off(D0, 1, 1)>(vb);
  const s16x4 l2 = tr_read<v_rd_off(D0, 2, 0)>(vb), h2 = tr_read<v_rd_off(D0, 2, 1)>(vb), l3 = tr_read<v_rd_off(D0, 3, 0)>(vb), h3 = tr_read<v_rd_off(D0, 3, 1)>(vb);
  asm volatile("s_waitcnt lgkmcnt(0)" ::: "memory"); SBAR();
#define PK(L, H) (bf16x8){L[0], L[1], L[2], L[3], H[0], H[1], H[2], H[3]}
  od = __builtin_amdgcn_mfma_f32_32x32x16_bf16(pa0, PK(l0, h0), od, 0, 0, 0);
  od = __builtin_amdgcn_mfma_f32_32x32x16_bf16(pa1, PK(l1, h1), od, 0, 0, 0);
  od = __builtin_amdgcn_mfma_f32_32x32x16_bf16(pa2, PK(l2, h2), od, 0, 0, 0);
  od = __builtin_amdgcn_mfma_f32_32x32x16_bf16(pa3, PK(l3, h3), od, 0, 0, 0);
#undef PK
}
__device__ __forceinline__ void pv_d0(f32x16* o, int vb, bf16x8 pa0, bf16x8 pa1, bf16x8 pa2, bf16x8 pa3) {
  pv_one<0>(o[0], vb, pa0, pa1, pa2, pa3); pv_one<1>(o[1], vb, pa0, pa1, pa2, pa3); pv_one<2>(o[2], vb, pa0, pa1, pa2, pa3); pv_one<3>(o[3], vb, pa0, pa1, pa2, pa3);
}

__device__ __forceinline__ void attn_half(f32x16 (&o)[4], const bf16_t* __restrict__ Qw, const bf16_t* __restrict__ Kc, const bf16_t* __restrict__ Vc,
                                          const bf16_t* __restrict__ Kn, const bf16_t* __restrict__ Vn, int ncache, int NT, char* lds) {
  const int tid = opaque_tid(), wid = tid >> 6, lane = tid & 63, r32 = lane & 31, hi = lane >> 5;
  char* V_lds = lds; char* K_lds = lds + 2 * SHM_V;
  float* wsf = (float*)(lds + 2 * SHM_V + 2 * SHM_K) + wid * 64; float* li_l = wsf; float* al_l = wsf + 32;
  float m_reg = -1e30f, l_reg = 0; bf16x8 qr[4];
#pragma unroll
  for (int d = 0; d < 4; ++d) o[d] = f32x16{};
#pragma unroll
  for (int d0 = 0; d0 < 4; ++d0) qr[d0] = *reinterpret_cast<const bf16x8*>(Qw + d0 * 16);
  const int sr = tid >> 4, sc = (tid & 15) * 8, vst0 = v_st(sr, sc), vst1 = v_st(32 + sr, sc);
  const int kr = tid >> 3, kc = (tid & 7) * 8, kst = KSWZ(kr, kc * 2);
  const int vb0 = (int)(uintptr_t)V_lds + v_rd_base(lane);
  struct { bf16x8 vs0, vs1, ks0; } sr_[2];
#define TPTR(jt, PC, PN) ((jt) < ncache ? (PC) + (size_t)(jt) * (64 * 512) : (PN) + (size_t)((jt) - ncache) * (64 * 512))
#define SLOAD(i, jt) do { const bf16_t* vt_ = TPTR(jt, Vc, Vn); const bf16_t* kt_ = TPTR(jt, Kc, Kn); \
    sr_[i].vs0 = *reinterpret_cast<const bf16x8*>(vt_ + (size_t)sr * 512 + sc); sr_[i].vs1 = *reinterpret_cast<const bf16x8*>(vt_ + (size_t)(32 + sr) * 512 + sc); \
    sr_[i].ks0 = *reinterpret_cast<const bf16x8*>(kt_ + (size_t)kr * 512 + kc); } while (0)
#define SWRITE(b, i) do { *(bf16x8*)(V_lds + (b) * SHM_V + vst0) = sr_[i].vs0; *(bf16x8*)(V_lds + (b) * SHM_V + vst1) = sr_[i].vs1; \
    *(bf16x8*)(K_lds + (b) * SHM_K + kst) = sr_[i].ks0; } while (0)
#define SWAIT() asm volatile("s_waitcnt vmcnt(3)" ::: "memory")
#define RESC(a) do { if (__any((a) < 1.f)) { if (hi == 0) al_l[r32] = (a); asm volatile("s_waitcnt lgkmcnt(0)" ::: "memory"); \
    _Pragma("unroll") for (int d = 0; d < 4; ++d) _Pragma("unroll") for (int r = 0; r < 16; ++r) o[d][r] *= al_l[crow(r, hi)]; } } while (0)
  f32x16 pA0, pA1, pB0, pB1; float mnA, mnB, alA, alB; bf16x8 pa0, pa1, pa2, pa3;
  constexpr int SE = 0, SO = 1;
  __syncthreads();
  SLOAD(SE, 0); asm volatile("s_waitcnt vmcnt(0)" ::: "memory"); SWRITE(0, SE); __syncthreads();
  qkt(pA0, pA1, K_lds, qr, r32, hi); partialSM(pA0, pA1, m_reg, mnA, alA);
  SLOAD(SO, 1); if (2 < NT) SLOAD(SE, 2);
  SWAIT(); SWRITE(1, SO); __syncthreads();
  for (int j = 1; j + 1 < NT; j += 2) {
    SBAR(); qkt(pB0, pB1, K_lds + SHM_K, qr, r32, hi);
    finishSM(pA0, pA1, alA, l_reg, pa0, pa1, pa2, pa3); SBAR();
    SLOAD(SO, j + 2); SBAR();
    pv_d0(o, vb0, pa0, pa1, pa2, pa3); partialSM(pB0, pB1, m_reg, mnB, alB);
    __syncthreads(); SWAIT(); SWRITE(0, SE);
    RESC(alB); __syncthreads();
    SBAR(); qkt(pA0, pA1, K_lds, qr, r32, hi);
    finishSM(pB0, pB1, alB, l_reg, pa0, pa1, pa2, pa3); SBAR();
    if (j + 3 < NT) SLOAD(SE, j + 3); SBAR();
    pv_d0(o, vb0 + SHM_V, pa0, pa1, pa2, pa3); partialSM(pA0, pA1, m_reg, mnA, alA);
    __syncthreads(); SWAIT(); SWRITE(1, SO);
    RESC(alA); __syncthreads();
  }
  SBAR(); qkt(pB0, pB1, K_lds + SHM_K, qr, r32, hi);
  finishSM(pA0, pA1, alA, l_reg, pa0, pa1, pa2, pa3); SBAR();
  pv_d0(o, vb0, pa0, pa1, pa2, pa3); partialSM(pB0, pB1, m_reg, mnB, alB);
  __syncthreads(); RESC(alB);
  finishSM(pB0, pB1, alB, l_reg, pa0, pa1, pa2, pa3); SBAR();
  pv_d0(o, vb0 + SHM_V, pa0, pa1, pa2, pa3);
  if (hi == 0) li_l[r32] = l_reg; asm volatile("s_waitcnt lgkmcnt(0)" ::: "memory");
#pragma unroll
  for (int r = 0; r < 16; ++r) { const float rl = __builtin_amdgcn_rcpf(li_l[crow(r, hi)]);
#pragma unroll
    for (int d = 0; d < 4; ++d) o[d][r] *= rl; }
#undef TPTR
#undef SLOAD
#undef SWRITE
#undef SWAIT
#undef RESC
}
}
typedef unsigned short bf16_t;
typedef float f32x4v __attribute__((ext_vector_type(4)));
typedef float f32x2v __attribute__((ext_vector_type(2)));
typedef unsigned u32x4v __attribute__((ext_vector_type(4)));
typedef unsigned u32x2v __attribute__((ext_vector_type(2)));
typedef short bf16x8v __attribute__((ext_vector_type(8)));
using att::f32x16;
#define LDS_WAIT() asm volatile("s_waitcnt lgkmcnt(0)" ::: "memory")
__device__ __forceinline__ unsigned pk2(float lo, float hi) { return pg8::cvt_pk_bf16(lo, hi); }
__device__ __forceinline__ float bf_lo(unsigned w) { return __uint_as_float(w << 16); }
__device__ __forceinline__ float bf_hi(unsigned w) { return __uint_as_float(w & 0xffff0000u); }
__device__ __forceinline__ float wave_sum(float v) {
#pragma unroll
    for (int o = 1; o < 64; o <<= 1) v += __shfl_xor(v, o);
    return v;
}
#define LAS __attribute__((address_space(3)))
#define XB_TMO      128
#define XB_XCNT(j)  (256  + 64 * (j))
#define XB_XSUB(j)  (1280 + 64 * (j))
#define XB_XGEN(j)  (2304 + 64 * (j))
#define XB_TOP      3328
#define XB_TOPGEN   3392
#define XCD_BAR_WORDS 3456
#define XB_SPIN_CAP (1u << 18)

__device__ __forceinline__ unsigned xb_ld(unsigned* p)              { return __hip_atomic_load(p, __ATOMIC_RELAXED, __HIP_MEMORY_SCOPE_AGENT); }
__device__ __forceinline__ unsigned xb_add(unsigned* p, unsigned v) { return __hip_atomic_fetch_add(p, v, __ATOMIC_RELAXED, __HIP_MEMORY_SCOPE_AGENT); }
__device__ __forceinline__ unsigned xb_xcc_id() { return (unsigned)__builtin_amdgcn_s_getreg((3 << 11) | 20) & 0xFu; }
#define XB_SPIN(cond, bar) do { unsigned _sp = 0; while (cond) { __builtin_amdgcn_s_sleep(1); \
    if ((++_sp & 255u) == 0u) { if (xb_ld(&(bar)[XB_TMO])) break; if (_sp > XB_SPIN_CAP) { atomicAdd(&(bar)[XB_TMO], 1u); break; } } } } while (0)

struct XcdBarrier {
    unsigned* bar; unsigned x;
    volatile LAS unsigned* st;
};

__device__ __forceinline__ XcdBarrier xcd_barrier_post(unsigned* bar, volatile LAS unsigned* st) {
    XcdBarrier b; b.bar = bar; b.x = xb_xcc_id(); b.st = st;
    if (threadIdx.x == 0) (void)xb_add(&bar[XB_XCNT(b.x)], 1u);
    return b;
}
__device__ __forceinline__ void xcd_barrier_complete(unsigned* bar, unsigned x, unsigned& nloc, unsigned& nx) {
    const unsigned G = gridDim.x * gridDim.y * gridDim.z;
    unsigned sum, cnt, mine, sp = 0u;
    for (;;) {
        sum = 0u; cnt = 0u; mine = 0u;
#pragma unroll
        for (unsigned j = 0; j < 16; ++j) { const unsigned c = xb_ld(&bar[XB_XCNT(j)]); sum += c; cnt += (c > 0u) ? 1u : 0u; mine = (j == x) ? c : mine; }
        if (sum == G) break;
        __builtin_amdgcn_s_sleep(1);
        if ((++sp & 255u) == 0u) { if (xb_ld(&bar[XB_TMO])) break; if (sp > XB_SPIN_CAP) { atomicAdd(&bar[XB_TMO], 1u); break; } }
    }
    nloc = mine > 0u ? mine : 1u; nx = cnt > 0u ? cnt : 1u;
}

__device__ __forceinline__ void xcd_barrier(const XcdBarrier& b) {
    asm volatile("s_waitcnt vmcnt(0)" ::: "memory");
    __syncthreads();
    if (threadIdx.x == 0) {
        unsigned* bar = b.bar;
        __builtin_amdgcn_s_waitcnt(0);
        unsigned nloc = b.st[0], nx = b.st[1];
        if (nloc == 0u) { xcd_barrier_complete(bar, b.x, nloc, nx); b.st[0] = nloc; b.st[1] = nx; }
        const unsigned old = xb_add(&bar[XB_XSUB(b.x)], 1u);
        const unsigned gen = old / nloc;
        if (old + 1u == (gen + 1u) * nloc) {
            __builtin_amdgcn_fence(__ATOMIC_RELEASE, "agent");
            asm volatile("s_waitcnt vmcnt(0)" ::: "memory");
            const unsigned og = xb_add(&bar[XB_TOP], 1u);
            const unsigned tg = og / nx;
            if (og + 1u == (tg + 1u) * nx) xb_add(&bar[XB_TOPGEN], 1u);
            else XB_SPIN(xb_ld(&bar[XB_TOPGEN]) == tg, bar);
            __builtin_amdgcn_fence(__ATOMIC_ACQUIRE, "agent");
            xb_add(&bar[XB_XGEN(b.x)], 1u);
            asm volatile("s_waitcnt vmcnt(0)" ::: "memory");
        } else {
            XB_SPIN(xb_ld(&bar[XB_XGEN(b.x)]) == gen, bar);
            __builtin_amdgcn_fence(__ATOMIC_ACQUIRE, "agent");
            asm volatile("s_waitcnt vmcnt(0)" ::: "memory");
        }
    }
    __syncthreads();
}

struct Args { const float* in[34]; float* out; unsigned char* ws; int ph_lo, ph_hi; };

__device__ __forceinline__ int in1_row(int n) { if (n < 1024) return n; const int j = (n - 1024) & 1023, t = j >> 7, i = j & 127; return 1024 + 256 * t + (n >= 2048 ? 128 : 0) + i; }
template <bool MAP1 = false>
__device__ __forceinline__ void p0_transpose_item(const float* __restrict__ W, int K, int N, bf16_t* __restrict__ WT, float* scr, int item, int lane) {
    const int nblk = N / 32, kb = item / nblk, nb = item % nblk, k0 = 64 * kb, n0 = 32 * nb;
#pragma unroll 8
    for (int i = 0; i < 32; ++i) { const int kk = 2 * i + (lane >> 5); scr[kk * 33 + (lane & 31)] = W[(size_t)(k0 + kk) * N + n0 + (lane & 31)]; }
    LDS_WAIT(); asm volatile("" ::: "memory");
    const int c = lane & 7;
#pragma unroll
    for (int j = 0; j < 4; ++j) { const int n = (lane >> 3) + 8 * j; const float* s = scr + (8 * c) * 33 + n;
        u32x4v o; o.x = pk2(s[0 * 33], s[1 * 33]); o.y = pk2(s[2 * 33], s[3 * 33]); o.z = pk2(s[4 * 33], s[5 * 33]); o.w = pk2(s[6 * 33], s[7 * 33]);
        *(u32x4v*)(WT + (size_t)(MAP1 ? in1_row(n0 + n) : n0 + n) * K + k0 + 8 * c) = o; }
    LDS_WAIT(); asm volatile("" ::: "memory");
}
__device__ __forceinline__ void p0_adaln_item(const Args& a, int item, float* silu_tab  , float* part  , int tid) {
    const int wid = tid >> 6, lane = tid & 63;
    const int layer = item / 48, blk = item % 48, j0 = blk * 128 + 2 * lane;
    const float* wm = a.in[layer ? 23 : 6]; const float* bm = a.in[layer ? 24 : 7];
    for (int i = tid; i < NCOND * DM; i += 512) { const int c = i >> 10, k = i & 1023; const float x = c == 0 ? a.in[5][k] : a.in[4][(c - 1) * DM + k]; silu_tab[i] = x / (1.f + __expf(-x)); }
    __syncthreads();
    f32x2v acc[NCOND];
#pragma unroll
    for (int c = 0; c < NCOND; ++c) acc[c] = (f32x2v){0.f, 0.f};
    const int kb = wid * 128;
    for (int k = kb; k < kb + 128; k += 16) {
        f32x2v w[16];
#pragma unroll
        for (int u = 0; u < 16; ++u) w[u] = *(const f32x2v*)(wm + (size_t)(k + u) * MODW + j0);
#pragma unroll
        for (int u = 0; u < 16; ++u)
#pragma unroll
            for (int c = 0; c < NCOND; ++c) acc[c] += w[u] * silu_tab[c * DM + k + u];
    }
#pragma unroll
    for (int c = 0; c < NCOND; ++c) *(f32x2v*)(part + (wid * NCOND + c) * 128 + 2 * lane) = acc[c];
    __syncthreads();
    float* mod = (float*)(a.ws + WS_MOD) + (size_t)layer * NCOND * MODW;
    for (int o = tid; o < NCOND * 128; o += 512) { const int c = o >> 7, j = o & 127; float s = bm[blk * 128 + j];
#pragma unroll
        for (int w8 = 0; w8 < 8; ++w8) s += part[(w8 * NCOND + c) * 128 + j];
        mod[(size_t)c * MODW + blk * 128 + j] = s; }
    __syncthreads();
}
__device__ __forceinline__ int row_cond(int row) { return row < MP ? 0 : 1 + ((row - MP) >> 12); }
__device__ __forceinline__ const float* x_in_row(const Args& a, int row) { return row < MP ? a.in[0] + (size_t)row * DM : a.in[1] + (size_t)(row - MP) * DM; }

__device__ __forceinline__ void p0_prologue(const Args& a, char* lds) {
    const int tid = opaque_tid(), wid = tid >> 6, lane = tid & 63, G = gridDim.x;
    float* scr = (float*)(lds + wid * 8704);
    if (blockIdx.x < 96) p0_adaln_item(a, blockIdx.x, (float*)(lds + 73728), (float*)(lds + 73728 + 20480), tid);
    const int gw = blockIdx.x * 8 + wid, NGW = G * 8;
    constexpr int I_IN0 = 16 * (IN0 / 32), I_OUT = 16 * 32, I_FF1 = 16 * (DFF / 32), I_FF2 = 64 * 32, I_IN1 = 16 * (IN1 / 32);
    constexpr int NITEMS = I_IN0 + I_OUT + I_FF1 + I_FF2 + I_IN1 + I_OUT + I_FF1 + I_FF2;
    constexpr int PASS1_PER_WAVE = 5;
    const int n_late = (G > 96) ? (G - 96) * 8 : 0, pass1 = n_late * PASS1_PER_WAVE < NITEMS ? n_late * PASS1_PER_WAVE : NITEMS;
#pragma unroll 1
    for (int pass = 0; pass < 2; ++pass) {
        int it0, it1, stride, first;
        if (pass == 0) { it0 = 0; it1 = pass1; stride = n_late; first = (int)blockIdx.x >= 96 ? (gw - 96 * 8) : it1; }
        else { it0 = pass1; it1 = NITEMS; stride = NGW; first = gw; }
        if (stride <= 0) continue;
#pragma unroll 1
        for (int it = it0 + first; it < it1; it += stride) {
        int r = it;
        if (r < I_IN0) { p0_transpose_item(a.in[8], DM, IN0, (bf16_t*)(a.ws + WS_WIN0), scr, r, lane); continue; } r -= I_IN0;
        if (r < I_OUT) { p0_transpose_item(a.in[16], DM, DM, (bf16_t*)(a.ws + WS_WOUT0), scr, r, lane); continue; } r -= I_OUT;
        if (r < I_FF1) { p0_transpose_item(a.in[19], DM, DFF, (bf16_t*)(a.ws + WS_WFF1_0), scr, r, lane); continue; } r -= I_FF1;
        if (r < I_FF2) { p0_transpose_item(a.in[20], DFF, DM, (bf16_t*)(a.ws + WS_WFF2_0), scr, r, lane); continue; } r -= I_FF2;
        if (r < I_IN1) { p0_transpose_item<true>(a.in[25], DM, IN1, (bf16_t*)(a.ws + WS_WIN1), scr, r, lane); continue; } r -= I_IN1;
        if (r < I_OUT) { p0_transpose_item(a.in[27], DM, DM, (bf16_t*)(a.ws + WS_WOUT1), scr, r, lane); continue; } r -= I_OUT;
        if (r < I_FF1) { p0_transpose_item(a.in[30], DM, DFF, (bf16_t*)(a.ws + WS_WFF1_1), scr, r, lane); continue; } r -= I_FF1;
        p0_transpose_item(a.in[31], DFF, DM, (bf16_t*)(a.ws + WS_WFF2_1), scr, r, lane);
            }
    }
    for (int i = blockIdx.x * 512 + tid; i < 2 * 131072 / 2; i += G * 512) {
        const bool isk = i < 65536; const int j = isk ? i : i - 65536;
        const float* src = (isk ? a.in[2] : a.in[3]) + (size_t)j * 8;
        const f32x4v x0 = *(const f32x4v*)src, x1 = *(const f32x4v*)(src + 4);
        u32x4v o; o.x = pk2(x0[0], x0[1]); o.y = pk2(x0[2], x0[3]); o.z = pk2(x1[0], x1[1]); o.w = pk2(x1[2], x1[3]);
        *(u32x4v*)((bf16_t*)(a.ws + (isk ? WS_CK : WS_CV)) + (size_t)j * 8) = o;
    }
    if (blockIdx.x == G - 1 && wid == 7) {
        const float s1 = wave_sum(a.in[9][lane] * a.in[10][lane]), s2 = wave_sum(a.in[11][lane] * a.in[12][lane]);
        if (lane == 0) ((float*)(a.ws + WS_MOD))[2 * NCOND * MODW] = __expf(s1) - __expf(s2) + LAMBDA_INIT;
    }
}
__device__ __forceinline__ void p_modulate0(const Args& a) {
    const int tid = opaque_tid(), wid = tid >> 6, lane = tid & 63;
    const float* mod = (const float*)(a.ws + WS_MOD); bf16_t* HB = (bf16_t*)(a.ws + WS_HB);
    for (int row = blockIdx.x * 8 + wid; row < MT; row += gridDim.x * 8) {
        const float* xr = x_in_row(a, row) + 4 * lane; const float* mc = mod + (size_t)row_cond(row) * MODW + 4 * lane;
        unsigned long long* o8 = (unsigned long long*)(HB + (size_t)row * DM) + lane;
#pragma unroll
        for (int j = 0; j < 4; ++j) { const f32x4v x = *(const f32x4v*)(xr + 256 * j), sh = *(const f32x4v*)(mc + 256 * j), sc = *(const f32x4v*)(mc + DM + 256 * j);
            const f32x4v h = x * (sc + 1.f) + sh; o8[64 * j] = (unsigned long long)pk2(h[0], h[1]) | ((unsigned long long)pk2(h[2], h[3]) << 32); }
    }
}
template <bool WRITE_H>
__device__ __forceinline__ void p_layernorm(const bf16_t* __restrict__ Y, const float* __restrict__ g, const float* __restrict__ b, const float* __restrict__ modn, bf16_t* HB, bf16_t* XB, float* OUT,
                                            int row0, int nrows, const bf16_t* __restrict__ P) {
    const int tid = opaque_tid(), wid = tid >> 6, lane = tid & 63;
    for (int row = row0 + blockIdx.x * 8 + wid; row < row0 + nrows; row += gridDim.x * 8) {
        const bf16_t* yr = Y + (size_t)row * DM + 8 * lane; const bf16_t* pr = P ? P + (size_t)(row - row0) * DM + 8 * lane : nullptr;
        f32x4v v[4]; float s = 0.f;
#pragma unroll
        for (int j = 0; j < 2; ++j) { const u32x4v w = *(const u32x4v*)(yr + 512 * j);
            v[2 * j] = (f32x4v){bf_lo(w.x), bf_hi(w.x), bf_lo(w.y), bf_hi(w.y)}; v[2 * j + 1] = (f32x4v){bf_lo(w.z), bf_hi(w.z), bf_lo(w.w), bf_hi(w.w)};
            if (pr) { const u32x4v q = *(const u32x4v*)(pr + 512 * j); v[2 * j] += (f32x4v){bf_lo(q.x), bf_hi(q.x), bf_lo(q.y), bf_hi(q.y)}; v[2 * j + 1] += (f32x4v){bf_lo(q.z), bf_hi(q.z), bf_lo(q.w), bf_hi(q.w)}; } }
#pragma unroll
        for (int j = 0; j < 4; ++j) s += (v[j][0] + v[j][1]) + (v[j][2] + v[j][3]);
        const float mean = wave_sum(s) * (1.f / DM); float s2 = 0.f;
#pragma unroll
        for (int j = 0; j < 4; ++j) { v[j] = v[j] - mean; s2 += (v[j][0] * v[j][0] + v[j][1] * v[j][1]) + (v[j][2] * v[j][2] + v[j][3] * v[j][3]); }
        const float rstd = 1.f / sqrtf(wave_sum(s2) * (1.f / DM) + LN_EPS_F);
        const float* mc = WRITE_H ? modn + (size_t)row_cond(row) * MODW + 8 * lane : nullptr;
#pragma unroll
        for (int j = 0; j < 2; ++j) { const int c = 8 * lane + 512 * j;
            const f32x4v y0 = v[2 * j] * rstd * *(const f32x4v*)(g + c) + *(const f32x4v*)(b + c), y1 = v[2 * j + 1] * rstd * *(const f32x4v*)(g + c + 4) + *(const f32x4v*)(b + c + 4);
            if (XB) { u32x4v o; o.x = pk2(y0[0], y0[1]); o.y = pk2(y0[2], y0[3]); o.z = pk2(y1[0], y1[1]); o.w = pk2(y1[2], y1[3]); *(u32x4v*)(XB + (size_t)row * DM + c) = o; }
            if (OUT) { *(f32x4v*)(OUT + (size_t)row * DM + c) = y0; *(f32x4v*)(OUT + (size_t)row * DM + c + 4) = y1; }
            if (WRITE_H) { const f32x4v h0 = y0 * (*(const f32x4v*)(mc + DM + 512 * j) + 1.f) + *(const f32x4v*)(mc + 512 * j), h1 = y1 * (*(const f32x4v*)(mc + DM + 512 * j + 4) + 1.f) + *(const f32x4v*)(mc + 512 * j + 4);
                u32x4v o; o.x = pk2(h0[0], h0[1]); o.y = pk2(h0[2], h0[3]); o.z = pk2(h1[0], h1[1]); o.w = pk2(h1[2], h1[3]); *(u32x4v*)(HB + (size_t)row * DM + c) = o; } }
    }
}
__device__ __forceinline__ void p_conv(const Args& a) {
    const int tid = opaque_tid(), wid = tid >> 6, lane = tid & 63;
    const bf16_t* BG = (const bf16_t*)(a.ws + WS_R1); const bf16_t* Z = BG + (size_t)MT * DM; bf16_t* MIX = (bf16_t*)(a.ws + WS_HB); const float* cw = a.in[26];
    for (int row = blockIdx.x * 8 + wid; row < MT; row += gridDim.x * 8) {
        const int pos = row < MP ? (row & 255) : ((row - MP) & 4095), len = row < MP ? 256 : 4096;
        const bool hasl = pos > 0, hasr = pos < len - 1;
#pragma unroll
        for (int j = 0; j < 2; ++j) {
            const int c8 = (lane + 64 * j) * 8; const bf16_t* p = Z + (size_t)row * DM + c8;
            const u32x4v bg = *(const u32x4v*)(BG + (size_t)row * DM + c8), z1 = *(const u32x4v*)p;
            u32x4v z0 = {0, 0, 0, 0}, z2 = z0;
            if (hasl) z0 = *(const u32x4v*)(p - DM);
            if (hasr) z2 = *(const u32x4v*)(p + DM);
            const f32x4v w0a = *(const f32x4v*)(cw + c8), w0b = *(const f32x4v*)(cw + c8 + 4), w1a = *(const f32x4v*)(cw + DM + c8), w1b = *(const f32x4v*)(cw + DM + c8 + 4),
                         w2a = *(const f32x4v*)(cw + 2 * DM + c8), w2b = *(const f32x4v*)(cw + 2 * DM + c8 + 4);
            u32x4v o;
#pragma unroll
            for (int e = 0; e < 4; ++e) {
                const float w0l = e < 2 ? w0a[2 * e] : w0b[2 * e - 4], w0h = e < 2 ? w0a[2 * e + 1] : w0b[2 * e - 3];
                const float w1l = e < 2 ? w1a[2 * e] : w1b[2 * e - 4], w1h = e < 2 ? w1a[2 * e + 1] : w1b[2 * e - 3];
                const float w2l = e < 2 ? w2a[2 * e] : w2b[2 * e - 4], w2h = e < 2 ? w2a[2 * e + 1] : w2b[2 * e - 3];
                const float yl = bf_lo(z0[e]) * w0l + bf_lo(z1[e]) * w1l + bf_lo(z2[e]) * w2l;
                const float yh = bf_hi(z0[e]) * w0h + bf_hi(z1[e]) * w1h + bf_hi(z2[e]) * w2h;
                o[e] = pk2(bf_lo(bg[e]) * yl, bf_hi(bg[e]) * yh);
            }
            *(u32x4v*)(MIX + (size_t)row * DM + c8) = o;
        }
    }
}
__device__ __forceinline__ void p_attention(const Args& a, char* lds) {
    const int tid = opaque_tid(), wid = tid >> 6, lane = tid & 63, r32 = lane & 31, hi = lane >> 5;
    const bf16_t* QB = (const bf16_t*)(a.ws + WS_R1); const bf16_t* KB = QB + (size_t)MT * 512; const bf16_t* VB = KB + (size_t)MT * 512;
    const bf16_t* CK = (const bf16_t*)(a.ws + WS_CK); const bf16_t* CV = (const bf16_t*)(a.ws + WS_CV);
    bf16_t* MIX = (bf16_t*)(a.ws + WS_HB);
    const float lam = ((const float*)(a.ws + WS_MOD))[2 * NCOND * MODW];
    float* o0s = a.out + (((size_t)blockIdx.x * 8 + wid) * 64 + lane) * 64;
    const float* subg = a.in[13];
    for (int ui = blockIdx.x; ui < 256 + 128; ui += gridDim.x) {
        int qrow0, h, ncache, NT; const bf16_t *Kc, *Vc, *Kn, *Vn;
        if (ui < 256) {
            const int xcd = ui & 7, slot = ui >> 3, bh = xcd * 2 + (slot >> 4), qb = slot & 15, b = bh >> 2; h = bh & 3;
            qrow0 = MP + b * 4096 + qb * 256; ncache = 4; NT = 68;
            Kc = CK + (size_t)(b * 256) * 512; Vc = CV + (size_t)(b * 256) * 512; Kn = KB + (size_t)(MP + b * 4096) * 512; Vn = VB + (size_t)(MP + b * 4096) * 512;
        } else { const int p = ui - 256, b = p >> 2; h = p & 3; qrow0 = b * 256; ncache = 0; NT = 4;
            Kn = KB + (size_t)(b * 256) * 512; Vn = VB + (size_t)(b * 256) * 512; Kc = Kn; Vc = Vn; }
        const bf16_t* Qw = QB + (size_t)(qrow0 + wid * 32 + r32) * 512 + h * 128 + hi * 8;
        f32x16 o[4];
        att::attn_half(o, Qw, Kc + h * 128, Vc + h * 128, Kn + h * 128, Vn + h * 128, ncache, NT, lds);
        { float* op = o0s; asm volatile("" : "+v"(op));
#pragma unroll
        for (int d = 0; d < 4; ++d)
#pragma unroll
            for (int r4 = 0; r4 < 4; ++r4) *(f32x4v*)(op + d * 16 + r4 * 4) = (f32x4v){o[d][4 * r4], o[d][4 * r4 + 1], o[d][4 * r4 + 2], o[d][4 * r4 + 3]}; }
        att::attn_half(o, Qw + 64, Kc + h * 128 + 64, Vc + h * 128, Kn + h * 128 + 64, Vn + h * 128, ncache, NT, lds);
        float ss[16];
#pragma unroll
        for (int r = 0; r < 16; ++r) ss[r] = 0.f;
        int hi_ = hi; const float* op = o0s; asm volatile("" : "+v"(op), "+v"(hi_));
#pragma unroll
        for (int d = 0; d < 4; ++d)
#pragma unroll
            for (int r4 = 0; r4 < 4; ++r4) { const f32x4v o0 = *(const f32x4v*)(op + d * 16 + r4 * 4);
#pragma unroll
                for (int e = 0; e < 4; ++e) { const int r = 4 * r4 + e; const float v = o0[e] - lam * o[d][r]; o[d][r] = v; ss[r] += v * v; } }
#pragma unroll
        for (int r = 0; r < 16; ++r) { float s = ss[r]; s += __shfl_xor(s, 1); s += __shfl_xor(s, 2); s += __shfl_xor(s, 4); s += __shfl_xor(s, 8); s += __shfl_xor(s, 16);
            ss[r] = (1.f - LAMBDA_INIT) / sqrtf(s * (1.f / 128.f) + LN_EPS_F); }
        bf16_t* mo = MIX + (size_t)(qrow0 + wid * 32) * DM + h * 128 + r32;
#pragma unroll
        for (int d = 0; d < 4; ++d) { const float gd = subg[d * 32 + r32];
#pragma unroll
            for (int r = 0; r < 16; ++r) { const float v = o[d][r] * ss[r] * gd; mo[(size_t)att::crow(r, hi_) * DM + d * 32] = (bf16_t)(pk2(v, v) & 0xffffu); } }
    }
}
__device__ __forceinline__ void p_sgu(const Args& a, char* lds) {
    const int tid = opaque_tid(), wid = tid >> 6, lane = tid & 63, r32 = lane & 31, hi = lane >> 5, G = gridDim.x;
    const bf16_t* UB = (const bf16_t*)(a.ws + WS_R1) + (size_t)3 * MT * 512; const bf16_t* GB = UB + (size_t)MT * 512;
    bf16_t* MIX = (bf16_t*)(a.ws + WS_HB);
    const float* sw = a.in[14]; const float* sb = a.in[15];
    bf16_t* Wl = (bf16_t*)lds; bf16_t* VT = (bf16_t*)(lds + 34816);
    int u0, nu; if (G == 256) { if ((int)blockIdx.x < 128) { u0 = blockIdx.x * 2; nu = 2; } else { u0 = 256 + (blockIdx.x - 128) * 4; nu = 4; } } else { u0 = 0; nu = 0; }
    for (int k = 0; (G == 256) ? (k < nu) : ((int)blockIdx.x + k * G < 768); ++k) {
        const int su = (G == 256) ? u0 + k : (int)blockIdx.x + k * G;
        const int chunk = su >> 2, g = su & 3, row0 = chunk * 128;
        __syncthreads();
        for (int it = 0; it < 8; ++it) { const int idx = (it * 512 + tid) * 4, p = idx >> 7, q = idx & 127;
            const f32x4v w = *(const f32x4v*)(sw + (size_t)g * 16384 + idx);
            u32x2v o; o.x = pk2(w[0], w[1]); o.y = pk2(w[2], w[3]); *(u32x2v*)(Wl + p * 136 + q) = o; }
#pragma unroll
        for (int it = 0; it < 4; ++it) { const int tok = wid * 16 + it * 4 + (lane >> 4), d0 = (lane & 15) * 8;
            const u32x4v x = *(const u32x4v*)(GB + (size_t)(row0 + tok) * 512 + g * 128 + d0);
            float f[8];
#pragma unroll
            for (int e = 0; e < 4; ++e) { f[2 * e] = bf_lo(x[e]); f[2 * e + 1] = bf_hi(x[e]); }
            float s = 0.f;
#pragma unroll
            for (int e = 0; e < 8; ++e) s += f[e];
            s += __shfl_xor(s, 1); s += __shfl_xor(s, 2); s += __shfl_xor(s, 4); s += __shfl_xor(s, 8);
            const float mean = s * (1.f / 128.f); float q2 = 0.f;
#pragma unroll
            for (int e = 0; e < 8; ++e) { f[e] -= mean; q2 += f[e] * f[e]; }
            q2 += __shfl_xor(q2, 1); q2 += __shfl_xor(q2, 2); q2 += __shfl_xor(q2, 4); q2 += __shfl_xor(q2, 8);
            const float rstd = 1.f / sqrtf(q2 * (1.f / 128.f) + LN_EPS_F);
#pragma unroll
            for (int e = 0; e < 8; ++e) VT[(d0 + e) * 136 + tok] = (bf16_t)(pk2(f[e] * rstd, 0.f) & 0xffffu);
        }
        __syncthreads();
        const int pbase = (wid & 3) * 32, dbase = (wid >> 2) * 64;
        f32x16 acc[2] = {f32x16{}, f32x16{}};
#pragma unroll
        for (int ks = 0; ks < 8; ++ks) {
            const bf16x8v bw = *(const bf16x8v*)(Wl + (pbase + r32) * 136 + ks * 16 + hi * 8);
#pragma unroll
            for (int ds = 0; ds < 2; ++ds) { const bf16x8v av = *(const bf16x8v*)(VT + (dbase + ds * 32 + r32) * 136 + ks * 16 + hi * 8);
                acc[ds] = __builtin_amdgcn_mfma_f32_32x32x16_bf16(av, bw, acc[ds], 0, 0, 0); }
        }
        const int p = pbase + r32; const float bias = sb[g * 128 + p];
        const bf16_t* up = UB + (size_t)(row0 + p) * 512 + g * 128; bf16_t* mo = MIX + (size_t)(row0 + p) * DM + 512 + g * 128;
#pragma unroll
        for (int ds = 0; ds < 2; ++ds)
#pragma unroll
            for (int rq = 0; rq < 4; ++rq) { const int d = dbase + ds * 32 + 8 * rq + 4 * hi;
                const u32x2v uu = *(const u32x2v*)(up + d);
                u32x2v o; o.x = pk2(bf_lo(uu.x) * (acc[ds][4 * rq] + bias), bf_hi(uu.x) * (acc[ds][4 * rq + 1] + bias));
                o.y = pk2(bf_lo(uu.y) * (acc[ds][4 * rq + 2] + bias), bf_hi(uu.y) * (acc[ds][4 * rq + 3] + bias));
                *(u32x2v*)(mo + d) = o; }
    }
}
constexpr int NPHASE = 20;
#ifndef PHMASK
#define PHMASK 0xfffff
#endif
#define PM(i) ((PHMASK >> (i)) & 1)
#ifndef PROBE_REP
#define PROBE_REP 0
#endif
#define NREP(i) (1 + ((PROBE_REP >> (i)) & 1))
__global__ void __launch_bounds__(512, 2) mega_fwd(Args a) {
    extern __shared__ __attribute__((aligned(16))) unsigned char lds_raw[];
    char* lds = (char*)lds_raw;
    PG8_LAS unsigned char* glds = (PG8_LAS unsigned char*)lds_raw;
    cg::grid_group grid = cg::this_grid();
    volatile LAS unsigned* MISC = (volatile LAS unsigned*)(glds + 131072);
    if (threadIdx.x < 16) MISC[threadIdx.x] = 0u;
    __syncthreads();
    unsigned* const barw = (unsigned*)(a.ws + WS_CTL);
    XcdBarrier xbar; xbar.bar = barw; xbar.x = 0; xbar.st = nullptr;
    const int lo = a.ph_lo, hi = a.ph_hi, G = gridDim.x, bx = blockIdx.x;
    float* const mod = (float*)(a.ws + WS_MOD);
    bf16_t* const YB = (bf16_t*)a.out;
    bf16_t* const XB = YB + (size_t)MT * DM;
    bf16_t* const HB = (bf16_t*)(a.ws + WS_HB);
    bf16_t* const R1 = (bf16_t*)(a.ws + WS_R1);
#define IN(k) (lo <= (k) && (k) < hi)
#define SEAM(k) do { if (IN(k) && IN((k) + 1)) { xcd_barrier(xbar); if ((PROBE_REP >> 20) & 1) xcd_barrier(xbar); } } while (0)
    int ph = 0;
    for (int rep = 0; rep < NREP(0); ++rep) { if (PM(0) && IN(ph)) p0_prologue(a, lds); __syncthreads(); }
    if (IN(ph) && bx == 0) for (int i = threadIdx.x; i < XCD_BAR_WORDS; i += 512) __hip_atomic_store(barw + i, 0u, __ATOMIC_RELAXED, __HIP_MEMORY_SCOPE_AGENT);
    if (IN(ph) && IN(ph + 1)) { grid.sync();
        xbar = xcd_barrier_post(barw, MISC + 8); }
    ++ph;
    for (int rep = 0; rep < NREP(1); ++rep) if (PM(1) && IN(ph)) p_modulate0(a);
    SEAM(ph); ++ph;
#pragma unroll 1
    for (int layer = 0; layer < 2; ++layer) {
        const float* lmod = mod + (size_t)layer * NCOND * MODW;
        const bf16_t* w_in = (const bf16_t*)(a.ws + (layer ? WS_WIN1 : WS_WIN0)); const bf16_t* w_out = (const bf16_t*)(a.ws + (layer ? WS_WOUT1 : WS_WOUT0));
        const bf16_t* w_ff1 = (const bf16_t*)(a.ws + (layer ? WS_WFF1_1 : WS_WFF1_0)); const bf16_t* w_ff2 = (const bf16_t*)(a.ws + (layer ? WS_WFF2_1 : WS_WFF2_0));
        const float* g_mix = a.in[layer ? 28 : 17]; const float* b_mix = a.in[layer ? 29 : 18]; const float* g_ff = a.in[layer ? 32 : 21]; const float* b_ff = a.in[layer ? 33 : 22];
        for (int rep = 0; rep < NREP(2); ++rep) if (IN(ph)) {
            if (PM(2) && layer == 0) { pg8::Gemm g{HB, w_in, MT, IN0, DM, DM}; pg8::StaticOrder S; S.init(MT, IN0, G, bx);
                pg8::EpiInProj0 E{R1, a.out + (size_t)MT * DM, a.out + (size_t)MT * DM + (size_t)MP * 512};
                pg8::gemm_phase<pg8::EpiInProj0, pg8::StaticOrder, true, true>(glds, g, S, E);
            } else if (PM(3) && layer == 1) { pg8::Gemm g{HB, w_in, MT, IN1, DM, DM}; pg8::StaticOrder S; S.init(MT, IN1, G, bx);
                pg8::EpiInProj1 E{R1, R1 + (size_t)MT * DM};
                pg8::gemm_phase<pg8::EpiInProj1, pg8::StaticOrder, true, true>(glds, g, S, E); }
        }
        SEAM(ph); ++ph;
        if (IN(ph)) { if (layer == 0) { for (int rep = 0; rep < NREP(4); ++rep) { if (PM(4)) p_attention(a, lds); } for (int rep = 0; rep < NREP(5); ++rep) { if (PM(5)) p_sgu(a, lds); } } else for (int rep = 0; rep < NREP(6); ++rep) { if (PM(6)) p_conv(a); } }
        SEAM(ph); ++ph;
        for (int rep = 0; rep < (layer == 0 ? NREP(7) : 1); ++rep) if (PM(7) && IN(ph)) { pg8::Gemm g{HB, w_out, MT, DM, DM, DM}; pg8::StaticOrder S; S.init(MT, DM, G, bx);
            pg8::EpiResid E{a.in[0], a.in[1], layer == 0 ? nullptr : XB, YB, lmod + 2 * DM, 0, nullptr, 0};
            pg8::gemm_phase<pg8::EpiResid, pg8::StaticOrder, true, true>(glds, g, S, E); }
        SEAM(ph); ++ph;
        if (PM(8) && IN(ph)) p_layernorm<true>(YB, g_mix, b_mix, lmod + 3 * DM, HB, XB, nullptr, 0, MT, nullptr);
        SEAM(ph); ++ph;
        bf16_t* const Pbuf = (bf16_t*)(a.ws + WS_R1 + (size_t)MHALF * DFF * 2);
        const float* const modnext = layer == 0 ? mod + (size_t)NCOND * MODW : nullptr;
        bf16_t* const Y2 = layer == 0 ? YB : HB;
#pragma unroll 1
        for (int half = 0; half < 2; ++half) {
            if (IN(ph)) {
                if (half == 1 && PM(11)) {
                    if (layer == 0) p_layernorm<true>(Y2, g_ff, b_ff, modnext, HB, XB, nullptr, 0, MHALF, Pbuf); else p_layernorm<false>(Y2, g_ff, b_ff, nullptr, nullptr, nullptr, a.out, 0, MHALF, Pbuf); }
                for (int rep = 0; rep < NREP(9); ++rep) if (PM(9)) { pg8::Gemm g{HB + (size_t)half * MHALF * DM, w_ff1, MHALF, DFF, DM, DM}; pg8::StaticOrder S; S.init(MHALF, DFF, G, bx);
                    pg8::EpiAct<1> E{R1, DFF};
                    pg8::gemm_phase<pg8::EpiAct<1>, pg8::StaticOrder, true, true>(glds, g, S, E); }
            }
            SEAM(ph); ++ph;
            if (PM(10) && IN(ph)) { const int helper = bx >= 192; const int koff = helper ? 3072 : 0;
                pg8::Gemm g{R1 + koff, w_ff2 + koff, MHALF, DM, helper ? 1024 : 3072, DFF}; pg8::SplitOrder S{bx};
                pg8::EpiResid E{nullptr, nullptr, XB, Y2, lmod + 5 * DM, half * (MHALF / 256), Pbuf, helper};
                pg8::gemm_phase<pg8::EpiResid, pg8::SplitOrder, true, true>(glds, g, S, E); }
            SEAM(ph); ++ph;
        }
        if (PM(11) && IN(ph)) { if (layer == 0) p_layernorm<true>(Y2, g_ff, b_ff, modnext, HB, XB, nullptr, MHALF, MHALF, Pbuf); else p_layernorm<false>(Y2, g_ff, b_ff, nullptr, nullptr, nullptr, a.out, MHALF, MHALF, Pbuf); }
        if (layer == 0) SEAM(ph);
        ++ph;
    }
#undef IN
#undef SEAM
}

extern "C" void kernel_launch(void* const* d_in, const int* in_sizes, int n_in, void* d_out, int out_size, void* d_ws, size_t ws_size, hipStream_t stream) {
    static int ready = 0;
    if (ready == 0) {
        if (n_in != 34 || ws_size < WS_END) { fprintf(stderr, "kernel_launch: built for 34 inputs and >= %zu bytes of workspace; got n_in %d ws %zu\n", (size_t)WS_END, n_in, ws_size); ready = -1; return; }
        if (hipFuncSetAttribute((const void*)mega_fwd, hipFuncAttributeMaxDynamicSharedMemorySize, LDS_BYTES) != hipSuccess) { fprintf(stderr, "kernel_launch: hipFuncSetAttribute failed\n"); ready = -1; return; }
        int dev = 0, cus = 0, per_cu = 0;
        hipGetDevice(&dev); hipDeviceGetAttribute(&cus, hipDeviceAttributeMultiprocessorCount, dev);
        hipOccupancyMaxActiveBlocksPerMultiprocessor(&per_cu, (const void*)mega_fwd, 512, LDS_BYTES);
        if (cus * per_cu < 256) { fprintf(stderr, "kernel_launch: resident capacity %d x %d < 256 workgroups\n", cus, per_cu); ready = -1; return; }
        ready = 1;
    }
    if (ready < 0) return;
    Args a{};
    for (int i = 0; i < 34; ++i) a.in[i] = (const float*)d_in[i];
    a.out = (float*)d_out; a.ws = (unsigned char*)d_ws;
#if MK_PER_PHASE
    for (int p = 0; p < NPHASE; ++p) { a.ph_lo = p; a.ph_hi = p + 1; hipLaunchKernelGGL(mega_fwd, dim3(256), dim3(512), LDS_BYTES, stream, a); }
#else
    a.ph_lo = 0; a.ph_hi = NPHASE;
    void* args[] = {&a};
    hipError_t e = hipLaunchCooperativeKernel((const void*)mega_fwd, dim3(256), dim3(512), args, LDS_BYTES, stream);
    if (e != hipSuccess) fprintf(stderr, "cooperative launch failed: %s\n", hipGetErrorString(e));
#endif
}
```
